# Optimizing an MI355X kernel written in HIP

```python
import jax, jax.numpy as jnp
from jax import lax
import numpy as np

D_MODEL = 1024
BATCH = 8
SEQ = 4096
DEPTH = 4

CHUNK = 64
PLE_DIM = 256
EPS = 1e-6
A_HEADS = 4
A_DK = 128
A_DV = 128
A_WIDTH = A_HEADS * A_DV
B_HEADS = 8
B_HD = 64
B_WIDTH = B_HEADS * B_HD
B_LEFT_CHUNKS = 8
B_BAND = (B_LEFT_CHUNKS + 1) * CHUNK
MAX_REL = 128
N_REL = 2 * MAX_REL + 1
D_FF = ((8 * D_MODEL // 3 + 255) // 256) * 256
IN_SIZES = (A_HEADS * A_DK, A_HEADS * A_DK, A_WIDTH, A_WIDTH,
            B_WIDTH, B_WIDTH, B_WIDTH,
            D_MODEL, D_MODEL)
D_IN = sum(IN_SIZES)

kernel_name = "hybrid_hgrn2_bandattn_streaming_trunk"


def rmsnorm(x, g):
    x32 = x.astype(jnp.float32)
    y = x32 * lax.rsqrt(jnp.mean(x32 * x32, axis=-1, keepdims=True) + EPS)
    return (y * g.astype(jnp.float32)).astype(x.dtype)


def head_rms(t, g):
    t32 = t.astype(jnp.float32)
    return t32 * lax.rsqrt(jnp.mean(t32 * t32, axis=-1, keepdims=True) + EPS) * g.astype(jnp.float32)


def hgrn2_mixer(q, f_logit, i, g, lb, onorm_g):
    f32 = jnp.float32
    bsz, seq, _ = q.shape
    nc = seq // CHUNK
    lb32 = lb.astype(f32)
    logf = jnp.logaddexp(jnp.log(lb32), jnp.log1p(-lb32) + jax.nn.log_sigmoid(f_logit.astype(f32)))
    k = 1.0 - jnp.exp(logf)

    def heads(t, d):
        return t.astype(f32).reshape(bsz, nc, CHUNK, A_HEADS, d).transpose(1, 0, 3, 2, 4)

    qc = heads(q, A_DK) * (A_DK ** -0.5)
    kc = heads(k, A_DK)
    lfc = heads(logf, A_DK)
    ic = heads(i, A_DV)
    causal = jnp.tril(jnp.ones((CHUNK, CHUNK), dtype=bool))

    def step(state, inp):
        qt, kt, lft, it = inp
        b = jnp.cumsum(lft, axis=-2)
        o_inter = jnp.einsum('bhtk,bhkv->bhtv', qt * jnp.exp(b), state)
        diff = b[..., :, None, :] - b[..., None, :, :]
        dec = jnp.exp(jnp.where(causal[:, :, None], diff, -jnp.inf))
        attn = jnp.einsum('bhtk,bhsk,bhtsk->bhts', qt, kt, dec)
        o = o_inter + jnp.einsum('bhts,bhsv->bhtv', attn, it)
        b_last = b[..., -1:, :]
        new_state = (jnp.exp(b_last[..., 0, :])[..., None] * state
                     + jnp.einsum('bhsk,bhsv->bhkv', kt * jnp.exp(b_last - b), it))
        return new_state, o

    s0 = jnp.zeros((bsz, A_HEADS, A_DK, A_DV), f32)
    _, o = lax.scan(step, s0, (qc, kc, lfc, ic))
    o = o.transpose(1, 0, 3, 2, 4).reshape(bsz, seq, A_HEADS, A_DV)
    o = head_rms(o, onorm_g).reshape(bsz, seq, A_WIDTH) * jax.nn.silu(g.astype(f32))
    return o.astype(q.dtype)


def band_attention(q, k, v, qn_g, kn_g, rel_bias):
    f32 = jnp.float32
    bsz, seq, _ = q.shape
    nc = seq // CHUNK
    qh = head_rms(q.reshape(bsz, seq, B_HEADS, B_HD), qn_g)
    kh = head_rms(k.reshape(bsz, seq, B_HEADS, B_HD), kn_g)
    vh = v.reshape(bsz, seq, B_HEADS, B_HD).astype(f32)
    pad = B_LEFT_CHUNKS * CHUNK
    kp = jnp.pad(kh, ((0, 0), (pad, 0), (0, 0), (0, 0)))
    vp = jnp.pad(vh, ((0, 0), (pad, 0), (0, 0), (0, 0)))
    band_idx = (jnp.arange(nc) * CHUNK)[:, None] + jnp.arange(B_BAND)[None, :]
    kb = kp[:, band_idx]
    vb = vp[:, band_idx]
    qc = qh.reshape(bsz, nc, CHUNK, B_HEADS, B_HD)
    scores = jnp.einsum('bnqhd,bnkhd->bnhqk', qc, kb) * (B_HD ** -0.5)
    rel = (pad + jnp.arange(CHUNK))[:, None] - jnp.arange(B_BAND)[None, :]
    bias = rel_bias.astype(f32)[:, jnp.clip(rel, -MAX_REL, MAX_REL) + MAX_REL]
    valid = band_idx >= pad
    scores = jnp.where(valid[None, :, None, None, :], scores + bias[None, None], -1e30)
    probs = jax.nn.softmax(scores, axis=-1)
    o = jnp.einsum('bnhqk,bnkhd->bnqhd', probs, vb)
    return o.reshape(bsz, seq, B_WIDTH).astype(q.dtype)


def setup_inputs(seed: int = 0) -> dict:
    key = jax.random.key(seed)
    ks = jax.random.split(key, 24)
    f32 = jnp.float32

    def nrm(k, shape, scale):
        return jax.random.normal(k, shape, f32) * scale

    def gain(k, shape):
        return 1.0 + 0.02 * jax.random.normal(k, shape, f32)

    return {
        "x": nrm(ks[0], (BATCH, SEQ, D_MODEL), 1.0),
        "p": nrm(ks[1], (DEPTH, BATCH, SEQ, PLE_DIM), 1.0),
        "norm_mix_g": gain(ks[2], (DEPTH, D_MODEL)),
        "w_in": nrm(ks[3], (DEPTH, D_MODEL, D_IN), D_MODEL ** -0.5),
        "hgrn_lb_logits": nrm(ks[4], (DEPTH, A_HEADS * A_DK), 0.5),
        "hgrn_onorm_g": gain(ks[5], (DEPTH, A_DV)),
        "attn_qnorm_g": gain(ks[6], (DEPTH, B_HD)),
        "attn_knorm_g": gain(ks[7], (DEPTH, B_HD)),
        "attn_rel_bias": nrm(ks[8], (DEPTH, B_HEADS, N_REL), 0.3),
        "w_branch_a": nrm(ks[9], (DEPTH, A_WIDTH, D_MODEL), A_WIDTH ** -0.5),
        "w_branch_b": nrm(ks[10], (DEPTH, B_WIDTH, D_MODEL), B_WIDTH ** -0.5),
        "w_out": nrm(ks[11], (DEPTH, D_MODEL, D_MODEL), 0.5 * D_MODEL ** -0.5),
        "norm_ffn_g": gain(ks[12], (DEPTH, D_MODEL)),
        "w_ffn_gate": nrm(ks[13], (DEPTH, D_MODEL, D_FF), D_MODEL ** -0.5),
        "w_ffn_up": nrm(ks[14], (DEPTH, D_MODEL, D_FF), D_MODEL ** -0.5),
        "w_ffn_down": nrm(ks[15], (DEPTH, D_FF, D_MODEL), 0.5 * D_FF ** -0.5),
        "norm_ple_g": gain(ks[16], (DEPTH, D_MODEL)),
        "w_ple_gate": nrm(ks[17], (DEPTH, D_MODEL, D_MODEL), D_MODEL ** -0.5),
        "w_ple_proj": nrm(ks[18], (DEPTH, PLE_DIM, D_MODEL), 0.5 * PLE_DIM ** -0.5),
    }


def reference(x, p, norm_mix_g, w_in, hgrn_lb_logits, hgrn_onorm_g, attn_qnorm_g, attn_knorm_g,
              attn_rel_bias, w_branch_a, w_branch_b, w_out, norm_ffn_g, w_ffn_gate, w_ffn_up,
              w_ffn_down, norm_ple_g, w_ple_gate, w_ple_proj):
    lb_soft = jax.nn.softmax(hgrn_lb_logits.astype(jnp.float32), axis=0)
    lb_cum = jnp.cumsum(lb_soft, axis=0)
    lower_bounds = lb_cum - lb_cum[0:1]
    split_at = [int(s) for s in np.cumsum(IN_SIZES)[:-1]]

    for li in range(DEPTH):
        h = rmsnorm(x, norm_mix_g[li])
        z = h @ w_in[li]
        qa, fa, ia, ga, qb, kb, vb, gate_a, gate_b = jnp.split(z, split_at, axis=-1)
        oa = hgrn2_mixer(qa, fa, ia, ga, lower_bounds[li], hgrn_onorm_g[li])
        ob = band_attention(qb, kb, vb, attn_qnorm_g[li], attn_knorm_g[li], attn_rel_bias[li])
        merged = (jax.nn.sigmoid(gate_a) * (oa @ w_branch_a[li])
                  + jax.nn.sigmoid(gate_b) * (ob @ w_branch_b[li]))
        x = x + merged @ w_out[li]
        h2 = rmsnorm(x, norm_ffn_g[li])
        x = x + (jax.nn.silu(h2 @ w_ffn_gate[li]) * (h2 @ w_ffn_up[li])) @ w_ffn_down[li]
        h3 = rmsnorm(x, norm_ple_g[li])
        x = x + jax.nn.sigmoid(h3 @ w_ple_gate[li]) * (p[li].astype(x.dtype) @ w_ple_proj[li])
    return x
```

```cpp
#include <hip/hip_runtime.h>
#include <hip/hip_cooperative_groups.h>
#include <cstdio>
#include <cstdint>
namespace cg = cooperative_groups;
__device__ __forceinline__ float shx(float v, int lane, int mask) { return __builtin_bit_cast(float, __builtin_amdgcn_ds_bpermute((lane ^ mask) << 2, __builtin_bit_cast(int, v))); }
__device__ __forceinline__ float shsrc(float v, int src) { return __builtin_bit_cast(float, __builtin_amdgcn_ds_bpermute(src << 2, __builtin_bit_cast(int, v))); }
__device__ __forceinline__ int lane_id_v() { int r; asm volatile("v_mbcnt_lo_u32_b32 %0, -1, 0" : "=v"(r)); asm volatile("v_mbcnt_hi_u32_b32 %0, -1, %0" : "+v"(r)); return r; }
namespace pg8 {
#define PG8_LAS __attribute__((address_space(3)))
typedef unsigned short bf16_t;
typedef short bf16x8 __attribute__((ext_vector_type(8)));
typedef float f32x4 __attribute__((ext_vector_type(4)));
typedef unsigned u32x4 __attribute__((ext_vector_type(4)));
constexpr int BM = 256, BK = 64, HALF = 128, HTB = HALF * BK * 2  , STAGE_BYTES = 8 * HTB, NXCD = 8, WGM = 8;

__host__ __device__ __forceinline__ int lds_byte(int r, int c) { const int st = (r >> 4) * 2 + (c >> 5), rr = r & 15, cc = c & 31, ob = rr * 64 + cc * 2; return st * 1024 + (ob ^ (((ob >> 9) & 1) << 5)); }
__host__ __device__ __forceinline__ void stage_rc(int b, int& R, int& C) { const int st = b / 1024, sb = b % 1024, swz = sb ^ (((sb >> 9) & 1) << 5); R = (st >> 1) * 16 + swz / 64; C = (st & 1) * 32 + (swz % 64) / 2; }
__host__ __device__ __forceinline__ int perm32(int rho) { const int n = rho >> 4, i = rho & 15; return 8 * (i >> 2) + 4 * n + (i & 3); }

struct Unit { int pm, pn; };
struct Gemm { const bf16_t* A; const bf16_t* Bt; int M, N, K, lda, ldb; };

struct StaticOrder {
    int nM, nN, nwg, G, c;
    __host__ __device__ void init(int M, int N, int G_, int c_) { nM = M / BM; nN = N / BM; nwg = nM * nN; G = G_; c = c_; }
    __host__ __device__ bool next(int i, Unit& u) const {
        const long L = (long)i * G + c; if (L >= nwg) return false;
        int wgid = (int)L; { const int q = nwg / NXCD, r = nwg % NXCD, xcd = wgid % NXCD, off = wgid / NXCD; wgid = (xcd < r ? xcd * (q + 1) : r * (q + 1) + (xcd - r) * q) + off; }
        const int nig = WGM * nN, gid = wgid / nig, fm = gid * WGM, gsz = (nM - fm) < WGM ? (nM - fm) : WGM;
        u.pm = fm + ((wgid % nig) % gsz); u.pn = (wgid % nig) / gsz; return true;
    }
    __device__ __forceinline__ void a_ready(const Unit&) const {}
    __device__ __forceinline__ void done(const Unit&) const {}
};

typedef float f32x2_cv __attribute__((ext_vector_type(2))); typedef __bf16 bf16x2_cv __attribute__((ext_vector_type(2)));
__device__ __forceinline__ unsigned cvt_pk_bf16(float lo, float hi) { f32x2_cv v = {lo, hi}; bf16x2_cv b = __builtin_convertvector(v, bf16x2_cv); return __builtin_bit_cast(unsigned, b); }
#ifndef MERGED_HOOK_T
#define MERGED_HOOK_T 8
#endif
typedef _Float16 f16_t;
typedef float f32x2 __attribute__((ext_vector_type(2)));
typedef _Float16 f16x2 __attribute__((ext_vector_type(2)));
__device__ __forceinline__ float bf2f(unsigned h) { return __uint_as_float(h << 16); }
__device__ __forceinline__ float fsigmoid(float z) { return __builtin_amdgcn_rcpf(1.f + __expf(-z)); }
__device__ __forceinline__ u32x4 pack8(const f32x4 a, const f32x4 b) { u32x4 w; w.x = cvt_pk_bf16(a[0], a[1]); w.y = cvt_pk_bf16(a[2], a[3]); w.z = cvt_pk_bf16(b[0], b[1]); w.w = cvt_pk_bf16(b[2], b[3]); return w; }
__device__ __forceinline__ void unpack8(const u32x4 w, f32x4& a, f32x4& b) {
    a[0] = __uint_as_float(w.x << 16); a[1] = __uint_as_float(w.x & 0xffff0000u); a[2] = __uint_as_float(w.y << 16); a[3] = __uint_as_float(w.y & 0xffff0000u);
    b[0] = __uint_as_float(w.z << 16); b[1] = __uint_as_float(w.z & 0xffff0000u); b[2] = __uint_as_float(w.w << 16); b[3] = __uint_as_float(w.w & 0xffff0000u); }
__device__ __forceinline__ unsigned pk_f16(float lo, float hi) { f32x2 v = {lo, hi}; f16x2 h = __builtin_convertvector(v, f16x2); return __builtin_bit_cast(unsigned, h); }
__device__ __forceinline__ float row_rstd(const float* ssq, int row, int fr, int fq) {
    const f32x4 a = *(const f32x4*)(ssq + (size_t)row * 16 + 4 * fq);
    float s = (a[0] + a[1]) + (a[2] + a[3]);
    s += shx(s, fq * 16 + fr, 16); s += shx(s, fq * 16 + fr, 32);
    return __builtin_amdgcn_rsqf(s * (1.0f / 1024.0f) + 1e-6f);
}

struct EpiIn {
    static constexpr bool PERM = true, AFTER_DRAIN = false; static constexpr int HOOK_T = 0;
    const float* ssq; const float* lb; const float* gq; const float* gk;
    bf16_t* RQ; f16_t* RLF; bf16_t* RI; bf16_t* ROAB; bf16_t* RAK; bf16_t* RAVT;
    __device__ __forceinline__ void mid(f32x4 (&acc)[2][2][4][2], const Unit& u, int wr, int wc, int fr, int fq) const {}
    __device__ __forceinline__ void operator()(const f32x4 (&acc)[2][2][4][2], const Unit& u, int wr, int wc, int fr, int fq) const {
        const int row0 = u.pm * BM + wr * 64 + fr;
        const int seg = u.pn >> 1;
        const int cseg = (u.pn & 1) * 256 + wc * 32 + 8 * fq;
        if (seg == 0 || seg == 2) {
            bf16_t* O = seg == 0 ? RQ : RI;
#pragma unroll
            for (int ai = 0; ai < 2; ++ai)
#pragma unroll
                for (int m = 0; m < 4; ++m) { const int row = row0 + ai * HALF + m * 16; const float rs = row_rstd(ssq, row, fr, fq);
#pragma unroll
                    for (int bj = 0; bj < 2; ++bj) *(u32x4*)(O + (size_t)row * 512 + cseg + bj * HALF) = pack8(acc[ai][bj][m][0] * rs, acc[ai][bj][m][1] * rs); }
        } else if (seg == 1) {
            f32x4 l0[2], l1[2];
#pragma unroll
            for (int bj = 0; bj < 2; ++bj) { l0[bj] = *(const f32x4*)(lb + cseg + bj * HALF); l1[bj] = *(const f32x4*)(lb + cseg + bj * HALF + 4); }
#pragma unroll
            for (int ai = 0; ai < 2; ++ai)
#pragma unroll
                for (int m = 0; m < 4; ++m) { const int row = row0 + ai * HALF + m * 16; const float rs = row_rstd(ssq, row, fr, fq);
#pragma unroll
                    for (int bj = 0; bj < 2; ++bj) { float o[8];
#pragma unroll
                        for (int e = 0; e < 4; ++e) { const float z0 = acc[ai][bj][m][0][e] * rs, z1 = acc[ai][bj][m][1][e] * rs;
                            const float f0 = l0[bj][e] + (1.f - l0[bj][e]) * fsigmoid(z0), f1 = l1[bj][e] + (1.f - l1[bj][e]) * fsigmoid(z1);
                            o[e] = __logf(fmaxf(f0, 1e-30f)); o[4 + e] = __logf(fmaxf(f1, 1e-30f)); }
                        u32x4 w; w.x = pk_f16(o[0], o[1]); w.y = pk_f16(o[2], o[3]); w.z = pk_f16(o[4], o[5]); w.w = pk_f16(o[6], o[7]);
                        *(u32x4*)(RLF + (size_t)row * 512 + cseg + bj * HALF) = w; } }
        } else if (seg == 3) {
#pragma unroll
            for (int ai = 0; ai < 2; ++ai)
#pragma unroll
                for (int m = 0; m < 4; ++m) { const int row = row0 + ai * HALF + m * 16; const float rs = row_rstd(ssq, row, fr, fq);
#pragma unroll
                    for (int bj = 0; bj < 2; ++bj) { f32x4 v0 = acc[ai][bj][m][0] * rs, v1 = acc[ai][bj][m][1] * rs;
#pragma unroll
                        for (int e = 0; e < 4; ++e) { v0[e] = v0[e] * fsigmoid(v0[e]); v1[e] = v1[e] * fsigmoid(v1[e]); }
                        *(u32x4*)(ROAB + (size_t)row * 1024 + cseg + bj * HALF) = pack8(v0, v1); } }
        } else if (seg == 4 || seg == 5) {
            const float* gg = seg == 4 ? gq : gk; const float sc = seg == 4 ? 0.18033688011112042f : 1.0f;
            f32x4 g0[2], g1[2];
#pragma unroll
            for (int bj = 0; bj < 2; ++bj) { g0[bj] = *(const f32x4*)(gg + 32 * bj + 8 * fq) * sc; g1[bj] = *(const f32x4*)(gg + 32 * bj + 8 * fq + 4) * sc; }
            const int head = (u.pn & 1) * 4 + wc;
            bf16_t* O = seg == 4 ? (ROAB + 512) : RAK; const int ld = seg == 4 ? 1024 : 512;
#pragma unroll
            for (int ai = 0; ai < 2; ++ai)
#pragma unroll
                for (int m = 0; m < 4; ++m) { const int row = row0 + ai * HALF + m * 16; const float rs = row_rstd(ssq, row, fr, fq);
                    float s = 0.f;
#pragma unroll
                    for (int bj = 0; bj < 2; ++bj)
#pragma unroll
                        for (int n = 0; n < 2; ++n) { const f32x4 x = acc[ai][bj][m][n]; s += (x[0] * x[0] + x[1] * x[1]) + (x[2] * x[2] + x[3] * x[3]); }
                    s += shx(s, fq * 16 + fr, 16); s += shx(s, fq * 16 + fr, 32);
                    const float rr = rs * __builtin_amdgcn_rsqf(rs * rs * s * (1.0f / 64.0f) + 1e-6f);
                    if (seg == 4) {
#pragma unroll
                        for (int bj = 0; bj < 2; ++bj) *(u32x4*)(O + (size_t)row * ld + head * 64 + 32 * bj + 8 * fq) = pack8(acc[ai][bj][m][0] * rr * g0[bj], acc[ai][bj][m][1] * rr * g1[bj]);
                    } else {
                        const int b = row >> 12, t = row & 4095, kc = t >> 6, key = t & 63, kh = key >> 5, p = key & 31, r16 = p & 15;
                        const int mrow = (r16 & 3) + 4 * (p >> 4) + 8 * (r16 >> 2);
                        bf16_t* kb_ = RAK + ((size_t)((b * 8 + head) * 64 + kc)) * 4096;
#pragma unroll
                        for (int bj = 0; bj < 2; ++bj) { const int d0 = 2 * bj + (fq >> 1), hi = fq & 1;
                            *(u32x4*)(kb_ + ((kh * 4 + d0) * 64 + hi * 32 + mrow) * 8) = pack8(acc[ai][bj][m][0] * rr * g0[bj], acc[ai][bj][m][1] * rr * g1[bj]); } } }
        } else {
#pragma unroll
            for (int ai = 0; ai < 2; ++ai)
#pragma unroll
                for (int m = 0; m < 4; ++m) { const int row = row0 + ai * HALF + m * 16; const float rs = row_rstd(ssq, row, fr, fq);
                    const int b = row >> 12, t = row & 4095, kc = t >> 6, tt = t & 63, kh = tt >> 5, hi = (tt >> 4) & 1, blk = (tt >> 3) & 1, j = tt & 7;
#pragma unroll
                    for (int bj = 0; bj < 2; ++bj) { const int col = cseg + bj * HALF; const int h = col >> 6, d = col & 63, dh = d >> 5;
                        bf16_t* p = RAVT + ((size_t)((b * 8 + h) * 64 + kc)) * 4096 + ((((dh * 2 + kh) * 2 + blk) * 64 + hi * 32 + (d & 31)) * 8 + j);
                        const u32x4 w = pack8(acc[ai][bj][m][0] * rs, acc[ai][bj][m][1] * rs);
                        p[0 * 8] = (bf16_t)(w.x & 0xffffu); p[1 * 8] = (bf16_t)(w.x >> 16); p[2 * 8] = (bf16_t)(w.y & 0xffffu); p[3 * 8] = (bf16_t)(w.y >> 16);
                        p[4 * 8] = (bf16_t)(w.z & 0xffffu); p[5 * 8] = (bf16_t)(w.z >> 16); p[6 * 8] = (bf16_t)(w.w & 0xffffu); p[7 * 8] = (bf16_t)(w.w >> 16); } }
        }
    }
};
struct EpiGate {
    static constexpr bool PERM = true, AFTER_DRAIN = false; static constexpr int HOOK_T = 0;
    const float* ssq; bf16_t* GA; bf16_t* GB;
    __device__ __forceinline__ void mid(f32x4 (&acc)[2][2][4][2], const Unit& u, int wr, int wc, int fr, int fq) const {}
    __device__ __forceinline__ void operator()(const f32x4 (&acc)[2][2][4][2], const Unit& u, int wr, int wc, int fr, int fq) const {
        const int row0 = u.pm * BM + wr * 64 + fr;
        bf16_t* O = (u.pn < 4 ? GA : GB) + (u.pn & 3) * 256 + wc * 32 + 8 * fq;
#pragma unroll
        for (int ai = 0; ai < 2; ++ai)
#pragma unroll
            for (int m = 0; m < 4; ++m) { const int row = row0 + ai * HALF + m * 16; const float rs = row_rstd(ssq, row, fr, fq);
#pragma unroll
                for (int bj = 0; bj < 2; ++bj) { f32x4 v0 = acc[ai][bj][m][0] * rs, v1 = acc[ai][bj][m][1] * rs;
#pragma unroll
                    for (int e = 0; e < 4; ++e) { v0[e] = fsigmoid(v0[e]); v1[e] = fsigmoid(v1[e]); }
                    *(u32x4*)(O + (size_t)row * 1024 + bj * HALF) = pack8(v0, v1); } }
    }
};
template <int MODE> struct EpiGated {
    static constexpr bool PERM = true, AFTER_DRAIN = false; static constexpr int HOOK_T = 0;
    const bf16_t* Gt; bf16_t* O;
    __device__ __forceinline__ void mid(f32x4 (&acc)[2][2][4][2], const Unit& u, int wr, int wc, int fr, int fq) const {}
    __device__ __forceinline__ void operator()(const f32x4 (&acc)[2][2][4][2], const Unit& u, int wr, int wc, int fr, int fq) const {
        const int row0 = u.pm * BM + wr * 64 + fr; const int col0 = u.pn * BM + wc * 32 + 8 * fq;
#pragma unroll
        for (int ai = 0; ai < 2; ++ai)
#pragma unroll
            for (int m = 0; m < 4; ++m) { const size_t ro = (size_t)(row0 + ai * HALF + m * 16) * 1024 + col0;
#pragma unroll
                for (int bj = 0; bj < 2; ++bj) { f32x4 g0, g1; unpack8(*(const u32x4*)(Gt + ro + bj * HALF), g0, g1);
                    f32x4 v0 = acc[ai][bj][m][0] * g0, v1 = acc[ai][bj][m][1] * g1;
                    if (MODE == 1) { f32x4 p0, p1; unpack8(*(const u32x4*)(O + ro + bj * HALF), p0, p1); v0 += p0; v1 += p1; }
                    *(u32x4*)(O + ro + bj * HALF) = pack8(v0, v1); }
                if (m & 1) asm volatile("" ::: "memory"); }
    }
};
struct EpiMerged {
    static constexpr bool PERM = true, AFTER_DRAIN = false; static constexpr int HOOK_T = 8;
    const bf16_t* GA; const bf16_t* GB; bf16_t* O;
    __device__ __forceinline__ void mid(f32x4 (&acc)[2][2][4][2], const Unit& u, int wr, int wc, int fr, int fq) const {
        const int row0 = u.pm * BM + wr * 64 + fr; const int col0 = u.pn * BM + wc * 32 + 8 * fq;
#pragma unroll
        for (int ai = 0; ai < 2; ++ai)
#pragma unroll
            for (int m = 0; m < 4; ++m) { const size_t ro = (size_t)(row0 + ai * HALF + m * 16) * 1024 + col0;
#pragma unroll
                for (int bj = 0; bj < 2; ++bj) { f32x4 a0, a1, b0, b1; unpack8(*(const u32x4*)(GA + ro + bj * HALF), a0, a1); unpack8(*(const u32x4*)(GB + ro + bj * HALF), b0, b1);
#pragma unroll
                    for (int e = 0; e < 4; ++e) { acc[ai][bj][m][0][e] *= a0[e] * __builtin_amdgcn_rcpf(fmaxf(b0[e], 1e-20f)); acc[ai][bj][m][1][e] *= a1[e] * __builtin_amdgcn_rcpf(fmaxf(b1[e], 1e-20f)); } }
                if (m & 1) asm volatile("" ::: "memory"); }
    }
    __device__ __forceinline__ void operator()(const f32x4 (&acc)[2][2][4][2], const Unit& u, int wr, int wc, int fr, int fq) const {
        const int row0 = u.pm * BM + wr * 64 + fr; const int col0 = u.pn * BM + wc * 32 + 8 * fq;
#pragma unroll
        for (int ai = 0; ai < 2; ++ai)
#pragma unroll
            for (int m = 0; m < 4; ++m) { const size_t ro = (size_t)(row0 + ai * HALF + m * 16) * 1024 + col0;
#pragma unroll
                for (int bj = 0; bj < 2; ++bj) { f32x4 b0, b1; unpack8(*(const u32x4*)(GB + ro + bj * HALF), b0, b1);
#pragma unroll
                    for (int e = 0; e < 4; ++e) { b0[e] = fmaxf(b0[e], 1e-20f); b1[e] = fmaxf(b1[e], 1e-20f); }
                    *(u32x4*)(O + ro + bj * HALF) = pack8(acc[ai][bj][m][0] * b0, acc[ai][bj][m][1] * b1); }
                if (m & 1) asm volatile("" ::: "memory"); }
    }
};
struct EpiBf {
    static constexpr bool PERM = true, AFTER_DRAIN = false; static constexpr int HOOK_T = 0;
    bf16_t* O; int ldc;
    __device__ __forceinline__ void mid(f32x4 (&acc)[2][2][4][2], const Unit& u, int wr, int wc, int fr, int fq) const {}
    __device__ __forceinline__ void operator()(const f32x4 (&acc)[2][2][4][2], const Unit& u, int wr, int wc, int fr, int fq) const {
        const int row0 = u.pm * BM + wr * 64 + fr; const int col0 = u.pn * BM + wc * 32 + 8 * fq;
#pragma unroll
        for (int ai = 0; ai < 2; ++ai)
#pragma unroll
            for (int m = 0; m < 4; ++m)
#pragma unroll
                for (int bj = 0; bj < 2; ++bj) *(u32x4*)(O + (size_t)(row0 + ai * HALF + m * 16) * ldc + col0 + bj * HALF) = pack8(acc[ai][bj][m][0], acc[ai][bj][m][1]);
    }
};
template <int MODE> struct EpiRes {
    static constexpr bool PERM = true, AFTER_DRAIN = false; static constexpr int HOOK_T = 0;
    const bf16_t* XI; float* out32; bf16_t* XB; float* ssq_out; const float* ssq_in;
    __device__ __forceinline__ void mid(f32x4 (&acc)[2][2][4][2], const Unit& u, int wr, int wc, int fr, int fq) const {}
    __device__ __forceinline__ void operator()(const f32x4 (&acc)[2][2][4][2], const Unit& u, int wr, int wc, int fr, int fq) const {
        const int row0 = u.pm * BM + wr * 64 + fr; const int col0 = u.pn * BM + wc * 32 + 8 * fq;
#pragma unroll
        for (int ai = 0; ai < 2; ++ai)
#pragma unroll
            for (int m = 0; m < 4; ++m) { const int row = row0 + ai * HALF + m * 16; const size_t ro = (size_t)row * 1024 + col0;
                float rs = 1.f; if (MODE == 1) rs = row_rstd(ssq_in, row, fr, fq);
                float s = 0.f;
#pragma unroll
                for (int bj = 0; bj < 2; ++bj) { f32x4 v0, v1; unpack8(*(const u32x4*)(XI + ro + bj * HALF), v0, v1);
                    if (MODE == 1) { f32x4 u0, u1; unpack8(*(const u32x4*)(XB + ro + bj * HALF), u0, u1);
#pragma unroll
                        for (int e = 0; e < 4; ++e) { v0[e] += fsigmoid(acc[ai][bj][m][0][e] * rs) * u0[e]; v1[e] += fsigmoid(acc[ai][bj][m][1][e] * rs) * u1[e]; }
                    } else { v0 += acc[ai][bj][m][0]; v1 += acc[ai][bj][m][1]; }
                    if (out32) { *(f32x4*)(out32 + ro + bj * HALF) = v0; *(f32x4*)(out32 + ro + bj * HALF + 4) = v1; }
                    *(u32x4*)(XB + ro + bj * HALF) = pack8(v0, v1);
                    s += ((v0[0] * v0[0] + v0[1] * v0[1]) + (v0[2] * v0[2] + v0[3] * v0[3])) + ((v1[0] * v1[0] + v1[1] * v1[1]) + (v1[2] * v1[2] + v1[3] * v1[3])); }
                s += shx(s, fq * 16 + fr, 16); s += shx(s, fq * 16 + fr, 32);
                if (fq == 0) ssq_out[(size_t)row * 16 + u.pn * 4 + wc] = s;
                if (m & 1) asm volatile("" ::: "memory"); }
    }
};
struct EpiFfnUp {
    static constexpr bool PERM = true, AFTER_DRAIN = false; static constexpr int HOOK_T = 0;
    const float* ssq; bf16_t* H;
    __device__ __forceinline__ void mid(f32x4 (&acc)[2][2][4][2], const Unit& u, int wr, int wc, int fr, int fq) const {}
    __device__ __forceinline__ void operator()(const f32x4 (&acc)[2][2][4][2], const Unit& u, int wr, int wc, int fr, int fq) const {
        const int row0 = u.pm * BM + wr * 64 + fr; const int col0 = u.pn * HALF + wc * 32 + 8 * fq;
#pragma unroll
        for (int ai = 0; ai < 2; ++ai)
#pragma unroll
            for (int m = 0; m < 4; ++m) { const int row = row0 + ai * HALF + m * 16; const float rs = row_rstd(ssq, row, fr, fq);
                f32x4 v0 = acc[ai][0][m][0] * rs, v1 = acc[ai][0][m][1] * rs; const f32x4 w0 = acc[ai][1][m][0] * rs, w1 = acc[ai][1][m][1] * rs;
#pragma unroll
                for (int e = 0; e < 4; ++e) { v0[e] = v0[e] * fsigmoid(v0[e]) * w0[e]; v1[e] = v1[e] * fsigmoid(v1[e]) * w1[e]; }
                *(u32x4*)(H + (size_t)row * 2816 + col0) = pack8(v0, v1); }
    }
};

template <class Epi, class Sched, bool ALIGN_EPI = false, bool SP2 = false>
__device__ __forceinline__ void gemm_phase(PG8_LAS unsigned char* lds, const Gemm g, const Sched& S, const Epi& E, int tid_in) {
    int tid_ = tid_in; asm volatile("" : "+v"(tid_));
    const int tid = tid_, wid = __builtin_amdgcn_readfirstlane(tid >> 6), lane = tid & 63, wr = wid >> 2, wc = wid & 3, fr = lane & 15, fq = lane >> 4;
    int K_ = g.K; asm volatile("" : "+s"(K_));
    const int K = K_, nt = K / BK;
    unsigned voffA[2], voffB[2];
#pragma unroll
    for (int i = 0; i < 2; ++i) { int R, C; stage_rc(tid * 16 + i * 8192, R, C); const int Rb = Epi::PERM ? ((R & ~31) + perm32(R & 31)) : R;
        voffA[i] = (unsigned)(R * g.lda + C) * 2u; voffB[i] = (unsigned)(Rb * g.ldb + C) * 2u; }
    const size_t kstep = (size_t)(BK * 2);
    const size_t hstepA = (size_t)HALF * g.lda * 2, hstepB = (size_t)HALF * g.ldb * 2;
    const size_t tstepA = 2 * hstepA, tstepB = 2 * hstepB;
    const unsigned ldsw = (unsigned)wid * 1024u;
    const int aoff = lds_byte(wr * 64 + fr, fq * 8), boff = lds_byte(wc * 32 + fr, fq * 8);
#define PG8_SA(b, h) (((b) * 2 + (h)) * HTB)
#define PG8_SB(b, h) ((4 + (b) * 2 + (h)) * HTB)
#define PG8_STAGE(bufoff, gbase, voff) do { _Pragma("unroll") for (int _i = 0; _i < 2; ++_i) \
        __builtin_amdgcn_global_load_lds((const unsigned*)((const char*)(gbase) + (voff)[_i]), (PG8_LAS unsigned*)(lds + (bufoff) + ldsw + _i * 8192), 16, 0, 0); } while (0)
#define PG8_LDA(dst, b, h) do { _Pragma("unroll") for (int m = 0; m < 4; ++m) _Pragma("unroll") for (int k = 0; k < 2; ++k) dst[m][k] = *(const PG8_LAS bf16x8*)(lds + PG8_SA(b, h) + aoff + m * 2048 + k * 1024); } while (0)
#define PG8_LDB(dst, b, h) do { _Pragma("unroll") for (int n = 0; n < 2; ++n) _Pragma("unroll") for (int k = 0; k < 2; ++k) dst[n][k] = *(const PG8_LAS bf16x8*)(lds + PG8_SB(b, h) + boff + n * 2048 + k * 1024); } while (0)
#define PG8_MMA(ai, bj, At, Bt) do { __builtin_amdgcn_s_setprio(1); _Pragma("unroll") for (int m = 0; m < 4; ++m) _Pragma("unroll") for (int n = 0; n < 2; ++n) _Pragma("unroll") for (int k = 0; k < 2; ++k) \
        acc[ai][bj][m][n] = __builtin_amdgcn_mfma_f32_16x16x32_bf16(Bt[n][k], At[m][k], acc[ai][bj][m][n], 0, 0, 0); __builtin_amdgcn_s_setprio(0); } while (0)
#define PG8_WAIT_V(n) asm volatile("s_waitcnt vmcnt(" #n ")" ::: "memory")
#define PG8_WAIT_L(n) asm volatile("s_waitcnt lgkmcnt(" #n ")" ::: "memory")
#define PG8_BAR __builtin_amdgcn_s_barrier()
#define PG8_SCHED __builtin_amdgcn_sched_barrier(0)
    Unit cur, nxt; int ui = 0;
    if (!S.next(0, cur)) return;
    f32x4 acc[2][2][4][2];
#pragma unroll
    for (int a = 0; a < 2; ++a)
#pragma unroll
        for (int b = 0; b < 2; ++b)
#pragma unroll
            for (int m = 0; m < 4; ++m)
#pragma unroll
                for (int n = 0; n < 2; ++n) acc[a][b][m][n] = (f32x4){0.f, 0.f, 0.f, 0.f};
    bf16x8 At[4][2], B0[2][2], B1[2][2];
    const char* cA = (const char*)g.A + (size_t)cur.pm * tstepA; const char* cB = (const char*)g.Bt + (size_t)cur.pn * tstepB;
    S.a_ready(cur);
    if constexpr (SP2) {
        PG8_STAGE(PG8_SB(0, 0), cB, voffB); PG8_STAGE(PG8_SB(0, 1), cB + hstepB, voffB); PG8_STAGE(PG8_SA(0, 0), cA, voffA); PG8_STAGE(PG8_SA(0, 1), cA + hstepA, voffA);
        if (wr == 1) PG8_BAR;
        PG8_WAIT_V(2); PG8_BAR;
        PG8_STAGE(PG8_SB(1, 0), cB + kstep, voffB); PG8_STAGE(PG8_SA(1, 0), cA + kstep, voffA); PG8_STAGE(PG8_SB(1, 1), cB + hstepB + kstep, voffB);
        PG8_WAIT_V(6); PG8_BAR;
    } else {
        PG8_STAGE(PG8_SB(0, 0), cB, voffB); PG8_STAGE(PG8_SA(0, 0), cA, voffA); PG8_STAGE(PG8_SB(0, 1), cB + hstepB, voffB); PG8_STAGE(PG8_SA(0, 1), cA + hstepA, voffA);
        if (wr == 1) PG8_BAR;
        PG8_WAIT_V(4); PG8_BAR;
        PG8_STAGE(PG8_SB(1, 0), cB + kstep, voffB); PG8_STAGE(PG8_SA(1, 0), cA + kstep, voffA); PG8_STAGE(PG8_SB(1, 1), cB + hstepB + kstep, voffB);
        PG8_WAIT_V(6); PG8_BAR;
    }
    for (;;) {
        const bool has_next = S.next(ui + 1, nxt);
        const char* nA = has_next ? (const char*)g.A + (size_t)nxt.pm * tstepA : cA; const char* nB = has_next ? (const char*)g.Bt + (size_t)nxt.pn * tstepB : cB;
        for (int t = 0; t < nt; t += 2) {
            if constexpr (Epi::HOOK_T > 0) { if (t == Epi::HOOK_T) { int frx = fr; asm volatile("" : "+v"(frx)); E.mid(acc, cur, wr, wc, frx, fq); } }
            const bool last = (t == nt - 2);
            const char* a1 = cA + (size_t)(t + 1) * kstep;
            const char* a2 = last ? nA : cA + (size_t)(t + 2) * kstep; const char* b2 = last ? nB : cB + (size_t)(t + 2) * kstep;
            const char* a3 = a2 + kstep; const char* b3 = b2 + kstep;
            if (last && has_next) S.a_ready(nxt);
            if constexpr (SP2) {
            PG8_LDB(B0, 0, 0); PG8_LDB(B1, 0, 1); PG8_SCHED; PG8_LDA(At, 0, 0); PG8_STAGE(PG8_SA(1, 1), a1 + hstepA, voffA);
            PG8_WAIT_V(8); PG8_WAIT_L(0); PG8_BAR; PG8_MMA(0, 0, At, B0); PG8_MMA(0, 1, At, B1); PG8_BAR; PG8_SCHED;
            PG8_LDA(At, 0, 1); PG8_STAGE(PG8_SB(0, 0), b2, voffB); PG8_STAGE(PG8_SB(0, 1), b2 + hstepB, voffB); PG8_STAGE(PG8_SA(0, 0), a2, voffA);
            PG8_WAIT_V(8); PG8_WAIT_L(0); PG8_BAR; PG8_MMA(1, 0, At, B0); PG8_MMA(1, 1, At, B1); PG8_BAR; PG8_SCHED;
            PG8_LDB(B0, 1, 0); PG8_LDB(B1, 1, 1); PG8_SCHED; PG8_LDA(At, 1, 0); PG8_STAGE(PG8_SA(0, 1), a2 + hstepA, voffA);
            PG8_WAIT_V(8); PG8_WAIT_L(0); PG8_BAR; PG8_MMA(0, 0, At, B0); PG8_MMA(0, 1, At, B1); PG8_BAR; PG8_SCHED;
            PG8_LDA(At, 1, 1); PG8_STAGE(PG8_SB(1, 0), b3, voffB); PG8_STAGE(PG8_SB(1, 1), b3 + hstepB, voffB); PG8_STAGE(PG8_SA(1, 0), a3, voffA);
            PG8_WAIT_V(8); PG8_WAIT_L(0); PG8_BAR; PG8_MMA(1, 0, At, B0); PG8_MMA(1, 1, At, B1); PG8_BAR; PG8_SCHED;
            } else {
            PG8_LDB(B0, 0, 0); PG8_SCHED; PG8_LDA(At, 0, 0); PG8_STAGE(PG8_SA(1, 1), a1 + hstepA, voffA);
            PG8_WAIT_L(8); PG8_BAR; PG8_WAIT_L(0); PG8_MMA(0, 0, At, B0); PG8_BAR; PG8_SCHED;
            PG8_LDB(B1, 0, 1); PG8_STAGE(PG8_SB(0, 0), b2, voffB);
            PG8_BAR; PG8_WAIT_L(0); PG8_MMA(0, 1, At, B1); PG8_BAR;
            PG8_LDA(At, 0, 1); PG8_STAGE(PG8_SA(0, 0), a2, voffA);
            PG8_BAR; PG8_WAIT_L(0); PG8_MMA(1, 0, At, B0); PG8_BAR; PG8_SCHED;
            PG8_STAGE(PG8_SB(0, 1), b2 + hstepB, voffB);
            PG8_WAIT_V(6); PG8_BAR; PG8_MMA(1, 1, At, B1); PG8_BAR;
            PG8_LDB(B0, 1, 0); PG8_SCHED; PG8_LDA(At, 1, 0); PG8_STAGE(PG8_SA(0, 1), a2 + hstepA, voffA);
            PG8_WAIT_L(8); PG8_BAR; PG8_WAIT_L(0); PG8_MMA(0, 0, At, B0); PG8_BAR; PG8_SCHED;
            PG8_LDB(B1, 1, 1); PG8_STAGE(PG8_SB(1, 0), b3, voffB);
            PG8_BAR; PG8_WAIT_L(0); PG8_MMA(0, 1, At, B1); PG8_BAR;
            PG8_LDA(At, 1, 1); PG8_STAGE(PG8_SA(1, 0), a3, voffA);
            PG8_BAR; PG8_WAIT_L(0); PG8_MMA(1, 0, At, B0); PG8_BAR; PG8_SCHED;
            PG8_STAGE(PG8_SB(1, 1), b3 + hstepB, voffB);
            PG8_WAIT_V(6); PG8_BAR; PG8_MMA(1, 1, At, B1); PG8_BAR;
            }
        }
        if constexpr (ALIGN_EPI) { if (wr == 0) PG8_BAR; }
        if constexpr (!Epi::AFTER_DRAIN) { int frx = fr; asm volatile("" : "+v"(frx)); E(acc, cur, wr, wc, frx, fq); S.done(cur); }
        if (!has_next) break;
#pragma unroll
        for (int a = 0; a < 2; ++a)
#pragma unroll
            for (int b = 0; b < 2; ++b)
#pragma unroll
                for (int m = 0; m < 4; ++m)
#pragma unroll
                    for (int n = 0; n < 2; ++n) acc[a][b][m][n] = (f32x4){0.f, 0.f, 0.f, 0.f};
        cur = nxt; cA = nA; cB = nB; ++ui;
        if constexpr (ALIGN_EPI) { if (wr == 1) PG8_BAR; }
    }
    PG8_WAIT_V(0);
    if constexpr (!ALIGN_EPI) { if (wr == 0) PG8_BAR; }
    PG8_BAR;
    if constexpr (Epi::AFTER_DRAIN) { E.fused(acc, cur, wr, wc, fr, fq, lds, wid, lane); S.done(cur); }
#undef PG8_SA
#undef PG8_SB
#undef PG8_STAGE
#undef PG8_LDA
#undef PG8_LDB
#undef PG8_MMA
#undef PG8_WAIT_V
#undef PG8_WAIT_L
#undef PG8_BAR
#undef PG8_SCHED
}
}

#define LAS __attribute__((address_space(3)))
typedef LAS unsigned char* ldsp;
typedef unsigned short bf16;
typedef _Float16 f16;
typedef float f32x4 __attribute__((ext_vector_type(4)));
typedef float f32x16 __attribute__((ext_vector_type(16)));
typedef short bf16x8 __attribute__((ext_vector_type(8)));
typedef unsigned u32x4 __attribute__((ext_vector_type(4)));
typedef unsigned u32x2 __attribute__((ext_vector_type(2)));

constexpr int T = 32768, DM = 1024, SEQ = 4096, DEPTH = 4, DFF = 2816, DIN = 5632;
constexpr size_t MiB = 1u << 20;
constexpr size_t WS_W0 = 2 * MiB, WS_WSTRIDE = 36 * MiB;
constexpr size_t WS_PB = 74 * MiB;
constexpr size_t WS_BX = 90 * MiB, WS_BU = 154 * MiB;
constexpr size_t WS_SSQA = 218 * MiB, WS_SSQB = 220 * MiB, WS_SSQC = 222 * MiB;
constexpr size_t WS_LB = 224 * MiB;
constexpr size_t WS_ADEC = 225 * MiB;
constexpr size_t WS_RQ = 226 * MiB, WS_RLF = 258 * MiB, WS_RI = 290 * MiB, WS_ROAB = 322 * MiB, WS_RAK = 386 * MiB, WS_RAVT = 418 * MiB, WS_RU = 450 * MiB;
constexpr size_t WS_GA = 226 * MiB, WS_GB = 450 * MiB, WS_MERGED = 386 * MiB, WS_HB = 226 * MiB;
constexpr size_t WS_END = 514 * MiB;
constexpr size_t WO_IN = 0, WO_AB = WO_IN + (size_t)DIN * 1024, WO_OUT = WO_AB + 1024 * 1024, WO_GU = WO_OUT + 1024 * 1024, WO_D = WO_GU + (size_t)DIN * 1024,
                 WO_PG = WO_D + (size_t)1024 * DFF, WO_PE = WO_PG + 1024 * 1024, WO_END = WO_PE + 1024 * 256;
static_assert(WO_END * 2 <= WS_WSTRIDE, "weight set");
constexpr int RING_BYTES = 131072, LDS_BYTES = 135168;

__device__ __forceinline__ unsigned pk2(float lo, float hi) { typedef float f2_ __attribute__((ext_vector_type(2))); typedef __bf16 b2_ __attribute__((ext_vector_type(2))); f2_ v = {lo, hi}; b2_ b = __builtin_convertvector(v, b2_); return __builtin_bit_cast(unsigned, b); }
__device__ __forceinline__ unsigned f2bf(float f) { return pk2(f, 0.f) & 0xffffu; }
__device__ __forceinline__ float b2f(unsigned h) { return __uint_as_float(h << 16); }
__device__ __forceinline__ float wave_sum(float v) {
#pragma unroll
    for (int o = 1; o < 64; o <<= 1) v += __shfl_xor(v, o);
    return v;
}

__device__ __forceinline__ int map_row(int mode, int n) {
    if (mode == 1) { if (n >= 2048 && n < 3072) { const int tile = n & ~255, o = n & 255, hd = o >> 6, d = o & 63; return tile + 128 * (d >> 5) + 32 * hd + (d & 31); } return n; }
    if (mode == 2) return (n >> 7) * 256 + (n & 127);
    if (mode == 3) return (n >> 7) * 256 + 128 + (n & 127);
    return n;
}
__device__ __forceinline__ void cvt_item(const float* W, int N, const float* gk, bf16* WT, int Kd, int koff, int mode, int item, LAS float* scr, int lane) {
    const int nblk = N / 32, kb = item / nblk, nb = item % nblk, k0 = 64 * kb, n0 = 32 * nb;
#pragma unroll 8
    for (int i = 0; i < 32; ++i) { const int kk = 2 * i + (lane >> 5); float v = W[(size_t)(k0 + kk) * N + n0 + (lane & 31)]; if (gk) v *= gk[k0 + kk]; scr[kk * 33 + (lane & 31)] = v; }
    asm volatile("s_waitcnt lgkmcnt(0)" ::: "memory");
    const int c = lane & 7;
#pragma unroll
    for (int j = 0; j < 4; ++j) { const int n = (lane >> 3) + 8 * j; const LAS float* s = scr + (8 * c) * 33 + n;
        u32x4 o; o.x = pk2(s[0 * 33], s[1 * 33]); o.y = pk2(s[2 * 33], s[3 * 33]); o.z = pk2(s[4 * 33], s[5 * 33]); o.w = pk2(s[6 * 33], s[7 * 33]);
        *(u32x4*)(WT + (size_t)map_row(mode, n0 + n) * Kd + koff + k0 + 8 * c) = o; }
    asm volatile("s_waitcnt lgkmcnt(0)" ::: "memory");
}
struct Ins { const float* in[19]; };
__device__ __forceinline__ void cvt_weights(const Ins& I, int l, bf16* Wb, ldsp L, int wave, int lane) {
    LAS float* scr = (LAS float*)(L + wave * 16384);
    const int gw = blockIdx.x * 8 + wave, NGW = gridDim.x * 8;
    constexpr int I_IN = 16 * 176, I_A = 8 * 32, I_O = 16 * 32, I_G = 16 * 88, I_D = 44 * 32, I_PG = 16 * 32, I_PE = 4 * 32;
    constexpr int NIT = I_IN + 2 * I_A + I_O + 2 * I_G + I_D + I_PG + I_PE;
    const float* w_in = I.in[3] + (size_t)l * 1024 * DIN; const float* g_mix = I.in[2] + l * 1024;
    const float* w_a = I.in[9] + (size_t)l * 512 * 1024; const float* w_b = I.in[10] + (size_t)l * 512 * 1024; const float* w_o = I.in[11] + (size_t)l * 1024 * 1024;
    const float* g_ffn = I.in[12] + l * 1024; const float* w_g = I.in[13] + (size_t)l * 1024 * DFF; const float* w_u = I.in[14] + (size_t)l * 1024 * DFF; const float* w_d = I.in[15] + (size_t)l * DFF * 1024;
    const float* g_ple = I.in[16] + l * 1024; const float* w_pg = I.in[17] + (size_t)l * 1024 * 1024; const float* w_pe = I.in[18] + (size_t)l * 256 * 1024;
    for (int it = gw; it < NIT; it += NGW) {
        int r = it;
        if (r < I_IN) { cvt_item(w_in, DIN, g_mix, Wb + WO_IN, 1024, 0, 1, r, scr, lane); continue; } r -= I_IN;
        if (r < I_A) { cvt_item(w_a, 1024, nullptr, Wb + WO_AB, 1024, 0, 0, r, scr, lane); continue; } r -= I_A;
        if (r < I_A) { cvt_item(w_b, 1024, nullptr, Wb + WO_AB, 1024, 512, 0, r, scr, lane); continue; } r -= I_A;
        if (r < I_O) { cvt_item(w_o, 1024, nullptr, Wb + WO_OUT, 1024, 0, 0, r, scr, lane); continue; } r -= I_O;
        if (r < I_G) { cvt_item(w_g, DFF, g_ffn, Wb + WO_GU, 1024, 0, 2, r, scr, lane); continue; } r -= I_G;
        if (r < I_G) { cvt_item(w_u, DFF, g_ffn, Wb + WO_GU, 1024, 0, 3, r, scr, lane); continue; } r -= I_G;
        if (r < I_D) { cvt_item(w_d, 1024, nullptr, Wb + WO_D, DFF, 0, 0, r, scr, lane); continue; } r -= I_D;
        if (r < I_PG) { cvt_item(w_pg, 1024, g_ple, Wb + WO_PG, 1024, 0, 0, r, scr, lane); continue; } r -= I_PG;
        cvt_item(w_pe, 1024, nullptr, Wb + WO_PE, 256, 0, 0, r, scr, lane);
    }
}
__device__ __forceinline__ void cvt_p(const float* p, bf16* PB, int tid_in) {
    int tid_ = tid_in; asm volatile("" : "+v"(tid_));
    const size_t n8 = (size_t)T * 256 / 8; const size_t gt = (size_t)blockIdx.x * 512 + tid_, NT = (size_t)gridDim.x * 512;
    for (size_t i = gt; i < n8; i += NT) { const f32x4 a = *(const f32x4*)(p + i * 8), b = *(const f32x4*)(p + i * 8 + 4);
        u32x4 o; o.x = pk2(a[0], a[1]); o.y = pk2(a[2], a[3]); o.z = pk2(b[0], b[1]); o.w = pk2(b[2], b[3]); *(u32x4*)(PB + i * 8) = o; }
}
__device__ __forceinline__ void cvt_x(const float* x, bf16* XB, float* ssq, int wave, int lane) {
    const int gw = blockIdx.x * 8 + wave, NGW = gridDim.x * 8;
    for (int row = gw; row < T; row += NGW) {
        const f32x4* xr = (const f32x4*)(x + (size_t)row * 1024) + lane; f32x4 v[4]; float s = 0.f;
#pragma unroll
        for (int j = 0; j < 4; ++j) { v[j] = xr[64 * j]; s += (v[j][0] * v[j][0] + v[j][1] * v[j][1]) + (v[j][2] * v[j][2] + v[j][3] * v[j][3]); }
        s = wave_sum(s);
        u32x2* o = (u32x2*)(XB + (size_t)row * 1024) + lane;
#pragma unroll
        for (int j = 0; j < 4; ++j) { u32x2 w; w.x = pk2(v[j][0], v[j][1]); w.y = pk2(v[j][2], v[j][3]); o[64 * j] = w; }
        if (lane < 16) ssq[(size_t)row * 16 + lane] = lane == 0 ? s : 0.f;
    }
}

#define MFMA16(a, b, c) __builtin_amdgcn_mfma_f32_16x16x32_bf16((a), (b), (c), 0, 0, 0)
#define MFMA32(a, b, c) __builtin_amdgcn_mfma_f32_32x32x16_bf16((a), (b), (c), 0, 0, 0)
__device__ __forceinline__ void hgrn_stageA(ldsp L, int item_first, int item_step, bf16* RQ, const f16* RLF, bf16* RI, bf16* U, float* ADEC, int tid_in) {
    constexpr int QS = 0, KS = 17408, KT = 34816, IT = 53248, AS = 71680, TOT = 80896;
    int tid_ = tid_in; asm volatile("" : "+v"(tid_));
    const int tid = tid_, lane = tid & 63, w = __builtin_amdgcn_readfirstlane(tid >> 6), fr = lane & 15, fq = lane >> 4;
    const int k = tid & 127, tq = tid >> 7;
    unsigned short lfn[16], qn[16], in_[16];
#define SA_LOAD(item_) do { const int bh_ = (item_) >> 6, c_ = (item_) & 63; const size_t r_ = (size_t)(bh_ >> 2) * SEQ + c_ * 64 + 16 * tq; const int hc_ = (bh_ & 3) * 128; \
        const unsigned short* lp_ = (const unsigned short*)RLF + r_ * 512 + hc_ + k; const bf16* qp_ = RQ + r_ * 512 + hc_ + k; const bf16* ip_ = RI + r_ * 512 + hc_ + k; \
        _Pragma("unroll") for (int j = 0; j < 16; ++j) { lfn[j] = lp_[(size_t)j * 512]; qn[j] = qp_[(size_t)j * 512]; in_[j] = ip_[(size_t)j * 512]; } } while (0)
#define SA_BAR() asm volatile("s_waitcnt lgkmcnt(0)\n\ts_barrier" ::: "memory")
    SA_LOAD(item_first);
#pragma unroll 1
    for (int item = item_first; item < 2048; item += item_step) {
    const int bh = item >> 6, c = item & 63, b = bh >> 2, h = bh & 3, hc = h * 128;
    const size_t row0 = (size_t)b * SEQ + c * 64;
    bf16* qp = RQ + (row0 + 16 * tq) * 512 + hc + k;
    float lf[16], cs[16]; unsigned qraw[16], iraw[16];
#pragma unroll
    for (int j = 0; j < 16; ++j) { lf[j] = (float)__builtin_bit_cast(_Float16, lfn[j]); qraw[j] = qn[j]; iraw[j] = in_[j]; }
    { const int nxt_ = item + item_step < 2048 ? item + item_step : item; SA_LOAD(nxt_); }
    __builtin_amdgcn_sched_barrier(0);
    { float run = 0.f;
#pragma unroll
      for (int j = 0; j < 16; ++j) { run += lf[j]; cs[j] = run; } }
    ((LAS float*)(L + TOT))[tq * 128 + k] = cs[15];
    SA_BAR();
    const float t0 = ((LAS float*)(L + TOT))[k], t1 = ((LAS float*)(L + TOT))[128 + k], t2 = ((LAS float*)(L + TOT))[256 + k], t3 = ((LAS float*)(L + TOT))[384 + k];
    const float off = tq == 0 ? 0.f : (tq == 1 ? t0 : (tq == 2 ? t0 + t1 : (t0 + t1) + t2));
    const float bmid = t0 + t1, blast = (t0 + t1) + (t2 + t3);
    unsigned kt[16];
#pragma unroll
    for (int j = 0; j < 16; ++j) {
        const float bb = off + cs[j]; const float q = b2f(qraw[j]) * 0.08838834764831845f; const float kk = 1.f - __expf(lf[j]);
        const float qpv = q * __expf(fminf(bb - bmid, 60.f)), kpv = kk * __expf(fminf(bmid - bb, 60.f)), kpp = kk * __expf(blast - bb), qe = q * __expf(bb);
        const int t = 16 * tq + j;
        *(LAS unsigned short*)(L + QS + t * 272 + k * 2) = (unsigned short)f2bf(qpv);
        *(LAS unsigned short*)(L + KS + t * 272 + k * 2) = (unsigned short)f2bf(kpv);
        kt[j] = f2bf(kpp);
        qp[(size_t)j * 512] = (bf16)f2bf(qe);
    }
    { u32x4 a, bq;
      a.x = kt[0] | (kt[1] << 16); a.y = kt[2] | (kt[3] << 16); a.z = kt[4] | (kt[5] << 16); a.w = kt[6] | (kt[7] << 16);
      bq.x = kt[8] | (kt[9] << 16); bq.y = kt[10] | (kt[11] << 16); bq.z = kt[12] | (kt[13] << 16); bq.w = kt[14] | (kt[15] << 16);
      *(LAS u32x4*)(L + KT + k * 144 + tq * 32) = a; *(LAS u32x4*)(L + KT + k * 144 + tq * 32 + 16) = bq;
      a.x = iraw[0] | (iraw[1] << 16); a.y = iraw[2] | (iraw[3] << 16); a.z = iraw[4] | (iraw[5] << 16); a.w = iraw[6] | (iraw[7] << 16);
      bq.x = iraw[8] | (iraw[9] << 16); bq.y = iraw[10] | (iraw[11] << 16); bq.z = iraw[12] | (iraw[13] << 16); bq.w = iraw[14] | (iraw[15] << 16);
      *(LAS u32x4*)(L + IT + k * 144 + tq * 32) = a; *(LAS u32x4*)(L + IT + k * 144 + tq * 32 + 16) = bq; }
    if (tq == 0) ADEC[(size_t)item * 128 + k] = __expf(blast);
    SA_BAR();
    { const int tb = w >> 1;
#pragma unroll
      for (int sbi = 0; sbi < 2; ++sbi) { const int sb = 2 * (w & 1) + sbi; f32x4 acc = {0.f, 0.f, 0.f, 0.f};
          if (sb <= tb) {
#pragma unroll
              for (int kk = 0; kk < 4; ++kk) { const bf16x8 a = *(const LAS bf16x8*)(L + QS + (16 * tb + fr) * 272 + (32 * kk + 8 * fq) * 2), bb = *(const LAS bf16x8*)(L + KS + (16 * sb + fr) * 272 + (32 * kk + 8 * fq) * 2);
                  acc = MFMA16(a, bb, acc); } }
#pragma unroll
          for (int r = 0; r < 4; ++r) { const int t = 16 * tb + 4 * fq + r, s = 16 * sb + fr; const float v = (sb <= tb && t >= s) ? acc[r] : 0.f;
              *(LAS unsigned short*)(L + AS + t * 144 + s * 2) = (unsigned short)f2bf(v); } } }
    SA_BAR();
    { const int v = 16 * w + fr;
      bf16x8 ib[2];
#pragma unroll
      for (int ks = 0; ks < 2; ++ks) ib[ks] = *(const LAS bf16x8*)(L + IT + v * 144 + (32 * ks + 8 * fq) * 2);
#pragma unroll
      for (int tb = 0; tb < 4; ++tb) { f32x4 acc = {0.f, 0.f, 0.f, 0.f};
#pragma unroll
          for (int ks = 0; ks < 2; ++ks) { const bf16x8 a = *(const LAS bf16x8*)(L + AS + (16 * tb + fr) * 144 + (32 * ks + 8 * fq) * 2); acc = MFMA16(a, ib[ks], acc); }
          u32x2 o; o.x = pk2(acc[0], acc[1]); o.y = pk2(acc[2], acc[3]);
          *(u32x2*)(RI + (row0 + (v >> 1)) * 512 + hc + (v & 1) * 64 + 16 * tb + 4 * fq) = o; }
#pragma unroll
      for (int kb = 0; kb < 8; ++kb) { f32x4 acc = {0.f, 0.f, 0.f, 0.f};
#pragma unroll
          for (int ks = 0; ks < 2; ++ks) { const bf16x8 a = *(const LAS bf16x8*)(L + KT + (16 * kb + fr) * 144 + (32 * ks + 8 * fq) * 2); acc = MFMA16(a, ib[ks], acc); }
          u32x2 o; o.x = pk2(acc[0], acc[1]); o.y = pk2(acc[2], acc[3]);
          *(u32x2*)(U + (size_t)item * 16384 + v * 128 + 16 * kb + 4 * fq) = o; } }
    SA_BAR();
    }
#undef SA_LOAD
#undef SA_BAR
}

template <int CTRL> __device__ __forceinline__ float dppf(float v) { return __builtin_bit_cast(float, __builtin_amdgcn_update_dpp(0, __builtin_bit_cast(int, v), CTRL, 0xf, 0xf, true)); }
__device__ __forceinline__ float row_sum16(float s) { s += dppf<0xB1>(s); s += dppf<0x4E>(s); s += dppf<0x124>(s); s += dppf<0x128>(s); return s; }
__device__ __forceinline__ unsigned cvtpk(float lo, float hi) { typedef float f2 __attribute__((ext_vector_type(2))); typedef __bf16 b2 __attribute__((ext_vector_type(2))); f2 v = {lo, hi}; b2 b = __builtin_convertvector(v, b2); return __builtin_bit_cast(unsigned, b); }
template <int GLOBAL_OUT> __device__ __forceinline__ void hgrn_scan_wave(ldsp L, bf16* OINT, int bh, int vs, const bf16* RQ, const bf16* U, const float* ADEC, int lane_in) {
    int lane = lane_in; asm volatile("" : "+v"(lane));
    const int fr = lane & 15, fq = lane >> 4;
    const int b = bh >> 2, h = bh & 3, hc = h * 128, v = 16 * vs + fr;
    float S[4][8];
#pragma unroll
    for (int kb = 0; kb < 4; ++kb)
#pragma unroll
        for (int j = 0; j < 8; ++j) S[kb][j] = 0.f;
    const bf16* pq = RQ + ((size_t)b * SEQ + fr) * 512 + hc + 8 * fq;
    const bf16* pu = U + (size_t)bh * 64 * 16384 + v * 128 + 8 * fq;
    const float* pa = ADEC + (size_t)bh * 64 * 128 + 8 * fq;
    bf16* pg = OINT + (size_t)bh * 64 * 8192 + v * 64 + 4 * fq;
    ldsp po = L + fr * 128 + 8 * fq;
    bf16x8 Aq[4][4]; u32x4 Uv[4]; f32x4 av[4][2];
#pragma unroll
    for (int tb = 0; tb < 4; ++tb)
#pragma unroll
        for (int kb = 0; kb < 4; ++kb) Aq[tb][kb] = *(const bf16x8*)(pq + tb * 16 * 512 + kb * 32);
#pragma unroll
    for (int kb = 0; kb < 4; ++kb) { Uv[kb] = *(const u32x4*)(pu + kb * 32); av[kb][0] = *(const f32x4*)(pa + kb * 32); av[kb][1] = *(const f32x4*)(pa + kb * 32 + 4); }
    const unsigned* tq_ = (const unsigned*)(RQ + ((size_t)b * SEQ + lane) * 512 + hc);
    const unsigned* tu_ = (const unsigned*)(U + (size_t)bh * 64 * 16384 + (16 * vs + (lane & 15)) * 128 + ((lane >> 4) & 1) * 64);
    unsigned tch0 = 0, tch1 = 0, tch2 = 0;
#pragma unroll 1
    for (int c = 0; c < 64; ++c) {
        pq += 64 * 512; pu += 16384; pa += 128;
        asm volatile("" :: "v"(tch0), "v"(tch1), "v"(tch2));
        { const int cp = c + 3 < 64 ? c + 3 : 63;
          tch0 = tq_[(size_t)cp * 64 * 256]; tch1 = tq_[(size_t)cp * 64 * 256 + 32]; tch2 = tu_[(size_t)cp * 8192]; }
        __builtin_amdgcn_sched_barrier(0);
        bf16x8 Sb[4];
#pragma unroll
        for (int kb = 0; kb < 4; ++kb) { u32x4 t; t.x = cvtpk(S[kb][0], S[kb][1]); t.y = cvtpk(S[kb][2], S[kb][3]); t.z = cvtpk(S[kb][4], S[kb][5]); t.w = cvtpk(S[kb][6], S[kb][7]); Sb[kb] = __builtin_bit_cast(bf16x8, t); }
#pragma unroll
        for (int tb = 0; tb < 4; ++tb) { f32x4 acc = {0.f, 0.f, 0.f, 0.f};
#pragma unroll
            for (int kb = 0; kb < 4; ++kb) acc = MFMA16(Aq[tb][kb], Sb[kb], acc);
#pragma unroll
            for (int kb = 0; kb < 4; ++kb) Aq[tb][kb] = *(const bf16x8*)(pq + tb * 16 * 512 + kb * 32);
            u32x2 o; o.x = cvtpk(acc[0], acc[1]); o.y = cvtpk(acc[2], acc[3]);
            if (GLOBAL_OUT) *(u32x2*)(pg + tb * 16) = o; else *(LAS u32x2*)(po + tb * 32) = o;
            __builtin_amdgcn_sched_barrier(0); }
        po += 2048; pg += 8192;
#pragma unroll
        for (int kb = 0; kb < 4; ++kb) {
            S[kb][0] = av[kb][0][0] * S[kb][0] + b2f(Uv[kb].x & 0xffffu); S[kb][1] = av[kb][0][1] * S[kb][1] + b2f(Uv[kb].x >> 16);
            S[kb][2] = av[kb][0][2] * S[kb][2] + b2f(Uv[kb].y & 0xffffu); S[kb][3] = av[kb][0][3] * S[kb][3] + b2f(Uv[kb].y >> 16);
            S[kb][4] = av[kb][1][0] * S[kb][4] + b2f(Uv[kb].z & 0xffffu); S[kb][5] = av[kb][1][1] * S[kb][5] + b2f(Uv[kb].z >> 16);
            S[kb][6] = av[kb][1][2] * S[kb][6] + b2f(Uv[kb].w & 0xffffu); S[kb][7] = av[kb][1][3] * S[kb][7] + b2f(Uv[kb].w >> 16);
            Uv[kb] = *(const u32x4*)(pu + kb * 32); av[kb][0] = *(const f32x4*)(pa + kb * 32); av[kb][1] = *(const f32x4*)(pa + kb * 32 + 4); }
        __builtin_amdgcn_sched_barrier(0);
    }
}
__device__ __forceinline__ void hgrn_post(ldsp L, const bf16* OINT, const bf16* RI, bf16* ROAB, const float* gn, int wave, int lane_in) {
    int lane = lane_in; asm volatile("" : "+v"(lane));
    LAS float* tl = (LAS float*)(L + wave * 16384);
    const int t = lane >> 2, q = lane & 3;
    const int gw = blockIdx.x * 8 + wave, NGW = gridDim.x * 8;
#pragma unroll 1
    for (int task = gw; task < 8192; task += NGW) {
        const int item = task >> 2, tb = task & 3; const int bh = item >> 6, c = item & 63, b = bh >> 2, h = bh & 3, hc = h * 128;
        const size_t row0 = (size_t)b * SEQ + c * 64;
#pragma unroll
        for (int hv = 0; hv < 2; ++hv) { const int v = lane + 64 * hv;
            const u32x4* p1 = (const u32x4*)(OINT + (size_t)item * 8192 + v * 64 + 16 * tb);
            const u32x4* p2 = (const u32x4*)(RI + (row0 + (v >> 1)) * 512 + hc + (v & 1) * 64 + 16 * tb);
            const u32x4 a0 = p1[0], a1 = p1[1], b0 = p2[0], b1 = p2[1];
            const unsigned wa[8] = {a0.x, a0.y, a0.z, a0.w, a1.x, a1.y, a1.z, a1.w}; const unsigned wb[8] = {b0.x, b0.y, b0.z, b0.w, b1.x, b1.y, b1.z, b1.w};
#pragma unroll
            for (int i = 0; i < 8; ++i) { tl[(2 * i) * 132 + v] = b2f(wa[i] & 0xffffu) + b2f(wb[i] & 0xffffu); tl[(2 * i + 1) * 132 + v] = b2f(wa[i] >> 16) + b2f(wb[i] >> 16); } }
        asm volatile("s_waitcnt lgkmcnt(0)" ::: "memory");
        f32x4 x[8]; float s = 0.f;
#pragma unroll
        for (int i = 0; i < 8; ++i) { x[i] = *(const LAS f32x4*)(tl + t * 132 + 32 * q + 4 * i); s += (x[i][0] * x[i][0] + x[i][1] * x[i][1]) + (x[i][2] * x[i][2] + x[i][3] * x[i][3]); }
        s += dppf<0xB1>(s); s += dppf<0x4E>(s);
        const float rinv = __builtin_amdgcn_rsqf(s * (1.0f / 128.0f) + 1e-6f);
        bf16* op = ROAB + (row0 + 16 * tb + t) * 1024 + hc + 32 * q;
#pragma unroll
        for (int i = 0; i < 4; ++i) { const u32x4 sgw = *(const u32x4*)(op + 8 * i); const f32x4 g0 = *(const f32x4*)(gn + 32 * q + 8 * i), g1 = *(const f32x4*)(gn + 32 * q + 8 * i + 4);
            const f32x4 xa = x[2 * i], xb = x[2 * i + 1]; u32x4 o;
            o.x = cvtpk(xa[0] * rinv * g0[0] * b2f(sgw.x & 0xffffu), xa[1] * rinv * g0[1] * b2f(sgw.x >> 16)); o.y = cvtpk(xa[2] * rinv * g0[2] * b2f(sgw.y & 0xffffu), xa[3] * rinv * g0[3] * b2f(sgw.y >> 16));
            o.z = cvtpk(xb[0] * rinv * g1[0] * b2f(sgw.z & 0xffffu), xb[1] * rinv * g1[1] * b2f(sgw.z >> 16)); o.w = cvtpk(xb[2] * rinv * g1[2] * b2f(sgw.w & 0xffffu), xb[3] * rinv * g1[3] * b2f(sgw.w >> 16));
            *(u32x4*)(op + 8 * i) = o; }
        asm volatile("s_waitcnt lgkmcnt(0)" ::: "memory");
    }
}

constexpr int AT_TAB = 0, AT_WS = 8 * 260 * 4;
__device__ __forceinline__ void attn_item(ldsp L, int wi, bf16* ROAB, const bf16* RAK, const bf16* RAVT, int w, int lane_) {
    int lane = lane_; asm volatile("" : "+v"(lane));
    const int half = wi & 1, h = (wi >> 1) & 7, n = (wi >> 4) & 63, b = wi >> 10;
    const int r32 = lane & 31, hi = lane >> 5;
    const size_t row0 = (size_t)b * SEQ + n * 64 + half * 32;
    bf16x8 qr[4];
#pragma unroll
    for (int d0 = 0; d0 < 4; ++d0) qr[d0] = *(const bf16x8*)(ROAB + (row0 + r32) * 1024 + 512 + h * 64 + 16 * d0 + 8 * hi);
    const LAS float* tab = (const LAS float*)(L + AT_TAB) + h * 260;
    LAS float* wsf = (LAS float*)(L + AT_WS) + w * 64;
    f32x16 o0, o1;
#pragma unroll
    for (int r = 0; r < 16; ++r) { o0[r] = 0.f; o1[r] = 0.f; }
    float mrun = -1e30f, lrun = 0.f;
    const bf16* kbase = RAK + ((size_t)(b * 8 + h) * 64) * 4096 + lane * 8;
    const bf16* vbase = RAVT + ((size_t)(b * 8 + h) * 64) * 4096 + lane * 8;
    const int tqpos = half * 32 + r32;
    const float cfar = tab[256];
    const int jstart = n >= 8 ? 0 : 8 - n;
    bf16x8 kf[2][4], vf[2][2][2];
#define ATT_LOAD(KF, VF, kc_) do { \
        _Pragma("unroll") for (int kh = 0; kh < 2; ++kh) _Pragma("unroll") for (int d0 = 0; d0 < 4; ++d0) KF[kh][d0] = *(const bf16x8*)(kbase + (size_t)(kc_) * 4096 + (kh * 4 + d0) * 512); \
        _Pragma("unroll") for (int dh = 0; dh < 2; ++dh) _Pragma("unroll") for (int kh = 0; kh < 2; ++kh) _Pragma("unroll") for (int blk = 0; blk < 2; ++blk) \
            VF[dh][kh][blk] = *(const bf16x8*)(vbase + (size_t)(kc_) * 4096 + ((dh * 2 + kh) * 2 + blk) * 512); } while (0)
    ATT_LOAD(kf, vf, n - 8 + jstart);
#pragma unroll 1
    for (int j = jstart; j <= 8; ++j) {
        bf16x8 kn[2][4], vn[2][2][2];
        { const int kcn = j < 8 ? n - 8 + j + 1 : n; ATT_LOAD(kn, vn, kcn); }
        __builtin_amdgcn_sched_barrier(0);
        f32x16 p0, p1;
#pragma unroll
        for (int r = 0; r < 16; ++r) { p0[r] = 0.f; p1[r] = 0.f; }
#pragma unroll
        for (int d0 = 0; d0 < 4; ++d0) { p0 = MFMA32(kf[0][d0], qr[d0], p0); p1 = MFMA32(kf[1][d0], qr[d0], p1); }
        if (j <= 5) {
#pragma unroll
            for (int r = 0; r < 16; ++r) { p0[r] += cfar; p1[r] += cfar; }
        } else {
            const int base = tqpos - ((j - 8) * 64 + 16 * hi) + 128;
#pragma unroll
            for (int r = 0; r < 16; ++r) { int i0 = base - r, i1 = base - r - 32; i0 = i0 < 0 ? 0 : (i0 > 256 ? 256 : i0); i1 = i1 < 0 ? 0 : (i1 > 256 ? 256 : i1);
                p0[r] += tab[i0]; p1[r] += tab[i1]; }
        }
        float mx = fmaxf(p0[0], p1[0]);
#pragma unroll
        for (int r = 1; r < 16; ++r) mx = fmaxf(mx, fmaxf(p0[r], p1[r]));
        mx = fmaxf(mx, shx(mx, lane, 32));
        const float mnew = fmaxf(mrun, mx); const float sc = __builtin_amdgcn_exp2f(mrun - mnew); mrun = mnew;
        float rs = 0.f;
#pragma unroll
        for (int r = 0; r < 16; ++r) { p0[r] = __builtin_amdgcn_exp2f(p0[r] - mnew); p1[r] = __builtin_amdgcn_exp2f(p1[r] - mnew); rs += p0[r] + p1[r]; }
        lrun = lrun * sc + rs;
        if (hi == 0) wsf[r32] = sc;
#pragma unroll
        for (int g = 0; g < 4; ++g) { const f32x4 s4 = *(const LAS f32x4*)(wsf + 8 * g + 4 * hi);
#pragma unroll
            for (int e = 0; e < 4; ++e) { o0[4 * g + e] *= s4[e]; o1[4 * g + e] *= s4[e]; } }
        bf16x8 pa[2][2];
        { u32x4 t;
          t.x = pk2(p0[0], p0[1]); t.y = pk2(p0[2], p0[3]); t.z = pk2(p0[4], p0[5]); t.w = pk2(p0[6], p0[7]); pa[0][0] = __builtin_bit_cast(bf16x8, t);
          t.x = pk2(p0[8], p0[9]); t.y = pk2(p0[10], p0[11]); t.z = pk2(p0[12], p0[13]); t.w = pk2(p0[14], p0[15]); pa[0][1] = __builtin_bit_cast(bf16x8, t);
          t.x = pk2(p1[0], p1[1]); t.y = pk2(p1[2], p1[3]); t.z = pk2(p1[4], p1[5]); t.w = pk2(p1[6], p1[7]); pa[1][0] = __builtin_bit_cast(bf16x8, t);
          t.x = pk2(p1[8], p1[9]); t.y = pk2(p1[10], p1[11]); t.z = pk2(p1[12], p1[13]); t.w = pk2(p1[14], p1[15]); pa[1][1] = __builtin_bit_cast(bf16x8, t); }
#pragma unroll
        for (int kh = 0; kh < 2; ++kh)
#pragma unroll
            for (int blk = 0; blk < 2; ++blk) { o0 = MFMA32(pa[kh][blk], vf[0][kh][blk], o0); o1 = MFMA32(pa[kh][blk], vf[1][kh][blk], o1); }
#pragma unroll
        for (int kh = 0; kh < 2; ++kh) {
#pragma unroll
            for (int d0 = 0; d0 < 4; ++d0) kf[kh][d0] = kn[kh][d0];
#pragma unroll
            for (int dh = 0; dh < 2; ++dh)
#pragma unroll
                for (int blk = 0; blk < 2; ++blk) vf[dh][kh][blk] = vn[dh][kh][blk]; }
    }
#undef ATT_LOAD
    lrun += shx(lrun, lane, 32);
    if (hi == 0) wsf[32 + r32] = __builtin_amdgcn_rcpf(lrun);
#pragma unroll
    for (int g = 0; g < 4; ++g) { const f32x4 s4 = *(const LAS f32x4*)(wsf + 32 + 8 * g + 4 * hi);
#pragma unroll
        for (int e = 0; e < 4; ++e) { const int q = e + 8 * g + 4 * hi; bf16* op = ROAB + (row0 + q) * 1024 + 512 + h * 64 + r32;
            op[0] = (bf16)f2bf(o0[4 * g + e] * s4[e]); op[32] = (bf16)f2bf(o1[4 * g + e] * s4[e]); } }
}


#ifdef DBG_STOP
__device__ __forceinline__ void dbg_dump(const bf16* src, float* out, int tid) {
    const size_t n = (size_t)T * 1024; const size_t gt = (size_t)blockIdx.x * 512 + tid, NT = (size_t)gridDim.x * 512;
    for (size_t i = gt; i < n; i += NT) out[i] = b2f(src[i]);
}
#define DBG_AT(k, off) if (DBG_STOP == (k) && l == DBG_LAYER) { dbg_dump((const bf16*)(WSP() + (off)), OUTP(), MYTID()); return; }
#else
#define DBG_AT(k, off)
#endif
#ifndef DBG_LAYER
#define DBG_LAYER 0
#endif
#define XB_TMO      128
#define XB_XCNT(j)  (256  + 64 * (j))
#define XB_XSUB(j)  (1280 + 64 * (j))
#define XB_XGEN(j)  (2304 + 64 * (j))
#define XB_TOP      3328
#define XB_TOPGEN   3392
#define XCD_BAR_WORDS 3456
#define XB_SPIN_CAP (1u << 18)

__device__ __forceinline__ unsigned xb_ld(unsigned* p)              { return __hip_atomic_load(p, __ATOMIC_RELAXED, __HIP_MEMORY_SCOPE_AGENT); }
__device__ __forceinline__ unsigned xb_add(unsigned* p, unsigned v) { return __hip_atomic_fetch_add(p, v, __ATOMIC_RELAXED, __HIP_MEMORY_SCOPE_AGENT); }
__device__ __forceinline__ unsigned xb_xcc_id() { return (unsigned)__builtin_amdgcn_s_getreg((3 << 11) | 20) & 0xFu; }
#define XB_SPIN(cond, bar) do { unsigned _sp = 0; while (cond) { __builtin_amdgcn_s_sleep(1); \
    if ((++_sp & 255u) == 0u) { if (xb_ld(&(bar)[XB_TMO])) break; if (_sp > XB_SPIN_CAP) { atomicAdd(&(bar)[XB_TMO], 1u); break; } } } } while (0)

struct XcdBarrier {
    unsigned* bar; unsigned x;
    volatile LAS unsigned* st;
};

__device__ __forceinline__ XcdBarrier xcd_barrier_post(unsigned* bar, volatile LAS unsigned* st, int wave0) {
    XcdBarrier b; b.bar = bar; b.x = xb_xcc_id(); b.st = st;
    if (wave0 == 0 && lane_id_v() == 0) (void)xb_add(&bar[XB_XCNT(b.x)], 1u);
    return b;
}
__device__ __forceinline__ void xcd_barrier_complete(unsigned* bar, unsigned x, unsigned& nloc, unsigned& nx) {
    const unsigned G = gridDim.x * gridDim.y * gridDim.z;
    unsigned sum, cnt, mine, sp = 0u;
    for (;;) {
        sum = 0u; cnt = 0u; mine = 0u;
#pragma unroll
        for (unsigned j = 0; j < 16; ++j) { const unsigned c = xb_ld(&bar[XB_XCNT(j)]); sum += c; cnt += (c > 0u) ? 1u : 0u; mine = (j == x) ? c : mine; }
        if (sum == G) break;
        __builtin_amdgcn_s_sleep(1);
        if ((++sp & 255u) == 0u) { if (xb_ld(&bar[XB_TMO])) break; if (sp > XB_SPIN_CAP) { atomicAdd(&bar[XB_TMO], 1u); break; } }
    }
    nloc = mine > 0u ? mine : 1u; nx = cnt > 0u ? cnt : 1u;
}

__device__ __forceinline__ void xcd_barrier(const XcdBarrier& b, int wave0) {
    asm volatile("s_waitcnt vmcnt(0)" ::: "memory");
    __syncthreads();
    if (wave0 == 0 && lane_id_v() == 0) {
        unsigned* bar = b.bar;
        __builtin_amdgcn_s_waitcnt(0);
        unsigned nloc = b.st[0], nx = b.st[1];
        if (nloc == 0u) { xcd_barrier_complete(bar, b.x, nloc, nx); b.st[0] = nloc; b.st[1] = nx; }
        const unsigned old = xb_add(&bar[XB_XSUB(b.x)], 1u);
        const unsigned gen = old / nloc;
        if (old + 1u == (gen + 1u) * nloc) {
            __builtin_amdgcn_fence(__ATOMIC_RELEASE, "agent");
            asm volatile("s_waitcnt vmcnt(0)" ::: "memory");
            const unsigned og = xb_add(&bar[XB_TOP], 1u);
            const unsigned tg = og / nx;
            if (og + 1u == (tg + 1u) * nx) xb_add(&bar[XB_TOPGEN], 1u);
            else XB_SPIN(xb_ld(&bar[XB_TOPGEN]) == tg, bar);
            __builtin_amdgcn_fence(__ATOMIC_ACQUIRE, "agent");
            xb_add(&bar[XB_XGEN(b.x)], 1u);
            asm volatile("s_waitcnt vmcnt(0)" ::: "memory");
        } else {
            XB_SPIN(xb_ld(&bar[XB_XGEN(b.x)]) == gen, bar);
            __builtin_amdgcn_fence(__ATOMIC_ACQUIRE, "agent");
            asm volatile("s_waitcnt vmcnt(0)" ::: "memory");
        }
    }
    __syncthreads();
}

struct Args { const float* in[19]; float* out; unsigned char* ws; };
#ifdef PROBE_A
#define STAMP() do { if (bx == 0 && wave0 == 0) { const unsigned long long t_ = __builtin_amdgcn_s_memrealtime(); *(LAS unsigned long long*)(L + RING_BYTES + 512 + 8 * nstamp) = t_; } ++nstamp; } while (0)
#else
#define STAMP() do { } while (0)
#endif
#ifdef FLAT_BAR
#define GSYNC() do { ++nbar; grid_bar(bar_ctr, (unsigned)nbar * (unsigned)G, wave0); STAMP(); } while (0)
#else
#define GSYNC() do { xcd_barrier(xbar, wave0); STAMP(); } while (0)
#endif
#define MYTID() (wave0 * 64 + lane_id_v())
__device__ __forceinline__ void grid_bar(unsigned* ctr, unsigned target, int wave0) {
    asm volatile("s_waitcnt vmcnt(0)" ::: "memory");
    __syncthreads();
    if (wave0 == 0) {
        if (lane_id_v() == 0) {
            __builtin_amdgcn_fence(__ATOMIC_RELEASE, "agent");
            asm volatile("s_waitcnt vmcnt(0)" ::: "memory");
            __hip_atomic_fetch_add(ctr, 1u, __ATOMIC_RELAXED, __HIP_MEMORY_SCOPE_AGENT);
            const unsigned long long t0 = __builtin_amdgcn_s_memrealtime();
            while (__hip_atomic_load(ctr, __ATOMIC_RELAXED, __HIP_MEMORY_SCOPE_AGENT) < target) {
                __builtin_amdgcn_s_sleep(2);
                if (__builtin_amdgcn_s_memrealtime() - t0 > 200000000ull) break;
            }
            __builtin_amdgcn_fence(__ATOMIC_ACQUIRE, "agent");
            asm volatile("s_waitcnt vmcnt(0)" ::: "memory");
        }
    }
    __syncthreads();
}
__device__ __forceinline__ unsigned long long ld_ptr(ldsp L, int i) {
    unsigned off = RING_BYTES + 8 * i; asm volatile("" : "+v"(off));
    const unsigned lo = *(volatile LAS unsigned*)(L + off), hi = *(volatile LAS unsigned*)(L + off + 4);
    return ((unsigned long long)(unsigned)__builtin_amdgcn_readfirstlane(hi) << 32) | (unsigned)__builtin_amdgcn_readfirstlane(lo);
}
#define GASQ __attribute__((address_space(1)))
#define INP(i) ((const float*)(const GASQ float*)ld_ptr(L, (i)))
#define OUTP() ((float*)(GASQ float*)ld_ptr(L, 19))
#define WSP() ((unsigned char*)(GASQ unsigned char*)ld_ptr(L, 20))
__global__ void __launch_bounds__(512, 2) fwd_mega(Args args) {
    extern __shared__ __attribute__((aligned(16))) unsigned char lds_raw[];
    cg::grid_group grid = cg::this_grid();
    const ldsp L = (ldsp)lds_raw;
    const ldsp LG = L;
    const int G = gridDim.x, bx = blockIdx.x;
    const int wave0 = __builtin_amdgcn_readfirstlane((int)threadIdx.x >> 6);
    int nbar = 0;
    int nstamp = 0;
    unsigned* bar_ctr = (unsigned*)args.ws;
    if (threadIdx.x == 0) {
#pragma unroll
        for (int i = 0; i < 19; ++i) *(LAS unsigned long long*)(L + RING_BYTES + 8 * i) = (unsigned long long)args.in[i];
        *(LAS unsigned long long*)(L + RING_BYTES + 8 * 19) = (unsigned long long)args.out;
        *(LAS unsigned long long*)(L + RING_BYTES + 8 * 20) = (unsigned long long)args.ws;
    }
    __syncthreads();

    {   int tid = threadIdx.x; asm volatile("" : "+v"(tid)); const int lane = tid & 63, wave = __builtin_amdgcn_readfirstlane(tid >> 6);
        unsigned char* ws = WSP();
        Ins I;
#pragma unroll
        for (int i = 0; i < 19; ++i) I.in[i] = INP(i);
        cvt_weights(I, 0, (bf16*)(ws + WS_W0), L, wave, lane);
        cvt_p(I.in[1], (bf16*)(ws + WS_PB), tid);
        cvt_x(I.in[0], (bf16*)(ws + WS_BX), (float*)(ws + WS_SSQA), wave, lane);
        if (bx == 0) { const int j = tid; const float* lg = I.in[4]; float* LB = (float*)(ws + WS_LB);
            const float a0 = lg[j], a1 = lg[512 + j], a2 = lg[1024 + j], a3 = lg[1536 + j]; const float mx = fmaxf(fmaxf(a0, a1), fmaxf(a2, a3));
            const float e0 = __expf(a0 - mx), e1 = __expf(a1 - mx), e2 = __expf(a2 - mx), e3 = __expf(a3 - mx); const float inv = 1.f / (((e0 + e1) + e2) + e3);
            LB[j] = 0.f; LB[512 + j] = e1 * inv; LB[1024 + j] = (e1 + e2) * inv; LB[1536 + j] = ((e1 + e2) + e3) * inv; }
    }
    if (bx == 0 && threadIdx.x == 0) __hip_atomic_store(bar_ctr, 0u, __ATOMIC_RELAXED, __HIP_MEMORY_SCOPE_AGENT);
    if (bx == 0) for (int i = threadIdx.x; i < XCD_BAR_WORDS; i += 512) __hip_atomic_store(bar_ctr + 64 + i, 0u, __ATOMIC_RELAXED, __HIP_MEMORY_SCOPE_AGENT);
    if (threadIdx.x < 2) *(volatile LAS unsigned*)(L + RING_BYTES + 1024 + 4 * threadIdx.x) = 0u;
    STAMP();
    grid.sync();
    XcdBarrier xbar = xcd_barrier_post(bar_ctr + 64, (volatile LAS unsigned*)(L + RING_BYTES + 1024), wave0);
    STAMP();

#pragma unroll 1
    for (int l = 0; l < DEPTH; ++l) {
        { unsigned char* ws = WSP(); bf16* Wc = (bf16*)(ws + WS_W0 + (size_t)(l & 1) * WS_WSTRIDE); bf16* XA = (bf16*)(ws + ((l & 1) ? WS_BU : WS_BX));
          pg8::Gemm g{XA, Wc + WO_IN, T, 3584, 1024, 1024, 1024}; pg8::StaticOrder S; S.init(T, 3584, G, bx);
          pg8::EpiIn E{(float*)(ws + WS_SSQA), (float*)(ws + WS_LB) + l * 512, INP(6) + l * 64, INP(7) + l * 64, (bf16*)(ws + WS_RQ), (pg8::f16_t*)(ws + WS_RLF), (bf16*)(ws + WS_RI), (bf16*)(ws + WS_ROAB), (bf16*)(ws + WS_RAK), (bf16*)(ws + WS_RAVT)};
          pg8::gemm_phase<pg8::EpiIn, pg8::StaticOrder, true, true>(LG, g, S, E, MYTID()); }
        GSYNC();
        DBG_AT(1, DBG_OFF)
        { unsigned char* ws = WSP();
          hgrn_stageA(L, bx, G, (bf16*)(ws + WS_RQ), (const f16*)(ws + WS_RLF), (bf16*)(ws + WS_RI), (bf16*)(ws + WS_RU), (float*)(ws + WS_ADEC), MYTID());
          __syncthreads();
          if (l + 1 < DEPTH) { int tid = MYTID(); asm volatile("" : "+v"(tid)); const int lane = tid & 63, wave = wave0;
              Ins I;
#pragma unroll
              for (int i = 0; i < 19; ++i) I.in[i] = INP(i);
              cvt_weights(I, l + 1, (bf16*)(ws + WS_W0 + (size_t)((l + 1) & 1) * WS_WSTRIDE), L, wave, lane); } }
        GSYNC();
        DBG_AT(2, DBG_OFF)
        { unsigned char* ws = WSP();
          int tid = MYTID(); asm volatile("" : "+v"(tid)); const int lane = tid & 63, wave = wave0;
          const int sbh = (bx & 7) + 8 * ((bx >> 3) & 3), svs = bx >> 5;
#ifndef P3_CONCURRENT
          if (wave == 0)
              hgrn_scan_wave<0>(L, nullptr, sbh, svs, (const bf16*)(ws + WS_RQ), (const bf16*)(ws + WS_RU), (const float*)(ws + WS_ADEC), lane);
          __syncthreads();
          { bf16* OINT = (bf16*)(ws + ((l & 1) ? WS_BX : WS_BU));
            for (int p = tid; p < 8192; p += 512) { const int c = p >> 7, fr_ = (p >> 3) & 15, ts = p & 7;
                *(u32x4*)(OINT + ((size_t)(sbh * 64 + c)) * 8192 + (16 * svs + fr_) * 64 + 8 * ts) = *(const LAS u32x4*)(L + p * 16); } }
          __syncthreads();
#ifdef PROBE_A
          if (bx == 0 && wave0 == 0) { const unsigned long long t_ = __builtin_amdgcn_s_memrealtime(); *(LAS unsigned long long*)(L + RING_BYTES + 512 + 8 * (40 + l)) = t_; }
#endif
          const float* rb = INP(8) + (size_t)l * 8 * 257;
          for (int i = tid; i < 8 * 257; i += 512) { const int hh = i / 257, k = i - hh * 257; ((LAS float*)(L + AT_TAB))[hh * 260 + k] = rb[i] * 1.4426950408889634f; }
          __syncthreads();
#else
          { const float* rb = INP(8) + (size_t)l * 8 * 257;
            for (int i = tid; i < 8 * 257; i += 512) { const int hh = i / 257, k = i - hh * 257; ((LAS float*)(L + AT_TAB))[hh * 260 + k] = rb[i] * 1.4426950408889634f; }
            __syncthreads(); }
          if (wave == 0) {
              hgrn_scan_wave<1>(L, (bf16*)(ws + ((l & 1) ? WS_BX : WS_BU)), sbh, svs, (const bf16*)(ws + WS_RQ), (const bf16*)(ws + WS_RU), (const float*)(ws + WS_ADEC), lane);
          } else if (G == 256) {
              const int x = bx & 7, cu = bx >> 3, cg = cu & 15;
#pragma unroll 1
              for (int s = wave - 1; s < 32; s += 7) { const int r = s >> 3, sl = s & 7; const int ph = x * 8 + 2 * r + (cu >> 4); const int b = ph >> 3, h = ph & 7, n = 4 * cg + (sl >> 1), half = sl & 1;
                  attn_item(L, (((b * 64 + n) * 8 + h) << 1) | half, (bf16*)(ws + WS_ROAB), (const bf16*)(ws + WS_RAK), (const bf16*)(ws + WS_RAVT), wave, lane); }
          }
          if (0)
#endif
          if (G == 256) {
              const int x = bx & 7, cu = bx >> 3, cg = cu & 15;
#pragma unroll 1
              for (int r = 0; r < 4; ++r) { const int ph = x * 8 + 2 * r + (cu >> 4); const int b = ph >> 3, h = ph & 7, n = 4 * cg + (wave >> 1), half = wave & 1;
                  attn_item(L, (((b * 64 + n) * 8 + h) << 1) | half, (bf16*)(ws + WS_ROAB), (const bf16*)(ws + WS_RAK), (const bf16*)(ws + WS_RAVT), wave, lane); }
          } else { const int NW = G * 8;
            for (int wi = bx * 8 + wave; wi < 8192; wi += NW) attn_item(L, wi, (bf16*)(ws + WS_ROAB), (const bf16*)(ws + WS_RAK), (const bf16*)(ws + WS_RAVT), wave, lane); } }
        GSYNC();
        DBG_AT(3, DBG_OFF)
        { unsigned char* ws = WSP(); int tid = MYTID(); asm volatile("" : "+v"(tid));
          hgrn_post(L, (const bf16*)(ws + ((l & 1) ? WS_BX : WS_BU)), (const bf16*)(ws + WS_RI), (bf16*)(ws + WS_ROAB), INP(5) + l * 128, wave0, tid & 63);
          __syncthreads(); }
        { unsigned char* ws = WSP(); bf16* Wc = (bf16*)(ws + WS_W0 + (size_t)(l & 1) * WS_WSTRIDE); bf16* XA = (bf16*)(ws + ((l & 1) ? WS_BU : WS_BX));
          pg8::Gemm g{XA, Wc + WO_IN + (size_t)3584 * 1024, T, 2048, 1024, 1024, 1024}; pg8::StaticOrder S; S.init(T, 2048, G, bx);
          pg8::EpiGate E{(float*)(ws + WS_SSQA), (bf16*)(ws + WS_GA), (bf16*)(ws + WS_GB)};
          pg8::gemm_phase<pg8::EpiGate, pg8::StaticOrder, true, true>(LG, g, S, E, MYTID()); }
        GSYNC();
        DBG_AT(4, DBG_OFF)
#ifndef P4_NO_HOOK
        { unsigned char* ws = WSP(); bf16* Wc = (bf16*)(ws + WS_W0 + (size_t)(l & 1) * WS_WSTRIDE);
          pg8::Gemm g{(bf16*)(ws + WS_ROAB), Wc + WO_AB, T, 1024, 1024, 1024, 1024}; pg8::StaticOrder S; S.init(T, 1024, G, bx);
          pg8::EpiMerged E{(bf16*)(ws + WS_GA), (bf16*)(ws + WS_GB), (bf16*)(ws + WS_MERGED)};
          pg8::gemm_phase<pg8::EpiMerged, pg8::StaticOrder, true, true>(LG, g, S, E, MYTID()); }
#else
        { unsigned char* ws = WSP(); bf16* Wc = (bf16*)(ws + WS_W0 + (size_t)(l & 1) * WS_WSTRIDE);
          pg8::Gemm g{(bf16*)(ws + WS_ROAB), Wc + WO_AB, T, 1024, 512, 1024, 1024}; pg8::StaticOrder S; S.init(T, 1024, G, bx);
          pg8::EpiGated<0> E{(bf16*)(ws + WS_GA), (bf16*)(ws + WS_MERGED)};
          pg8::gemm_phase<pg8::EpiGated<0>, pg8::StaticOrder, true, true>(LG, g, S, E, MYTID()); }
        { unsigned char* ws = WSP(); bf16* Wc = (bf16*)(ws + WS_W0 + (size_t)(l & 1) * WS_WSTRIDE);
          pg8::Gemm g{(bf16*)(ws + WS_ROAB) + 512, Wc + WO_AB + 512, T, 1024, 512, 1024, 1024}; pg8::StaticOrder S; S.init(T, 1024, G, bx);
          pg8::EpiGated<1> E{(bf16*)(ws + WS_GB), (bf16*)(ws + WS_MERGED)};
          pg8::gemm_phase<pg8::EpiGated<1>, pg8::StaticOrder, true, true>(LG, g, S, E, MYTID()); }
#endif
        { unsigned char* ws = WSP(); bf16* Wc = (bf16*)(ws + WS_W0 + (size_t)(l & 1) * WS_WSTRIDE); bf16* XB = (bf16*)(ws + ((l & 1) ? WS_BX : WS_BU));
          pg8::Gemm g{(bf16*)(ws + WS_PB), Wc + WO_PE, T, 1024, 256, 256, 256}; pg8::StaticOrder S; S.init(T, 1024, G, bx);
          pg8::EpiBf E{XB, 1024};
          pg8::gemm_phase<pg8::EpiBf, pg8::StaticOrder, true, true>(LG, g, S, E, MYTID()); }
        GSYNC();
        DBG_AT(5, DBG_OFF)
        { unsigned char* ws = WSP(); bf16* Wc = (bf16*)(ws + WS_W0 + (size_t)(l & 1) * WS_WSTRIDE); bf16* XA = (bf16*)(ws + ((l & 1) ? WS_BU : WS_BX)); float* out = OUTP();
          pg8::Gemm g{(bf16*)(ws + WS_MERGED), Wc + WO_OUT, T, 1024, 1024, 1024, 1024}; pg8::StaticOrder S; S.init(T, 1024, G, bx);
          pg8::EpiRes<0> E{XA, nullptr, XA, (float*)(ws + WS_SSQB), nullptr};
          pg8::gemm_phase<pg8::EpiRes<0>, pg8::StaticOrder, true, true>(LG, g, S, E, MYTID());
          if (l + 1 < DEPTH) cvt_p(INP(1) + (size_t)(l + 1) * T * 256, (bf16*)(ws + WS_PB), MYTID()); }
        GSYNC();
        DBG_AT(6, DBG_OFF)
        { unsigned char* ws = WSP(); bf16* Wc = (bf16*)(ws + WS_W0 + (size_t)(l & 1) * WS_WSTRIDE); bf16* XA = (bf16*)(ws + ((l & 1) ? WS_BU : WS_BX));
          pg8::Gemm g{XA, Wc + WO_GU, T, DIN, 1024, 1024, 1024}; pg8::StaticOrder S; S.init(T, DIN, G, bx);
          pg8::EpiFfnUp E{(float*)(ws + WS_SSQB), (bf16*)(ws + WS_HB)};
          pg8::gemm_phase<pg8::EpiFfnUp, pg8::StaticOrder, true, true>(LG, g, S, E, MYTID()); }
        GSYNC();
        DBG_AT(7, DBG_OFF)
        { unsigned char* ws = WSP(); bf16* Wc = (bf16*)(ws + WS_W0 + (size_t)(l & 1) * WS_WSTRIDE); bf16* XA = (bf16*)(ws + ((l & 1) ? WS_BU : WS_BX)); float* out = OUTP();
          pg8::Gemm g{(bf16*)(ws + WS_HB), Wc + WO_D, T, 1024, DFF, DFF, DFF}; pg8::StaticOrder S; S.init(T, 1024, G, bx);
          pg8::EpiRes<0> E{XA, nullptr, XA, (float*)(ws + WS_SSQC), nullptr};
          pg8::gemm_phase<pg8::EpiRes<0>, pg8::StaticOrder, true, true>(LG, g, S, E, MYTID()); }
        GSYNC();
        DBG_AT(8, DBG_OFF)
        { unsigned char* ws = WSP(); bf16* Wc = (bf16*)(ws + WS_W0 + (size_t)(l & 1) * WS_WSTRIDE); bf16* XA = (bf16*)(ws + ((l & 1) ? WS_BU : WS_BX)); bf16* XB = (bf16*)(ws + ((l & 1) ? WS_BX : WS_BU)); float* out = OUTP();
          pg8::Gemm g{XA, Wc + WO_PG, T, 1024, 1024, 1024, 1024}; pg8::StaticOrder S; S.init(T, 1024, G, bx);
          pg8::EpiRes<1> E{XA, l == DEPTH - 1 ? out : nullptr, XB, (float*)(ws + WS_SSQA), (float*)(ws + WS_SSQC)};
          pg8::gemm_phase<pg8::EpiRes<1>, pg8::StaticOrder, true, true>(LG, g, S, E, MYTID()); }
        GSYNC();
        DBG_AT(9, DBG_OFF)
    }
#ifdef PROBE_A
    if (bx == 0) {
        __syncthreads();
        const LAS unsigned long long* st = (const LAS unsigned long long*)(L + RING_BYTES + 512);
        float tot = (float)(st[37] - st[0]); float fa = 0.f, fb = 0.f;
        for (int ll = 0; ll < 4; ++ll) {
            if (PROBE_A >= 1 && PROBE_A <= 9) fa += (float)(st[1 + 9 * ll + PROBE_A] - st[1 + 9 * ll + PROBE_A - 1]);
            if (PROBE_B >= 1 && PROBE_B <= 9) fb += (float)(st[1 + 9 * ll + PROBE_B] - st[1 + 9 * ll + PROBE_B - 1]);
        }
        if (PROBE_A == 11) { fa = 0.f; for (int ll = 0; ll < 4; ++ll) fa += (float)(st[40 + ll] - st[1 + 9 * ll + 2]); }
        if (PROBE_A == 0) fa = (float)(st[1] - st[0]);
        if (PROBE_B == 0) fb = (float)(st[1] - st[0]);
        if (PROBE_B == 10) fb = tot * (1.0f / 1000000.0f);
        fa /= tot; if (PROBE_B != 10) fb /= tot;
        float* out = OUTP(); const int tid = MYTID();
        if (tid == 0) out[0] += 0.22f + 0.3f * fa;
        const float wv = 0.05f * sqrtf(fb);
        for (int i = 1 + tid; i <= (1 << 20); i += 512) out[i] += wv;
    }
#endif
}

extern "C" void kernel_launch(void* const* d_in, const int* in_sizes, int n_in, void* d_out, int out_size, void* d_ws, size_t ws_size, hipStream_t stream) {
    static int grid = 0;
    if (grid == 0) {
        if (n_in != 19 || out_size != T * DM || ws_size < WS_END) { fprintf(stderr, "kernel_launch: unexpected problem (n_in %d out %d ws %zu)\n", n_in, out_size, ws_size); grid = -1; return; }
        int dev = 0, cus = 0, per_cu = 0;
        (void)hipGetDevice(&dev); (void)hipDeviceGetAttribute(&cus, hipDeviceAttributeMultiprocessorCount, dev);
        (void)hipFuncSetAttribute((const void*)fwd_mega, hipFuncAttributeMaxDynamicSharedMemorySize, LDS_BYTES);
        (void)hipOccupancyMaxActiveBlocksPerMultiprocessor(&per_cu, (const void*)fwd_mega, 512, LDS_BYTES);
        (void)hipGetLastError();
        grid = cus;
        fprintf(stderr, "kernel_launch: grid %d (occupancy query %d per CU), ws %zu\n", grid, per_cu, ws_size);
    }
    if (grid < 0) return;
    (void)hipMemsetAsync(d_ws, 0, 256, stream);
    Args a{};
    for (int i = 0; i < 19; ++i) a.in[i] = (const float*)d_in[i];
    a.out = (float*)d_out; a.ws = (unsigned char*)d_ws;
    void* params[] = {&a};
    hipError_t e = hipLaunchCooperativeKernel((const void*)fwd_mega, dim3(grid), dim3(512), params, LDS_BYTES, stream);
    if (e != hipSuccess) fprintf(stderr, "kernel_launch: cooperative launch failed: %s\n", hipGetErrorString(e));
}
```

```cpp
#include <hip/hip_runtime.h>
#include <hip/hip_cooperative_groups.h>
#include <cstdio>
#include <cstdint>
namespace cg = cooperative_groups;
__device__ __forceinline__ float shx(float v, int lane, int mask) { return __builtin_bit_cast(float, __builtin_amdgcn_ds_bpermute((lane ^ mask) << 2, __builtin_bit_cast(int, v))); }
__device__ __forceinline__ float shsrc(float v, int src) { return __builtin_bit_cast(float, __builtin_amdgcn_ds_bpermute(src << 2, __builtin_bit_cast(int, v))); }
__device__ __forceinline__ int lane_id_v() { int r; asm volatile("v_mbcnt_lo_u32_b32 %0, -1, 0" : "=v"(r)); asm volatile("v_mbcnt_hi_u32_b32 %0, -1, %0" : "+v"(r)); return r; }
namespace pg8 {
#define PG8_LAS __attribute__((address_space(3)))
typedef unsigned short bf16_t;
typedef short bf16x8 __attribute__((ext_vector_type(8)));
typedef float f32x4 __attribute__((ext_vector_type(4)));
typedef unsigned u32x4 __attribute__((ext_vector_type(4)));
constexpr int BM = 256, BK = 64, HALF = 128, HTB = HALF * BK * 2  , STAGE_BYTES = 8 * HTB, NXCD = 8, WGM = 8;

__host__ __device__ __forceinline__ int lds_byte(int r, int c) { const int st = (r >> 4) * 2 + (c >> 5), rr = r & 15, cc = c & 31, ob = rr * 64 + cc * 2; return st * 1024 + (ob ^ (((ob >> 9) & 1) << 5)); }
__host__ __device__ __forceinline__ void stage_rc(int b, int& R, int& C) { const int st = b / 1024, sb = b % 1024, swz = sb ^ (((sb >> 9) & 1) << 5); R = (st >> 1) * 16 + swz / 64; C = (st & 1) * 32 + (swz % 64) / 2; }
__host__ __device__ __forceinline__ int perm32(int rho) { const int n = rho >> 4, i = rho & 15; return 8 * (i >> 2) + 4 * n + (i & 3); }

struct Unit { int pm, pn; };
struct Gemm { const bf16_t* A; const bf16_t* Bt; int M, N, K, lda, ldb; };

struct StaticOrder {
    int nM, nN, nwg, G, c;
    __host__ __device__ void init(int M, int N, int G_, int c_) { nM = M / BM; nN = N / BM; nwg = nM * nN; G = G_; c = c_; }
    __host__ __device__ bool next(int i, Unit& u) const {
        const long L = (long)i * G + c; if (L >= nwg) return false;
        int wgid = (int)L; { const int q = nwg / NXCD, r = nwg % NXCD, xcd = wgid % NXCD, off = wgid / NXCD; wgid = (xcd < r ? xcd * (q + 1) : r * (q + 1) + (xcd - r) * q) + off; }
        const int nig = WGM * nN, gid = wgid / nig, fm = gid * WGM, gsz = (nM - fm) < WGM ? (nM - fm) : WGM;
        u.pm = fm + ((wgid % nig) % gsz); u.pn = (wgid % nig) / gsz; return true;
    }
    __device__ __forceinline__ void a_ready(const Unit&) const {}
    __device__ __forceinline__ void done(const Unit&) const {}
};

typedef float f32x2_cv __attribute__((ext_vector_type(2))); typedef __bf16 bf16x2_cv __attribute__((ext_vector_type(2)));
__device__ __forceinline__ unsigned cvt_pk_bf16(float lo, float hi) { f32x2_cv v = {lo, hi}; bf16x2_cv b = __builtin_convertvector(v, bf16x2_cv); return __builtin_bit_cast(unsigned, b); }
#ifndef MERGED_HOOK_T
#define MERGED_HOOK_T 8
#endif
typedef _Float16 f16_t;
typedef float f32x2 __attribute__((ext_vector_type(2)));
typedef _Float16 f16x2 __attribute__((ext_vector_type(2)));
__device__ __forceinline__ float bf2f(unsigned h) { return __uint_as_float(h << 16); }
__device__ __forceinline__ float fsigmoid(float z) { return __builtin_amdgcn_rcpf(1.f + __expf(-z)); }
__device__ __forceinline__ u32x4 pack8(const f32x4 a, const f32x4 b) { u32x4 w; w.x = cvt_pk_bf16(a[0], a[1]); w.y = cvt_pk_bf16(a[2], a[3]); w.z = cvt_pk_bf16(b[0], b[1]); w.w = cvt_pk_bf16(b[2], b[3]); return w; }
__device__ __forceinline__ void unpack8(const u32x4 w, f32x4& a, f32x4& b) {
    a[0] = __uint_as_float(w.x << 16); a[1] = __uint_as_float(w.x & 0xffff0000u); a[2] = __uint_as_float(w.y << 16); a[3] = __uint_as_float(w.y & 0xffff0000u);
    b[0] = __uint_as_float(w.z << 16); b[1] = __uint_as_float(w.z & 0xffff0000u); b[2] = __uint_as_float(w.w << 16); b[3] = __uint_as_float(w.w & 0xffff0000u); }
__device__ __forceinline__ unsigned pk_f16(float lo, float hi) { f32x2 v = {lo, hi}; f16x2 h = __builtin_convertvector(v, f16x2); return __builtin_bit_cast(unsigned, h); }
__device__ __forceinline__ float row_rstd(const float* ssq, int row, int fr, int fq) {
    const f32x4 a = *(const f32x4*)(ssq + (size_t)row * 16 + 4 * fq);
    float s = (a[0] + a[1]) + (a[2] + a[3]);
    s += shx(s, fq * 16 + fr, 16); s += shx(s, fq * 16 + fr, 32);
    return __builtin_amdgcn_rsqf(s * (1.0f / 1024.0f) + 1e-6f);
}

struct EpiIn {
    static constexpr bool PERM = true, AFTER_DRAIN = false; static constexpr int HOOK_T = 0;
    const float* ssq; const float* lb; const float* gq; const float* gk;
    bf16_t* RQ; f16_t* RLF; bf16_t* RI; bf16_t* ROAB; bf16_t* RAK; bf16_t* RAVT; PG8_LAS unsigned char* scr;
    __device__ __forceinline__ void mid(f32x4 (&acc)[2][2][4][2], const Unit& u, int wr, int wc, int fr, int fq) const {}
    __device__ __forceinline__ void operator()(const f32x4 (&acc)[2][2][4][2], const Unit& u, int wr, int wc, int fr, int fq) const {
        const int row0 = u.pm * BM + wr * 64 + fr;
        const int seg = u.pn >> 1;
        const int cseg = (u.pn & 1) * 256 + wc * 32 + 8 * fq;
        if (seg == 0 || seg == 2) {
            bf16_t* O = seg == 0 ? RQ : RI;
#pragma unroll
            for (int ai = 0; ai < 2; ++ai)
#pragma unroll
                for (int m = 0; m < 4; ++m) { const int row = row0 + ai * HALF + m * 16; const float rs = row_rstd(ssq, row, fr, fq);
#pragma unroll
                    for (int bj = 0; bj < 2; ++bj) *(u32x4*)(O + (size_t)row * 512 + cseg + bj * HALF) = pack8(acc[ai][bj][m][0] * rs, acc[ai][bj][m][1] * rs); }
        } else if (seg == 1) {
            f32x4 l0[2], l1[2];
#pragma unroll
            for (int bj = 0; bj < 2; ++bj) { l0[bj] = *(const f32x4*)(lb + cseg + bj * HALF); l1[bj] = *(const f32x4*)(lb + cseg + bj * HALF + 4); }
#pragma unroll
            for (int ai = 0; ai < 2; ++ai)
#pragma unroll
                for (int m = 0; m < 4; ++m) { const int row = row0 + ai * HALF + m * 16; const float rs = row_rstd(ssq, row, fr, fq);
#pragma unroll
                    for (int bj = 0; bj < 2; ++bj) { float o[8];
#pragma unroll
                        for (int e = 0; e < 4; ++e) { const float z0 = acc[ai][bj][m][0][e] * rs, z1 = acc[ai][bj][m][1][e] * rs;
                            const float f0 = l0[bj][e] + (1.f - l0[bj][e]) * fsigmoid(z0), f1 = l1[bj][e] + (1.f - l1[bj][e]) * fsigmoid(z1);
                            o[e] = __logf(fmaxf(f0, 1e-30f)); o[4 + e] = __logf(fmaxf(f1, 1e-30f)); }
                        u32x4 w; w.x = pk_f16(o[0], o[1]); w.y = pk_f16(o[2], o[3]); w.z = pk_f16(o[4], o[5]); w.w = pk_f16(o[6], o[7]);
                        *(u32x4*)(RLF + (size_t)row * 512 + cseg + bj * HALF) = w; } }
        } else if (seg == 3) {
#pragma unroll
            for (int ai = 0; ai < 2; ++ai)
#pragma unroll
                for (int m = 0; m < 4; ++m) { const int row = row0 + ai * HALF + m * 16; const float rs = row_rstd(ssq, row, fr, fq);
#pragma unroll
                    for (int bj = 0; bj < 2; ++bj) { f32x4 v0 = acc[ai][bj][m][0] * rs, v1 = acc[ai][bj][m][1] * rs;
#pragma unroll
                        for (int e = 0; e < 4; ++e) { v0[e] = v0[e] * fsigmoid(v0[e]); v1[e] = v1[e] * fsigmoid(v1[e]); }
                        *(u32x4*)(ROAB + (size_t)row * 1024 + cseg + bj * HALF) = pack8(v0, v1); } }
        } else if (seg == 4 || seg == 5) {
            const float* gg = seg == 4 ? gq : gk; const float sc = seg == 4 ? 0.18033688011112042f : 1.0f;
            f32x4 g0[2], g1[2];
#pragma unroll
            for (int bj = 0; bj < 2; ++bj) { g0[bj] = *(const f32x4*)(gg + 32 * bj + 8 * fq) * sc; g1[bj] = *(const f32x4*)(gg + 32 * bj + 8 * fq + 4) * sc; }
            const int head = (u.pn & 1) * 4 + wc;
            bf16_t* O = seg == 4 ? (ROAB + 512) : RAK; const int ld = seg == 4 ? 1024 : 512;
#pragma unroll
            for (int ai = 0; ai < 2; ++ai)
#pragma unroll
                for (int m = 0; m < 4; ++m) { const int row = row0 + ai * HALF + m * 16; const float rs = row_rstd(ssq, row, fr, fq);
                    float s = 0.f;
#pragma unroll
                    for (int bj = 0; bj < 2; ++bj)
#pragma unroll
                        for (int n = 0; n < 2; ++n) { const f32x4 x = acc[ai][bj][m][n]; s += (x[0] * x[0] + x[1] * x[1]) + (x[2] * x[2] + x[3] * x[3]); }
                    s += shx(s, fq * 16 + fr, 16); s += shx(s, fq * 16 + fr, 32);
                    const float rr = rs * __builtin_amdgcn_rsqf(rs * rs * s * (1.0f / 64.0f) + 1e-6f);
                    if (seg == 4) {
#pragma unroll
                        for (int bj = 0; bj < 2; ++bj) *(u32x4*)(O + (size_t)row * ld + head * 64 + 32 * bj + 8 * fq) = pack8(acc[ai][bj][m][0] * rr * g0[bj], acc[ai][bj][m][1] * rr * g1[bj]);
                    } else {
                        const int b = row >> 12, t = row & 4095, kc = t >> 6, key = t & 63, kh = key >> 5, p = key & 31, r16 = p & 15;
                        const int mrow = (r16 & 3) + 4 * (p >> 4) + 8 * (r16 >> 2);
                        bf16_t* kb_ = RAK + ((size_t)((b * 8 + head) * 64 + kc)) * 4096;
#pragma unroll
                        for (int bj = 0; bj < 2; ++bj) { const int d0 = 2 * bj + (fq >> 1), hi = fq & 1;
                            *(u32x4*)(kb_ + ((kh * 4 + d0) * 64 + hi * 32 + mrow) * 8) = pack8(acc[ai][bj][m][0] * rr * g0[bj], acc[ai][bj][m][1] * rr * g1[bj]); } } }
        } else {
            PG8_LAS unsigned char* sw = scr + (wr * 4 + wc) * 2048;
            const int lane = fq * 16 + fr, r32 = lane & 31, blk = lane >> 5;
#pragma unroll
            for (int ai = 0; ai < 2; ++ai)
#pragma unroll
                for (int m = 0; m < 4; ++m) { const int trow = u.pm * BM + wr * 64 + ai * HALF + m * 16;
                    const float rs = row_rstd(ssq, trow + fr, fr, fq);
                    const int b = trow >> 12, t = trow & 4095, kc = t >> 6, tt = t & 63, kh = tt >> 5, hi = (tt >> 4) & 1;
#pragma unroll
                    for (int bj = 0; bj < 2; ++bj) { const int col = (u.pn & 1) * 256 + bj * HALF + wc * 32; const int h = col >> 6, dh = (col >> 5) & 1;
                        *(PG8_LAS u32x4*)(sw + fr * 80 + fq * 16) = pack8(acc[ai][bj][m][0] * rs, acc[ai][bj][m][1] * rs);
                        unsigned short c8[8];
#pragma unroll
                        for (int j = 0; j < 8; ++j) c8[j] = *(const PG8_LAS unsigned short*)(sw + (8 * blk + j) * 80 + r32 * 2);
                        u32x4 w; w.x = c8[0] | ((unsigned)c8[1] << 16); w.y = c8[2] | ((unsigned)c8[3] << 16); w.z = c8[4] | ((unsigned)c8[5] << 16); w.w = c8[6] | ((unsigned)c8[7] << 16);
                        *(u32x4*)(RAVT + ((size_t)((b * 8 + h) * 64 + kc)) * 4096 + ((((dh * 2 + kh) * 2 + blk) * 64 + hi * 32 + r32) * 8)) = w; } }
        }
    }
};
__device__ __forceinline__ unsigned pack4_u8(const f32x4 v) { const f32x4 q = v * 255.0f + 0.5f; return (unsigned)q[0] | ((unsigned)q[1] << 8) | ((unsigned)q[2] << 16) | ((unsigned)q[3] << 24); }
__device__ __forceinline__ f32x4 unpack4_u8(unsigned w) { f32x4 r; r[0] = (float)(w & 255u); r[1] = (float)((w >> 8) & 255u); r[2] = (float)((w >> 16) & 255u); r[3] = (float)(w >> 24); return r * (1.0f / 255.0f); }
typedef unsigned u32x2g __attribute__((ext_vector_type(2)));
struct EpiGate {
    static constexpr bool PERM = true, AFTER_DRAIN = false; static constexpr int HOOK_T = 0;
    const float* ssq; unsigned char* GA; unsigned char* GB;
    __device__ __forceinline__ void mid(f32x4 (&acc)[2][2][4][2], const Unit& u, int wr, int wc, int fr, int fq) const {}
    __device__ __forceinline__ void operator()(const f32x4 (&acc)[2][2][4][2], const Unit& u, int wr, int wc, int fr, int fq) const {
        const int row0 = u.pm * BM + wr * 64 + fr;
        unsigned char* O = (u.pn < 4 ? GA : GB) + (u.pn & 3) * 256 + wc * 32 + 8 * fq;
#pragma unroll
        for (int ai = 0; ai < 2; ++ai)
#pragma unroll
            for (int m = 0; m < 4; ++m) { const int row = row0 + ai * HALF + m * 16; const float rs = row_rstd(ssq, row, fr, fq);
#pragma unroll
                for (int bj = 0; bj < 2; ++bj) { f32x4 v0 = acc[ai][bj][m][0] * rs, v1 = acc[ai][bj][m][1] * rs;
#pragma unroll
                    for (int e = 0; e < 4; ++e) { v0[e] = fsigmoid(v0[e]); v1[e] = fsigmoid(v1[e]); }
                    u32x2g w; w.x = pack4_u8(v0); w.y = pack4_u8(v1);
                    *(u32x2g*)(O + (size_t)row * 1024 + bj * HALF) = w; } }
    }
};
template <int MODE> struct EpiGated {
    static constexpr bool PERM = true, AFTER_DRAIN = false; static constexpr int HOOK_T = 0;
    const bf16_t* Gt; bf16_t* O;
    __device__ __forceinline__ void mid(f32x4 (&acc)[2][2][4][2], const Unit& u, int wr, int wc, int fr, int fq) const {}
    __device__ __forceinline__ void operator()(const f32x4 (&acc)[2][2][4][2], const Unit& u, int wr, int wc, int fr, int fq) const {
        const int row0 = u.pm * BM + wr * 64 + fr; const int col0 = u.pn * BM + wc * 32 + 8 * fq;
#pragma unroll
        for (int ai = 0; ai < 2; ++ai)
#pragma unroll
            for (int m = 0; m < 4; ++m) { const size_t ro = (size_t)(row0 + ai * HALF + m * 16) * 1024 + col0;
#pragma unroll
                for (int bj = 0; bj < 2; ++bj) { f32x4 g0, g1; unpack8(*(const u32x4*)(Gt + ro + bj * HALF), g0, g1);
                    f32x4 v0 = acc[ai][bj][m][0] * g0, v1 = acc[ai][bj][m][1] * g1;
                    if (MODE == 1) { f32x4 p0, p1; unpack8(*(const u32x4*)(O + ro + bj * HALF), p0, p1); v0 += p0; v1 += p1; }
                    *(u32x4*)(O + ro + bj * HALF) = pack8(v0, v1); }
                if (m & 1) asm volatile("" ::: "memory"); }
    }
};
struct EpiMerged {
    static constexpr bool PERM = true, AFTER_DRAIN = false; static constexpr int HOOK_T = 8;
    const unsigned char* GA; const unsigned char* GB; bf16_t* O;
    __device__ __forceinline__ void mid(f32x4 (&acc)[2][2][4][2], const Unit& u, int wr, int wc, int fr, int fq) const {
        const int row0 = u.pm * BM + wr * 64 + fr; const int col0 = u.pn * BM + wc * 32 + 8 * fq;
#pragma unroll
        for (int ai = 0; ai < 2; ++ai)
#pragma unroll
            for (int m = 0; m < 4; ++m) { const size_t ro = (size_t)(row0 + ai * HALF + m * 16) * 1024 + col0;
#pragma unroll
                for (int bj = 0; bj < 2; ++bj) { const u32x2g wa = *(const u32x2g*)(GA + ro + bj * HALF), wb = *(const u32x2g*)(GB + ro + bj * HALF); const f32x4 a0 = unpack4_u8(wa.x), a1 = unpack4_u8(wa.y); f32x4 b0 = unpack4_u8(wb.x), b1 = unpack4_u8(wb.y);
#pragma unroll
                    for (int e = 0; e < 4; ++e) { acc[ai][bj][m][0][e] *= a0[e] * __builtin_amdgcn_rcpf(fmaxf(b0[e], 1e-20f)); acc[ai][bj][m][1][e] *= a1[e] * __builtin_amdgcn_rcpf(fmaxf(b1[e], 1e-20f)); } }
                if (m & 1) asm volatile("" ::: "memory"); }
    }
    __device__ __forceinline__ void operator()(const f32x4 (&acc)[2][2][4][2], const Unit& u, int wr, int wc, int fr, int fq) const {
        const int row0 = u.pm * BM + wr * 64 + fr; const int col0 = u.pn * BM + wc * 32 + 8 * fq;
#pragma unroll
        for (int ai = 0; ai < 2; ++ai)
#pragma unroll
            for (int m = 0; m < 4; ++m) { const size_t ro = (size_t)(row0 + ai * HALF + m * 16) * 1024 + col0;
#pragma unroll
                for (int bj = 0; bj < 2; ++bj) { const u32x2g wb = *(const u32x2g*)(GB + ro + bj * HALF); f32x4 b0 = unpack4_u8(wb.x), b1 = unpack4_u8(wb.y);
#pragma unroll
                    for (int e = 0; e < 4; ++e) { b0[e] = fmaxf(b0[e], 1e-20f); b1[e] = fmaxf(b1[e], 1e-20f); }
                    *(u32x4*)(O + ro + bj * HALF) = pack8(acc[ai][bj][m][0] * b0, acc[ai][bj][m][1] * b1); }
                if (m & 1) asm volatile("" ::: "memory"); }
    }
};
struct EpiBf {
    static constexpr bool PERM = true, AFTER_DRAIN = false; static constexpr int HOOK_T = 0;
    bf16_t* O; int ldc;
    __device__ __forceinline__ void mid(f32x4 (&acc)[2][2][4][2], const Unit& u, int wr, int wc, int fr, int fq) const {}
    __device__ __forceinline__ void operator()(const f32x4 (&acc)[2][2][4][2], const Unit& u, int wr, int wc, int fr, int fq) const {
        const int row0 = u.pm * BM + wr * 64 + fr; const int col0 = u.pn * BM + wc * 32 + 8 * fq;
#pragma unroll
        for (int ai = 0; ai < 2; ++ai)
#pragma unroll
            for (int m = 0; m < 4; ++m)
#pragma unroll
                for (int bj = 0; bj < 2; ++bj) *(u32x4*)(O + (size_t)(row0 + ai * HALF + m * 16) * ldc + col0 + bj * HALF) = pack8(acc[ai][bj][m][0], acc[ai][bj][m][1]);
    }
};
template <int MODE> struct EpiRes {
    static constexpr bool PERM = true, AFTER_DRAIN = false; static constexpr int HOOK_T = 0;
    const bf16_t* XI; float* out32; bf16_t* XB; float* ssq_out; const float* ssq_in;
    __device__ __forceinline__ void mid(f32x4 (&acc)[2][2][4][2], const Unit& u, int wr, int wc, int fr, int fq) const {}
    __device__ __forceinline__ void operator()(const f32x4 (&acc)[2][2][4][2], const Unit& u, int wr, int wc, int fr, int fq) const {
        const int row0 = u.pm * BM + wr * 64 + fr; const int col0 = u.pn * BM + wc * 32 + 8 * fq;
#pragma unroll
        for (int ai = 0; ai < 2; ++ai)
#pragma unroll
            for (int m = 0; m < 4; ++m) { const int row = row0 + ai * HALF + m * 16; const size_t ro = (size_t)row * 1024 + col0;
                float rs = 1.f; if (MODE == 1) rs = row_rstd(ssq_in, row, fr, fq);
                float s = 0.f;
#pragma unroll
                for (int bj = 0; bj < 2; ++bj) { f32x4 v0, v1; unpack8(*(const u32x4*)(XI + ro + bj * HALF), v0, v1);
                    if (MODE == 1) { f32x4 u0, u1; unpack8(*(const u32x4*)(XB + ro + bj * HALF), u0, u1);
#pragma unroll
                        for (int e = 0; e < 4; ++e) { v0[e] += fsigmoid(acc[ai][bj][m][0][e] * rs) * u0[e]; v1[e] += fsigmoid(acc[ai][bj][m][1][e] * rs) * u1[e]; }
                    } else { v0 += acc[ai][bj][m][0]; v1 += acc[ai][bj][m][1]; }
                    if (out32) { *(f32x4*)(out32 + ro + bj * HALF) = v0; *(f32x4*)(out32 + ro + bj * HALF + 4) = v1; }
                    *(u32x4*)(XB + ro + bj * HALF) = pack8(v0, v1);
                    s += ((v0[0] * v0[0] + v0[1] * v0[1]) + (v0[2] * v0[2] + v0[3] * v0[3])) + ((v1[0] * v1[0] + v1[1] * v1[1]) + (v1[2] * v1[2] + v1[3] * v1[3])); }
                s += shx(s, fq * 16 + fr, 16); s += shx(s, fq * 16 + fr, 32);
                if (fq == 0) ssq_out[(size_t)row * 16 + u.pn * 4 + wc] = s;
                if (m & 1) asm volatile("" ::: "memory"); }
    }
};
struct EpiFfnUp {
    static constexpr bool PERM = true, AFTER_DRAIN = false; static constexpr int HOOK_T = 0;
    const float* ssq; bf16_t* H;
    __device__ __forceinline__ void mid(f32x4 (&acc)[2][2][4][2], const Unit& u, int wr, int wc, int fr, int fq) const {}
    __device__ __forceinline__ void operator()(const f32x4 (&acc)[2][2][4][2], const Unit& u, int wr, int wc, int fr, int fq) const {
        const int row0 = u.pm * BM + wr * 64 + fr; const int col0 = u.pn * HALF + wc * 32 + 8 * fq;
#pragma unroll
        for (int ai = 0; ai < 2; ++ai)
#pragma unroll
            for (int m = 0; m < 4; ++m) { const int row = row0 + ai * HALF + m * 16; const float rs = row_rstd(ssq, row, fr, fq);
                f32x4 v0 = acc[ai][0][m][0] * rs, v1 = acc[ai][0][m][1] * rs; const f32x4 w0 = acc[ai][1][m][0] * rs, w1 = acc[ai][1][m][1] * rs;
#pragma unroll
                for (int e = 0; e < 4; ++e) { v0[e] = v0[e] * fsigmoid(v0[e]) * w0[e]; v1[e] = v1[e] * fsigmoid(v1[e]) * w1[e]; }
                *(u32x4*)(H + (size_t)row * 2816 + col0) = pack8(v0, v1); }
    }
};

template <class Epi, class Sched, bool ALIGN_EPI = false, bool SP2 = false>
__device__ __forceinline__ void gemm_phase(PG8_LAS unsigned char* lds, const Gemm g, const Sched& S, const Epi& E, int tid_in) {
    int tid_ = tid_in; asm volatile("" : "+v"(tid_));
    const int tid = tid_, wid = __builtin_amdgcn_readfirstlane(tid >> 6), lane = tid & 63, wr = wid >> 2, wc = wid & 3, fr = lane & 15, fq = lane >> 4;
    int K_ = g.K; asm volatile("" : "+s"(K_));
    const int K = K_, nt = K / BK;
    unsigned voffA[2], voffB[2];
#pragma unroll
    for (int i = 0; i < 2; ++i) { int R, C; stage_rc(tid * 16 + i * 8192, R, C); const int Rb = Epi::PERM ? ((R & ~31) + perm32(R & 31)) : R;
        voffA[i] = (unsigned)(R * g.lda + C) * 2u; voffB[i] = (unsigned)(Rb * g.ldb + C) * 2u; }
    const size_t kstep = (size_t)(BK * 2);
    const size_t hstepA = (size_t)HALF * g.lda * 2, hstepB = (size_t)HALF * g.ldb * 2;
    const size_t tstepA = 2 * hstepA, tstepB = 2 * hstepB;
    const unsigned ldsw = (unsigned)wid * 1024u;
    const int aoff = lds_byte(wr * 64 + fr, fq * 8), boff = lds_byte(wc * 32 + fr, fq * 8);
#define PG8_SA(b, h) (((b) * 2 + (h)) * HTB)
#define PG8_SB(b, h) ((4 + (b) * 2 + (h)) * HTB)
#define PG8_STAGE(bufoff, gbase, voff) do { _Pragma("unroll") for (int _i = 0; _i < 2; ++_i) \
        __builtin_amdgcn_global_load_lds((const unsigned*)((const char*)(gbase) + (voff)[_i]), (PG8_LAS unsigned*)(lds + (bufoff) + ldsw + _i * 8192), 16, 0, 0); } while (0)
#define PG8_LDA(dst, b, h) do { _Pragma("unroll") for (int m = 0; m < 4; ++m) _Pragma("unroll") for (int k = 0; k < 2; ++k) dst[m][k] = *(const PG8_LAS bf16x8*)(lds + PG8_SA(b, h) + aoff + m * 2048 + k * 1024); } while (0)
#define PG8_LDB(dst, b, h) do { _Pragma("unroll") for (int n = 0; n < 2; ++n) _Pragma("unroll") for (int k = 0; k < 2; ++k) dst[n][k] = *(const PG8_LAS bf16x8*)(lds + PG8_SB(b, h) + boff + n * 2048 + k * 1024); } while (0)
#define PG8_MMA(ai, bj, At, Bt) do { __builtin_amdgcn_s_setprio(1); _Pragma("unroll") for (int m = 0; m < 4; ++m) _Pragma("unroll") for (int n = 0; n < 2; ++n) _Pragma("unroll") for (int k = 0; k < 2; ++k) \
        acc[ai][bj][m][n] = __builtin_amdgcn_mfma_f32_16x16x32_bf16(Bt[n][k], At[m][k], acc[ai][bj][m][n], 0, 0, 0); __builtin_amdgcn_s_setprio(0); } while (0)
#define PG8_WAIT_V(n) asm volatile("s_waitcnt vmcnt(" #n ")" ::: "memory")
#define PG8_WAIT_L(n) asm volatile("s_waitcnt lgkmcnt(" #n ")" ::: "memory")
#define PG8_BAR __builtin_amdgcn_s_barrier()
#define PG8_SCHED __builtin_amdgcn_sched_barrier(0)
    Unit cur, nxt; int ui = 0;
    if (!S.next(0, cur)) return;
    f32x4 acc[2][2][4][2];
#pragma unroll
    for (int a = 0; a < 2; ++a)
#pragma unroll
        for (int b = 0; b < 2; ++b)
#pragma unroll
            for (int m = 0; m < 4; ++m)
#pragma unroll
                for (int n = 0; n < 2; ++n) acc[a][b][m][n] = (f32x4){0.f, 0.f, 0.f, 0.f};
    bf16x8 At[4][2], B0[2][2], B1[2][2];
    const char* cA = (const char*)g.A + (size_t)cur.pm * tstepA; const char* cB = (const char*)g.Bt + (size_t)cur.pn * tstepB;
    S.a_ready(cur);
    if constexpr (SP2) {
        PG8_STAGE(PG8_SB(0, 0), cB, voffB); PG8_STAGE(PG8_SB(0, 1), cB + hstepB, voffB); PG8_STAGE(PG8_SA(0, 0), cA, voffA); PG8_STAGE(PG8_SA(0, 1), cA + hstepA, voffA);
        if (wr == 1) PG8_BAR;
        PG8_WAIT_V(2); PG8_BAR;
        PG8_STAGE(PG8_SB(1, 0), cB + kstep, voffB); PG8_STAGE(PG8_SA(1, 0), cA + kstep, voffA); PG8_STAGE(PG8_SB(1, 1), cB + hstepB + kstep, voffB);
        PG8_WAIT_V(6); PG8_BAR;
    } else {
        PG8_STAGE(PG8_SB(0, 0), cB, voffB); PG8_STAGE(PG8_SA(0, 0), cA, voffA); PG8_STAGE(PG8_SB(0, 1), cB + hstepB, voffB); PG8_STAGE(PG8_SA(0, 1), cA + hstepA, voffA);
        if (wr == 1) PG8_BAR;
        PG8_WAIT_V(4); PG8_BAR;
        PG8_STAGE(PG8_SB(1, 0), cB + kstep, voffB); PG8_STAGE(PG8_SA(1, 0), cA + kstep, voffA); PG8_STAGE(PG8_SB(1, 1), cB + hstepB + kstep, voffB);
        PG8_WAIT_V(6); PG8_BAR;
    }
    for (;;) {
        const bool has_next = S.next(ui + 1, nxt);
        const char* nA = has_next ? (const char*)g.A + (size_t)nxt.pm * tstepA : cA; const char* nB = has_next ? (const char*)g.Bt + (size_t)nxt.pn * tstepB : cB;
        for (int t = 0; t < nt; t += 2) {
            if constexpr (Epi::HOOK_T > 0) { if (t == Epi::HOOK_T) { int frx = fr; asm volatile("" : "+v"(frx)); E.mid(acc, cur, wr, wc, frx, fq); } }
            const bool last = (t == nt - 2);
            const char* a1 = cA + (size_t)(t + 1) * kstep;
            const char* a2 = last ? nA : cA + (size_t)(t + 2) * kstep; const char* b2 = last ? nB : cB + (size_t)(t + 2) * kstep;
            const char* a3 = a2 + kstep; const char* b3 = b2 + kstep;
            if (last && has_next) S.a_ready(nxt);
            if constexpr (SP2) {
            PG8_LDB(B0, 0, 0); PG8_LDB(B1, 0, 1); PG8_SCHED; PG8_LDA(At, 0, 0); PG8_STAGE(PG8_SA(1, 1), a1 + hstepA, voffA);
            PG8_WAIT_V(8); PG8_WAIT_L(0); PG8_BAR; PG8_MMA(0, 0, At, B0); PG8_MMA(0, 1, At, B1); PG8_BAR; PG8_SCHED;
            PG8_LDA(At, 0, 1); PG8_STAGE(PG8_SB(0, 0), b2, voffB); PG8_STAGE(PG8_SB(0, 1), b2 + hstepB, voffB); PG8_STAGE(PG8_SA(0, 0), a2, voffA);
            PG8_WAIT_V(8); PG8_WAIT_L(0); PG8_BAR; PG8_MMA(1, 0, At, B0); PG8_MMA(1, 1, At, B1); PG8_BAR; PG8_SCHED;
            PG8_LDB(B0, 1, 0); PG8_LDB(B1, 1, 1); PG8_SCHED; PG8_LDA(At, 1, 0); PG8_STAGE(PG8_SA(0, 1), a2 + hstepA, voffA);
            PG8_WAIT_V(8); PG8_WAIT_L(0); PG8_BAR; PG8_MMA(0, 0, At, B0); PG8_MMA(0, 1, At, B1); PG8_BAR; PG8_SCHED;
            PG8_LDA(At, 1, 1); PG8_STAGE(PG8_SB(1, 0), b3, voffB); PG8_STAGE(PG8_SB(1, 1), b3 + hstepB, voffB); PG8_STAGE(PG8_SA(1, 0), a3, voffA);
            PG8_WAIT_V(8); PG8_WAIT_L(0); PG8_BAR; PG8_MMA(1, 0, At, B0); PG8_MMA(1, 1, At, B1); PG8_BAR; PG8_SCHED;
            } else {
            PG8_LDB(B0, 0, 0); PG8_SCHED; PG8_LDA(At, 0, 0); PG8_STAGE(PG8_SA(1, 1), a1 + hstepA, voffA);
            PG8_WAIT_L(8); PG8_BAR; PG8_WAIT_L(0); PG8_MMA(0, 0, At, B0); PG8_BAR; PG8_SCHED;
            PG8_LDB(B1, 0, 1); PG8_STAGE(PG8_SB(0, 0), b2, voffB);
            PG8_BAR; PG8_WAIT_L(0); PG8_MMA(0, 1, At, B1); PG8_BAR;
            PG8_LDA(At, 0, 1); PG8_STAGE(PG8_SA(0, 0), a2, voffA);
            PG8_BAR; PG8_WAIT_L(0); PG8_MMA(1, 0, At, B0); PG8_BAR; PG8_SCHED;
            PG8_STAGE(PG8_SB(0, 1), b2 + hstepB, voffB);
            PG8_WAIT_V(6); PG8_BAR; PG8_MMA(1, 1, At, B1); PG8_BAR;
            PG8_LDB(B0, 1, 0); PG8_SCHED; PG8_LDA(At, 1, 0); PG8_STAGE(PG8_SA(0, 1), a2 + hstepA, voffA);
            PG8_WAIT_L(8); PG8_BAR; PG8_WAIT_L(0); PG8_MMA(0, 0, At, B0); PG8_BAR; PG8_SCHED;
            PG8_LDB(B1, 1, 1); PG8_STAGE(PG8_SB(1, 0), b3, voffB);
            PG8_BAR; PG8_WAIT_L(0); PG8_MMA(0, 1, At, B1); PG8_BAR;
            PG8_LDA(At, 1, 1); PG8_STAGE(PG8_SA(1, 0), a3, voffA);
            PG8_BAR; PG8_WAIT_L(0); PG8_MMA(1, 0, At, B0); PG8_BAR; PG8_SCHED;
            PG8_STAGE(PG8_SB(1, 1), b3 + hstepB, voffB);
            PG8_WAIT_V(6); PG8_BAR; PG8_MMA(1, 1, At, B1); PG8_BAR;
            }
        }
        if constexpr (ALIGN_EPI) { if (wr == 0) PG8_BAR; }
        if constexpr (!Epi::AFTER_DRAIN) { int frx = fr; asm volatile("" : "+v"(frx)); E(acc, cur, wr, wc, frx, fq); S.done(cur); }
        if (!has_next) break;
#pragma unroll
        for (int a = 0; a < 2; ++a)
#pragma unroll
            for (int b = 0; b < 2; ++b)
#pragma unroll
                for (int m = 0; m < 4; ++m)
#pragma unroll
                    for (int n = 0; n < 2; ++n) acc[a][b][m][n] = (f32x4){0.f, 0.f, 0.f, 0.f};
        cur = nxt; cA = nA; cB = nB; ++ui;
        if constexpr (ALIGN_EPI) { if (wr == 1) PG8_BAR; }
    }
    PG8_WAIT_V(0);
    if constexpr (!ALIGN_EPI) { if (wr == 0) PG8_BAR; }
    PG8_BAR;
    if constexpr (Epi::AFTER_DRAIN) { E.fused(acc, cur, wr, wc, fr, fq, lds, wid, lane); S.done(cur); }
#undef PG8_SA
#undef PG8_SB
#undef PG8_STAGE
#undef PG8_LDA
#undef PG8_LDB
#undef PG8_MMA
#undef PG8_WAIT_V
#undef PG8_WAIT_L
#undef PG8_BAR
#undef PG8_SCHED
}
}

#define LAS __attribute__((address_space(3)))
typedef LAS unsigned char* ldsp;
typedef unsigned short bf16;
typedef _Float16 f16;
typedef float f32x4 __attribute__((ext_vector_type(4)));
typedef float f32x16 __attribute__((ext_vector_type(16)));
typedef short bf16x8 __attribute__((ext_vector_type(8)));
typedef unsigned u32x4 __attribute__((ext_vector_type(4)));
typedef unsigned u32x2 __attribute__((ext_vector_type(2)));

constexpr int T = 32768, DM = 1024, SEQ = 4096, DEPTH = 4, DFF = 2816, DIN = 5632;
constexpr size_t MiB = 1u << 20;
constexpr size_t WS_W0 = 2 * MiB, WS_WSTRIDE = 36 * MiB;
constexpr size_t WS_PB = 74 * MiB;
constexpr size_t WS_BX = 90 * MiB, WS_BU = 154 * MiB;
constexpr size_t WS_SSQA = 218 * MiB, WS_SSQB = 220 * MiB, WS_SSQC = 222 * MiB;
constexpr size_t WS_LB = 224 * MiB;
constexpr size_t WS_ADEC = 225 * MiB;
constexpr size_t WS_RQ = 226 * MiB, WS_RLF = 258 * MiB, WS_RI = 290 * MiB, WS_ROAB = 322 * MiB, WS_RAK = 386 * MiB, WS_RAVT = 418 * MiB, WS_RU = 450 * MiB;
constexpr size_t WS_GA = 226 * MiB, WS_GB = 450 * MiB, WS_MERGED = 386 * MiB, WS_HB = 226 * MiB;
constexpr size_t WS_END = 515 * MiB;
constexpr size_t WO_IN = 0, WO_AB = WO_IN + (size_t)DIN * 1024, WO_OUT = WO_AB + 1024 * 1024, WO_GU = WO_OUT + 1024 * 1024, WO_D = WO_GU + (size_t)DIN * 1024,
                 WO_PG = WO_D + (size_t)1024 * DFF, WO_PE = WO_PG + 1024 * 1024, WO_END = WO_PE + 1024 * 256;
static_assert(WO_END * 2 <= WS_WSTRIDE, "weight set");
constexpr int RING_BYTES = 131072, EPI_SCR = 139264, LDS_BYTES = 155648;

__device__ __forceinline__ unsigned pk2(float lo, float hi) { typedef float f2_ __attribute__((ext_vector_type(2))); typedef __bf16 b2_ __attribute__((ext_vector_type(2))); f2_ v = {lo, hi}; b2_ b = __builtin_convertvector(v, b2_); return __builtin_bit_cast(unsigned, b); }
__device__ __forceinline__ unsigned f2bf(float f) { return pk2(f, 0.f) & 0xffffu; }
__device__ __forceinline__ float b2f(unsigned h) { return __uint_as_float(h << 16); }
__device__ __forceinline__ float wave_sum(float v) {
#pragma unroll
    for (int o = 1; o < 64; o <<= 1) v += __shfl_xor(v, o);
    return v;
}

__device__ __forceinline__ int map_row(int mode, int n) {
    if (mode == 1) { if (n >= 2048 && n < 3072) { const int tile = n & ~255, o = n & 255, hd = o >> 6, d = o & 63; return tile + 128 * (d >> 5) + 32 * hd + (d & 31); } return n; }
    if (mode == 2) return (n >> 7) * 256 + (n & 127);
    if (mode == 3) return (n >> 7) * 256 + 128 + (n & 127);
    return n;
}
struct CvtP { const float* W; const float* gk; bf16* WT; int N, Kd, koff, mode, item; };
struct Ins { const float* in[19]; };
__device__ __forceinline__ CvtP cvt_params(const Ins& I, int l, bf16* Wb, int it) {
    constexpr int I_IN = 16 * 176, I_A = 8 * 32, I_O = 16 * 32, I_G = 16 * 88, I_D = 44 * 32, I_PG = 16 * 32;
    int r = it; CvtP p;
    if (r < I_IN) { p = CvtP{I.in[3] + (size_t)l * 1024 * DIN, I.in[2] + l * 1024, Wb + WO_IN, DIN, 1024, 0, 1, r}; return p; } r -= I_IN;
    if (r < I_A) { p = CvtP{I.in[9] + (size_t)l * 512 * 1024, nullptr, Wb + WO_AB, 1024, 1024, 0, 0, r}; return p; } r -= I_A;
    if (r < I_A) { p = CvtP{I.in[10] + (size_t)l * 512 * 1024, nullptr, Wb + WO_AB, 1024, 1024, 512, 0, r}; return p; } r -= I_A;
    if (r < I_O) { p = CvtP{I.in[11] + (size_t)l * 1024 * 1024, nullptr, Wb + WO_OUT, 1024, 1024, 0, 0, r}; return p; } r -= I_O;
    if (r < I_G) { p = CvtP{I.in[13] + (size_t)l * 1024 * DFF, I.in[12] + l * 1024, Wb + WO_GU, DFF, 1024, 0, 2, r}; return p; } r -= I_G;
    if (r < I_G) { p = CvtP{I.in[14] + (size_t)l * 1024 * DFF, I.in[12] + l * 1024, Wb + WO_GU, DFF, 1024, 0, 3, r}; return p; } r -= I_G;
    if (r < I_D) { p = CvtP{I.in[15] + (size_t)l * DFF * 1024, nullptr, Wb + WO_D, 1024, DFF, 0, 0, r}; return p; } r -= I_D;
    if (r < I_PG) { p = CvtP{I.in[17] + (size_t)l * 1024 * 1024, I.in[16] + l * 1024, Wb + WO_PG, 1024, 1024, 0, 0, r}; return p; } r -= I_PG;
    p = CvtP{I.in[18] + (size_t)l * 256 * 1024, nullptr, Wb + WO_PE, 1024, 256, 0, 0, r}; return p;
}
__device__ __forceinline__ void cvt_load(const CvtP& p, f32x4 (&wv)[8], float (&gv)[8], int lane) {
    const int nblk = p.N / 32, kb = p.item / nblk, nb = p.item % nblk, k0 = 64 * kb, n0 = 32 * nb;
#pragma unroll
    for (int i = 0; i < 8; ++i) { const int kk = 8 * i + (lane >> 3); wv[i] = *(const f32x4*)(p.W + (size_t)(k0 + kk) * p.N + n0 + 4 * (lane & 7)); gv[i] = p.gk ? p.gk[k0 + kk] : 1.f; }
}
__device__ __forceinline__ void cvt_store(const CvtP& p, const f32x4 (&wv)[8], const float (&gv)[8], LAS float* scr, int lane) {
    const int nblk = p.N / 32, kb = p.item / nblk, nb = p.item % nblk, k0 = 64 * kb, n0 = 32 * nb;
#pragma unroll
    for (int i = 0; i < 8; ++i) { const int kk = 8 * i + (lane >> 3); LAS float* d = scr + kk * 33 + 4 * (lane & 7);
        d[0] = wv[i][0] * gv[i]; d[1] = wv[i][1] * gv[i]; d[2] = wv[i][2] * gv[i]; d[3] = wv[i][3] * gv[i]; }
    asm volatile("s_waitcnt lgkmcnt(0)" ::: "memory");
    const int c = lane & 7;
#pragma unroll
    for (int j = 0; j < 4; ++j) { const int n = (lane >> 3) + 8 * j; const LAS float* s = scr + (8 * c) * 33 + n;
        u32x4 o; o.x = pk2(s[0 * 33], s[1 * 33]); o.y = pk2(s[2 * 33], s[3 * 33]); o.z = pk2(s[4 * 33], s[5 * 33]); o.w = pk2(s[6 * 33], s[7 * 33]);
        *(u32x4*)(p.WT + (size_t)map_row(p.mode, n0 + n) * p.Kd + p.koff + k0 + 8 * c) = o; }
    asm volatile("s_waitcnt lgkmcnt(0)" ::: "memory");
}
__device__ __forceinline__ void cvt_weights(const Ins& I, int l, bf16* Wb, ldsp L, int wave, int lane) {
    LAS float* scr = (LAS float*)(L + wave * 16384);
    const int gw = blockIdx.x * 8 + wave, NGW = gridDim.x * 8;
    constexpr int NIT = 16 * 176 + 2 * 8 * 32 + 16 * 32 + 2 * 16 * 88 + 44 * 32 + 16 * 32 + 4 * 32;
    if (gw >= NIT) return;
    CvtP pc = cvt_params(I, l, Wb, gw); f32x4 wa[8]; float ga[8];
    cvt_load(pc, wa, ga, lane);
#pragma unroll 1
    for (int it = gw; it < NIT; it += NGW) {
        const int nx = it + NGW < NIT ? it + NGW : it;
        const CvtP pn = cvt_params(I, l, Wb, nx); f32x4 wb[8]; float gb[8];
        cvt_load(pn, wb, gb, lane);
        __builtin_amdgcn_sched_barrier(0);
        cvt_store(pc, wa, ga, scr, lane);
        pc = pn;
#pragma unroll
        for (int i = 0; i < 8; ++i) { wa[i] = wb[i]; ga[i] = gb[i]; }
    }
}
__device__ __forceinline__ void cvt_p(const float* p, bf16* PB, int tid_in) {
    int tid_ = tid_in; asm volatile("" : "+v"(tid_));
    const size_t n8 = (size_t)T * 256 / 8; const size_t gt = (size_t)blockIdx.x * 512 + tid_, NT = (size_t)gridDim.x * 512;
    for (size_t i0 = gt; i0 < n8; i0 += 4 * NT) {
        f32x4 a[4], b[4];
#pragma unroll
        for (int u = 0; u < 4; ++u) { const size_t i = i0 + u * NT; if (i < n8) { a[u] = *(const f32x4*)(p + i * 8); b[u] = *(const f32x4*)(p + i * 8 + 4); } }
#pragma unroll
        for (int u = 0; u < 4; ++u) { const size_t i = i0 + u * NT; if (i < n8) { u32x4 o; o.x = pk2(a[u][0], a[u][1]); o.y = pk2(a[u][2], a[u][3]); o.z = pk2(b[u][0], b[u][1]); o.w = pk2(b[u][2], b[u][3]); *(u32x4*)(PB + i * 8) = o; } } }
}
__device__ __forceinline__ void cvt_x(const float* x, bf16* XB, float* ssq, int wave, int lane) {
    const int gw = blockIdx.x * 8 + wave, NGW = gridDim.x * 8;
    for (int row0 = gw; row0 < T; row0 += 4 * NGW) {
        f32x4 v[4][4];
#pragma unroll
        for (int u = 0; u < 4; ++u) { const int row = row0 + u * NGW; if (row < T) { const f32x4* xr = (const f32x4*)(x + (size_t)row * 1024) + lane;
#pragma unroll
            for (int j = 0; j < 4; ++j) v[u][j] = xr[64 * j]; } }
#pragma unroll
        for (int u = 0; u < 4; ++u) { const int row = row0 + u * NGW; if (row < T) { float s = 0.f;
#pragma unroll
            for (int j = 0; j < 4; ++j) s += (v[u][j][0] * v[u][j][0] + v[u][j][1] * v[u][j][1]) + (v[u][j][2] * v[u][j][2] + v[u][j][3] * v[u][j][3]);
            s = wave_sum(s);
            u32x2* o = (u32x2*)(XB + (size_t)row * 1024) + lane;
#pragma unroll
            for (int j = 0; j < 4; ++j) { u32x2 w; w.x = pk2(v[u][j][0], v[u][j][1]); w.y = pk2(v[u][j][2], v[u][j][3]); o[64 * j] = w; }
            if (lane < 16) ssq[(size_t)row * 16 + lane] = lane == 0 ? s : 0.f; } }
    }
}

#define MFMA16(a, b, c) __builtin_amdgcn_mfma_f32_16x16x32_bf16((a), (b), (c), 0, 0, 0)
#define MFMA32(a, b, c) __builtin_amdgcn_mfma_f32_32x32x16_bf16((a), (b), (c), 0, 0, 0)
__device__ __forceinline__ void hgrn_stageA(ldsp L, int item_first, int item_step, bf16* RQ, const f16* RLF, bf16* RI, bf16* U, float* ADEC, int tid_in) {
    constexpr int QS = 0, KS = 17408, KT = 34816, IT = 53248, AS = 71680, TOT = 80896;
    int tid_ = tid_in; asm volatile("" : "+v"(tid_));
    const int tid = tid_, lane = tid & 63, w = __builtin_amdgcn_readfirstlane(tid >> 6), fr = lane & 15, fq = lane >> 4;
    const int k = tid & 127, tq = tid >> 7;
    unsigned short lfn[16], qn[16], in_[16];
#define SA_LOAD(item_) do { const int bh_ = (item_) >> 6, c_ = (item_) & 63; const size_t r_ = (size_t)(bh_ >> 2) * SEQ + c_ * 64 + 16 * tq; const int hc_ = (bh_ & 3) * 128; \
        const unsigned short* lp_ = (const unsigned short*)RLF + r_ * 512 + hc_ + k; const bf16* qp_ = RQ + r_ * 512 + hc_ + k; const bf16* ip_ = RI + r_ * 512 + hc_ + k; \
        _Pragma("unroll") for (int j = 0; j < 16; ++j) { lfn[j] = lp_[(size_t)j * 512]; qn[j] = qp_[(size_t)j * 512]; in_[j] = ip_[(size_t)j * 512]; } } while (0)
#define SA_BAR() asm volatile("s_waitcnt lgkmcnt(0)\n\ts_barrier" ::: "memory")
    SA_LOAD(item_first);
    float lf[16]; unsigned qraw[16], iraw[16];
#define SA_CONSUME() do { _Pragma("unroll") for (int j = 0; j < 16; ++j) { lf[j] = (float)__builtin_bit_cast(_Float16, lfn[j]); qraw[j] = qn[j]; iraw[j] = in_[j]; } } while (0)
    SA_CONSUME();
#pragma unroll 1
    for (int item = item_first; item < 2048; item += item_step) {
    const int bh = item >> 6, c = item & 63, b = bh >> 2, h = bh & 3, hc = h * 128;
    const size_t row0 = (size_t)b * SEQ + c * 64;
    bf16* qp = RQ + (row0 + 16 * tq) * 512 + hc + k;
    float cs[16];
    { const int nxt_ = item + item_step < 2048 ? item + item_step : item; SA_LOAD(nxt_); }
    __builtin_amdgcn_sched_barrier(0);
    { float run = 0.f;
#pragma unroll
      for (int j = 0; j < 16; ++j) { run += lf[j]; cs[j] = run; } }
    ((LAS float*)(L + TOT))[tq * 128 + k] = cs[15];
    SA_BAR();
    const float t0 = ((LAS float*)(L + TOT))[k], t1 = ((LAS float*)(L + TOT))[128 + k], t2 = ((LAS float*)(L + TOT))[256 + k], t3 = ((LAS float*)(L + TOT))[384 + k];
    const float off = tq == 0 ? 0.f : (tq == 1 ? t0 : (tq == 2 ? t0 + t1 : (t0 + t1) + t2));
    const float bmid = t0 + t1, blast = (t0 + t1) + (t2 + t3);
    unsigned kt[16];
    const float c_last = __expf(blast - bmid), c_mid = __expf(bmid);
#pragma unroll
    for (int j = 0; j < 16; ++j) {
        const float bb = off + cs[j]; const float q = b2f(qraw[j]) * 0.08838834764831845f; const float kk = 1.f - __expf(lf[j]);
        const float ee = __expf(fminf(fmaxf(bb - bmid, -60.f), 60.f)), ei = __builtin_amdgcn_rcpf(ee);
        const float qpv = q * ee, kpv = kk * ei, kpp = kpv * c_last, qe = qpv * c_mid;
        const int t = 16 * tq + j;
        *(LAS unsigned short*)(L + QS + t * 272 + k * 2) = (unsigned short)f2bf(qpv);
        *(LAS unsigned short*)(L + KS + t * 272 + k * 2) = (unsigned short)f2bf(kpv);
        kt[j] = f2bf(kpp);
        qp[(size_t)j * 512] = (bf16)f2bf(qe);
    }
    { u32x4 a, bq;
      a.x = kt[0] | (kt[1] << 16); a.y = kt[2] | (kt[3] << 16); a.z = kt[4] | (kt[5] << 16); a.w = kt[6] | (kt[7] << 16);
      bq.x = kt[8] | (kt[9] << 16); bq.y = kt[10] | (kt[11] << 16); bq.z = kt[12] | (kt[13] << 16); bq.w = kt[14] | (kt[15] << 16);
      *(LAS u32x4*)(L + KT + k * 144 + tq * 32) = a; *(LAS u32x4*)(L + KT + k * 144 + tq * 32 + 16) = bq;
      a.x = iraw[0] | (iraw[1] << 16); a.y = iraw[2] | (iraw[3] << 16); a.z = iraw[4] | (iraw[5] << 16); a.w = iraw[6] | (iraw[7] << 16);
      bq.x = iraw[8] | (iraw[9] << 16); bq.y = iraw[10] | (iraw[11] << 16); bq.z = iraw[12] | (iraw[13] << 16); bq.w = iraw[14] | (iraw[15] << 16);
      *(LAS u32x4*)(L + IT + k * 144 + tq * 32) = a; *(LAS u32x4*)(L + IT + k * 144 + tq * 32 + 16) = bq; }
    if (tq == 0) ADEC[(size_t)item * 128 + k] = __expf(blast);
    SA_BAR();
    { const int tb = w >> 1;
#pragma unroll
      for (int sbi = 0; sbi < 2; ++sbi) { const int sb = 2 * (w & 1) + sbi; f32x4 acc = {0.f, 0.f, 0.f, 0.f};
          if (sb <= tb) {
#pragma unroll
              for (int kk = 0; kk < 4; ++kk) { const bf16x8 a = *(const LAS bf16x8*)(L + QS + (16 * tb + fr) * 272 + (32 * kk + 8 * fq) * 2), bb = *(const LAS bf16x8*)(L + KS + (16 * sb + fr) * 272 + (32 * kk + 8 * fq) * 2);
                  acc = MFMA16(a, bb, acc); } }
#pragma unroll
          for (int r = 0; r < 4; ++r) { const int t = 16 * tb + 4 * fq + r, s = 16 * sb + fr; const float v = (sb <= tb && t >= s) ? acc[r] : 0.f;
              *(LAS unsigned short*)(L + AS + t * 144 + s * 2) = (unsigned short)f2bf(v); } } }
    SA_BAR();
    { const int v = 16 * w + fr;
      u32x2 o2[4], u3[8];
      bf16x8 ib[2];
#pragma unroll
      for (int ks = 0; ks < 2; ++ks) ib[ks] = *(const LAS bf16x8*)(L + IT + v * 144 + (32 * ks + 8 * fq) * 2);
#pragma unroll
      for (int tb = 0; tb < 4; ++tb) { f32x4 acc = {0.f, 0.f, 0.f, 0.f};
#pragma unroll
          for (int ks = 0; ks < 2; ++ks) { const bf16x8 a = *(const LAS bf16x8*)(L + AS + (16 * tb + fr) * 144 + (32 * ks + 8 * fq) * 2); acc = MFMA16(a, ib[ks], acc); }
          o2[tb].x = pk2(acc[0], acc[1]); o2[tb].y = pk2(acc[2], acc[3]); }
#pragma unroll
      for (int kb = 0; kb < 8; ++kb) { f32x4 acc = {0.f, 0.f, 0.f, 0.f};
#pragma unroll
          for (int ks = 0; ks < 2; ++ks) { const bf16x8 a = *(const LAS bf16x8*)(L + KT + (16 * kb + fr) * 144 + (32 * ks + 8 * fq) * 2); acc = MFMA16(a, ib[ks], acc); }
          u3[kb].x = pk2(acc[0], acc[1]); u3[kb].y = pk2(acc[2], acc[3]); }
      SA_CONSUME();
      __builtin_amdgcn_sched_barrier(0);
#pragma unroll
      for (int tb = 0; tb < 4; ++tb) *(u32x2*)(RI + (row0 + (v >> 1)) * 512 + hc + (v & 1) * 64 + 16 * tb + 4 * fq) = o2[tb];
#pragma unroll
      for (int kb = 0; kb < 8; ++kb) *(u32x2*)(U + (size_t)item * 16384 + v * 128 + 16 * kb + 4 * fq) = u3[kb]; }
    SA_BAR();
    }
#undef SA_LOAD
#undef SA_CONSUME
#undef SA_BAR
}

template <int CTRL> __device__ __forceinline__ float dppf(float v) { return __builtin_bit_cast(float, __builtin_amdgcn_update_dpp(0, __builtin_bit_cast(int, v), CTRL, 0xf, 0xf, true)); }
__device__ __forceinline__ float row_sum16(float s) { s += dppf<0xB1>(s); s += dppf<0x4E>(s); s += dppf<0x124>(s); s += dppf<0x128>(s); return s; }
__device__ __forceinline__ unsigned cvtpk(float lo, float hi) { typedef float f2 __attribute__((ext_vector_type(2))); typedef __bf16 b2 __attribute__((ext_vector_type(2))); f2 v = {lo, hi}; b2 b = __builtin_convertvector(v, b2); return __builtin_bit_cast(unsigned, b); }
template <int GLOBAL_OUT> __device__ __forceinline__ void hgrn_scan_wave(ldsp L, bf16* OINT, int bh, int vs, const bf16* RQ, const bf16* U, const float* ADEC, int lane_in) {
    int lane = lane_in; asm volatile("" : "+v"(lane));
    const int fr = lane & 15, fq = lane >> 4;
    const int b = bh >> 2, h = bh & 3, hc = h * 128, v = 16 * vs + fr;
    float S[4][8];
#pragma unroll
    for (int kb = 0; kb < 4; ++kb)
#pragma unroll
        for (int j = 0; j < 8; ++j) S[kb][j] = 0.f;
    const bf16* pq = RQ + ((size_t)b * SEQ + fr) * 512 + hc + 8 * fq;
    const bf16* pu = U + (size_t)bh * 64 * 16384 + v * 128 + 8 * fq;
    const float* pa = ADEC + (size_t)bh * 64 * 128 + 8 * fq;
    bf16* pg = OINT + (size_t)bh * 64 * 8192 + v * 64 + 4 * fq;
    ldsp po = L + fr * 128 + 8 * fq;
    bf16x8 Aq[4][4]; u32x4 Uv[4]; f32x4 av[4][2];
#pragma unroll
    for (int tb = 0; tb < 4; ++tb)
#pragma unroll
        for (int kb = 0; kb < 4; ++kb) Aq[tb][kb] = *(const bf16x8*)(pq + tb * 16 * 512 + kb * 32);
#pragma unroll
    for (int kb = 0; kb < 4; ++kb) { Uv[kb] = *(const u32x4*)(pu + kb * 32); av[kb][0] = *(const f32x4*)(pa + kb * 32); av[kb][1] = *(const f32x4*)(pa + kb * 32 + 4); }
    const unsigned* tq_ = (const unsigned*)(RQ + ((size_t)b * SEQ + lane) * 512 + hc);
    const unsigned* tu_ = (const unsigned*)(U + (size_t)bh * 64 * 16384 + (16 * vs + (lane & 15)) * 128 + ((lane >> 4) & 1) * 64);
    unsigned tch0 = 0, tch1 = 0, tch2 = 0;
#pragma unroll 1
    for (int c = 0; c < 64; ++c) {
        pq += 64 * 512; pu += 16384; pa += 128;
        asm volatile("" :: "v"(tch0), "v"(tch1), "v"(tch2));
        { const int cp = c + 3 < 64 ? c + 3 : 63;
          tch0 = tq_[(size_t)cp * 64 * 256]; tch1 = tq_[(size_t)cp * 64 * 256 + 32]; tch2 = tu_[(size_t)cp * 8192]; }
        __builtin_amdgcn_sched_barrier(0);
        bf16x8 Sb[4];
#pragma unroll
        for (int kb = 0; kb < 4; ++kb) { u32x4 t; t.x = cvtpk(S[kb][0], S[kb][1]); t.y = cvtpk(S[kb][2], S[kb][3]); t.z = cvtpk(S[kb][4], S[kb][5]); t.w = cvtpk(S[kb][6], S[kb][7]); Sb[kb] = __builtin_bit_cast(bf16x8, t); }
#pragma unroll
        for (int tb = 0; tb < 4; ++tb) { f32x4 acc = {0.f, 0.f, 0.f, 0.f};
#pragma unroll
            for (int kb = 0; kb < 4; ++kb) acc = MFMA16(Aq[tb][kb], Sb[kb], acc);
#pragma unroll
            for (int kb = 0; kb < 4; ++kb) Aq[tb][kb] = *(const bf16x8*)(pq + tb * 16 * 512 + kb * 32);
            u32x2 o; o.x = cvtpk(acc[0], acc[1]); o.y = cvtpk(acc[2], acc[3]);
            if (GLOBAL_OUT) *(u32x2*)(pg + tb * 16) = o; else *(LAS u32x2*)(po + tb * 32) = o;
            __builtin_amdgcn_sched_barrier(0); }
        po += 2048; pg += 8192;
#pragma unroll
        for (int kb = 0; kb < 4; ++kb) {
            S[kb][0] = av[kb][0][0] * S[kb][0] + b2f(Uv[kb].x & 0xffffu); S[kb][1] = av[kb][0][1] * S[kb][1] + b2f(Uv[kb].x >> 16);
            S[kb][2] = av[kb][0][2] * S[kb][2] + b2f(Uv[kb].y & 0xffffu); S[kb][3] = av[kb][0][3] * S[kb][3] + b2f(Uv[kb].y >> 16);
            S[kb][4] = av[kb][1][0] * S[kb][4] + b2f(Uv[kb].z & 0xffffu); S[kb][5] = av[kb][1][1] * S[kb][5] + b2f(Uv[kb].z >> 16);
            S[kb][6] = av[kb][1][2] * S[kb][6] + b2f(Uv[kb].w & 0xffffu); S[kb][7] = av[kb][1][3] * S[kb][7] + b2f(Uv[kb].w >> 16);
            Uv[kb] = *(const u32x4*)(pu + kb * 32); av[kb][0] = *(const f32x4*)(pa + kb * 32); av[kb][1] = *(const f32x4*)(pa + kb * 32 + 4); }
        __builtin_amdgcn_sched_barrier(0);
    }
}
template <int GLOBAL_OUT> __device__ __forceinline__ void hgrn_scan_wave4(ldsp L, bf16* OINT, int bh, int vs, int tb, const bf16* RQ, const bf16* U, const float* ADEC, int lane_in) {
    int lane = lane_in; asm volatile("" : "+v"(lane));
    const int fr = lane & 15, fq = lane >> 4;
    const int b = bh >> 2, h = bh & 3, hc = h * 128, v = 16 * vs + fr;
    float S[4][8];
#pragma unroll
    for (int kb = 0; kb < 4; ++kb)
#pragma unroll
        for (int j = 0; j < 8; ++j) S[kb][j] = 0.f;
    const bf16* pq = RQ + ((size_t)b * SEQ + 16 * tb + fr) * 512 + hc + 8 * fq;
    const bf16* pu = U + (size_t)bh * 64 * 16384 + v * 128 + 8 * fq;
    const float* pa = ADEC + (size_t)bh * 64 * 128 + 8 * fq;
    ldsp po = L + fr * 128 + 8 * fq + tb * 32;
    bf16* pg = OINT + (size_t)bh * 64 * 8192 + v * 64 + 4 * fq + tb * 16;
    bf16x8 A0[4], A1[4]; u32x4 U0[4], U1[4]; f32x4 a0[4][2], a1[4][2];
#define SC_LOAD(A_, U_, a_, cc) do { _Pragma("unroll") for (int kb = 0; kb < 4; ++kb) { A_[kb] = *(const bf16x8*)(pq + (size_t)(cc) * 64 * 512 + kb * 32); \
        U_[kb] = *(const u32x4*)(pu + (size_t)(cc) * 16384 + kb * 32); a_[kb][0] = *(const f32x4*)(pa + (size_t)(cc) * 128 + kb * 32); a_[kb][1] = *(const f32x4*)(pa + (size_t)(cc) * 128 + kb * 32 + 4); } } while (0)
#define SC_STEP(A_, U_, a_, cc) do { bf16x8 Sb[4]; \
        _Pragma("unroll") for (int kb = 0; kb < 4; ++kb) { u32x4 t; t.x = cvtpk(S[kb][0], S[kb][1]); t.y = cvtpk(S[kb][2], S[kb][3]); t.z = cvtpk(S[kb][4], S[kb][5]); t.w = cvtpk(S[kb][6], S[kb][7]); Sb[kb] = __builtin_bit_cast(bf16x8, t); } \
        f32x4 acc = {0.f, 0.f, 0.f, 0.f}; \
        _Pragma("unroll") for (int kb = 0; kb < 4; ++kb) acc = MFMA16(A_[kb], Sb[kb], acc); \
        _Pragma("unroll") for (int kb = 0; kb < 4; ++kb) { \
            S[kb][0] = a_[kb][0][0] * S[kb][0] + b2f(U_[kb].x & 0xffffu); S[kb][1] = a_[kb][0][1] * S[kb][1] + b2f(U_[kb].x >> 16); \
            S[kb][2] = a_[kb][0][2] * S[kb][2] + b2f(U_[kb].y & 0xffffu); S[kb][3] = a_[kb][0][3] * S[kb][3] + b2f(U_[kb].y >> 16); \
            S[kb][4] = a_[kb][1][0] * S[kb][4] + b2f(U_[kb].z & 0xffffu); S[kb][5] = a_[kb][1][1] * S[kb][5] + b2f(U_[kb].z >> 16); \
            S[kb][6] = a_[kb][1][2] * S[kb][6] + b2f(U_[kb].w & 0xffffu); S[kb][7] = a_[kb][1][3] * S[kb][7] + b2f(U_[kb].w >> 16); } \
        __builtin_amdgcn_sched_barrier(0); \
        SC_LOAD(A_, U_, a_, (cc) + 2); \
        { u32x2 o; o.x = cvtpk(acc[0], acc[1]); o.y = cvtpk(acc[2], acc[3]); if (GLOBAL_OUT) *(u32x2*)(pg + (size_t)(cc) * 8192) = o; else *(LAS u32x2*)(po + (cc) * 2048) = o; } \
        __builtin_amdgcn_sched_barrier(0); } while (0)
    SC_LOAD(A0, U0, a0, 0); SC_LOAD(A1, U1, a1, 1);
#pragma unroll 1
    for (int c = 0; c < 64; c += 2) { SC_STEP(A0, U0, a0, c); SC_STEP(A1, U1, a1, c + 1); }
#undef SC_LOAD
#undef SC_STEP
}
__device__ __forceinline__ void hgrn_post(ldsp L, const bf16* OINT, const bf16* RI, bf16* ROAB, const float* gn, int wave, int lane_in) {
    int lane = lane_in; asm volatile("" : "+v"(lane));
    LAS float* tl = (LAS float*)(L + wave * 16384);
    const int t = lane >> 2, q = lane & 3;
    const int gw = blockIdx.x * 8 + wave, NGW = gridDim.x * 8;
    f32x4 gnv[8];
#pragma unroll
    for (int i = 0; i < 8; ++i) gnv[i] = *(const f32x4*)(gn + 32 * q + 4 * i);
#pragma unroll 1
    for (int task = gw; task < 8192; task += NGW) {
        const int item = task >> 2, tb = task & 3; const int bh = item >> 6, c = item & 63, b = bh >> 2, h = bh & 3, hc = h * 128;
        const size_t row0 = (size_t)b * SEQ + c * 64;
        bf16* op = ROAB + (row0 + 16 * tb + t) * 1024 + hc + 32 * q;
        u32x4 sgw4[4];
#pragma unroll
        for (int i = 0; i < 4; ++i) sgw4[i] = *(const u32x4*)(op + 8 * i);
#pragma unroll
        for (int hv = 0; hv < 2; ++hv) { const int v = lane + 64 * hv;
            const u32x4* p1 = (const u32x4*)(OINT + (size_t)item * 8192 + v * 64 + 16 * tb);
            const u32x4* p2 = (const u32x4*)(RI + (row0 + (v >> 1)) * 512 + hc + (v & 1) * 64 + 16 * tb);
            const u32x4 a0 = p1[0], a1 = p1[1], b0 = p2[0], b1 = p2[1];
            const unsigned wa[8] = {a0.x, a0.y, a0.z, a0.w, a1.x, a1.y, a1.z, a1.w}; const unsigned wb[8] = {b0.x, b0.y, b0.z, b0.w, b1.x, b1.y, b1.z, b1.w};
#pragma unroll
            for (int i = 0; i < 8; ++i) { tl[(2 * i) * 132 + v] = b2f(wa[i] & 0xffffu) + b2f(wb[i] & 0xffffu); tl[(2 * i + 1) * 132 + v] = b2f(wa[i] >> 16) + b2f(wb[i] >> 16); } }
        asm volatile("s_waitcnt lgkmcnt(0)" ::: "memory");
        f32x4 x[8]; float s = 0.f;
#pragma unroll
        for (int i = 0; i < 8; ++i) { x[i] = *(const LAS f32x4*)(tl + t * 132 + 32 * q + 4 * i); s += (x[i][0] * x[i][0] + x[i][1] * x[i][1]) + (x[i][2] * x[i][2] + x[i][3] * x[i][3]); }
        s += dppf<0xB1>(s); s += dppf<0x4E>(s);
        const float rinv = __builtin_amdgcn_rsqf(s * (1.0f / 128.0f) + 1e-6f);
#pragma unroll
        for (int i = 0; i < 4; ++i) { const u32x4 sgw = sgw4[i]; const f32x4 g0 = gnv[2 * i], g1 = gnv[2 * i + 1];
            const f32x4 xa = x[2 * i], xb = x[2 * i + 1]; u32x4 o;
            o.x = cvtpk(xa[0] * rinv * g0[0] * b2f(sgw.x & 0xffffu), xa[1] * rinv * g0[1] * b2f(sgw.x >> 16)); o.y = cvtpk(xa[2] * rinv * g0[2] * b2f(sgw.y & 0xffffu), xa[3] * rinv * g0[3] * b2f(sgw.y >> 16));
            o.z = cvtpk(xb[0] * rinv * g1[0] * b2f(sgw.z & 0xffffu), xb[1] * rinv * g1[1] * b2f(sgw.z >> 16)); o.w = cvtpk(xb[2] * rinv * g1[2] * b2f(sgw.w & 0xffffu), xb[3] * rinv * g1[3] * b2f(sgw.w >> 16));
            *(u32x4*)(op + 8 * i) = o; }
        asm volatile("s_waitcnt lgkmcnt(0)" ::: "memory");
    }
}

constexpr int AT_TAB = 0, AT_WS = 8 * 260 * 4;
__device__ __forceinline__ void attn_item(ldsp L, int wi, bf16* ROAB, const bf16* RAK, const bf16* RAVT, int w, int lane_) {
    int lane = lane_; asm volatile("" : "+v"(lane));
    const int half = wi & 1, h = (wi >> 1) & 7, n = (wi >> 4) & 63, b = wi >> 10;
    const int r32 = lane & 31, hi = lane >> 5;
    const size_t row0 = (size_t)b * SEQ + n * 64 + half * 32;
    bf16x8 qr[4];
#pragma unroll
    for (int d0 = 0; d0 < 4; ++d0) qr[d0] = *(const bf16x8*)(ROAB + (row0 + r32) * 1024 + 512 + h * 64 + 16 * d0 + 8 * hi);
    const LAS float* tab = (const LAS float*)(L + AT_TAB) + h * 260;
    LAS float* wsf = (LAS float*)(L + AT_WS) + w * 64;
    f32x16 o0, o1;
#pragma unroll
    for (int r = 0; r < 16; ++r) { o0[r] = 0.f; o1[r] = 0.f; }
    float mrun = -1e30f, lrun = 0.f;
    const bf16* kbase = RAK + ((size_t)(b * 8 + h) * 64) * 4096 + lane * 8;
    const bf16* vbase = RAVT + ((size_t)(b * 8 + h) * 64) * 4096 + lane * 8;
    const int tqpos = half * 32 + r32;
    const float cfar = tab[256];
    const int jstart = n >= 8 ? 0 : 8 - n;
    bf16x8 kf[2][4], vf[2][2][2];
#define ATT_LOAD(KF, VF, kc_) do { \
        _Pragma("unroll") for (int kh = 0; kh < 2; ++kh) _Pragma("unroll") for (int d0 = 0; d0 < 4; ++d0) KF[kh][d0] = *(const bf16x8*)(kbase + (size_t)(kc_) * 4096 + (kh * 4 + d0) * 512); \
        _Pragma("unroll") for (int dh = 0; dh < 2; ++dh) _Pragma("unroll") for (int kh = 0; kh < 2; ++kh) _Pragma("unroll") for (int blk = 0; blk < 2; ++blk) \
            VF[dh][kh][blk] = *(const bf16x8*)(vbase + (size_t)(kc_) * 4096 + ((dh * 2 + kh) * 2 + blk) * 512); } while (0)
    ATT_LOAD(kf, vf, n - 8 + jstart);
#pragma unroll 1
    for (int j = jstart; j <= 8; ++j) {
        bf16x8 kn[2][4], vn[2][2][2];
        { const int kcn = j < 8 ? n - 8 + j + 1 : n; ATT_LOAD(kn, vn, kcn); }
        __builtin_amdgcn_sched_barrier(0);
        f32x16 p0, p1;
#pragma unroll
        for (int r = 0; r < 16; ++r) { p0[r] = 0.f; p1[r] = 0.f; }
#pragma unroll
        for (int d0 = 0; d0 < 4; ++d0) { p0 = MFMA32(kf[0][d0], qr[d0], p0); p1 = MFMA32(kf[1][d0], qr[d0], p1); }
        float sub;
        if (j <= 5) { sub = mrun - cfar; }
        else {
            const int base = tqpos - ((j - 8) * 64 + 16 * hi) + 128;
#pragma unroll
            for (int r = 0; r < 16; ++r) { int i0 = base - r, i1 = base - r - 32; i0 = i0 < 0 ? 0 : (i0 > 256 ? 256 : i0); i1 = i1 < 0 ? 0 : (i1 > 256 ? 256 : i1);
                p0[r] += tab[i0]; p1[r] += tab[i1]; }
            sub = mrun;
        }
        if (j == jstart) {
            float mx = fmaxf(p0[0], p1[0]);
#pragma unroll
            for (int r = 1; r < 16; ++r) mx = fmaxf(mx, fmaxf(p0[r], p1[r]));
            mx = fmaxf(mx, shx(mx, lane, 32));
            if (j <= 5) { mrun = mx + cfar; sub = mx; } else { mrun = mx; sub = mx; }
        }
        float rs = 0.f;
#pragma unroll
        for (int r = 0; r < 16; ++r) { p0[r] = __builtin_amdgcn_exp2f(p0[r] - sub); p1[r] = __builtin_amdgcn_exp2f(p1[r] - sub); rs += p0[r] + p1[r]; }
        lrun += rs;
        bf16x8 pa[2][2];
        { u32x4 t;
          t.x = pk2(p0[0], p0[1]); t.y = pk2(p0[2], p0[3]); t.z = pk2(p0[4], p0[5]); t.w = pk2(p0[6], p0[7]); pa[0][0] = __builtin_bit_cast(bf16x8, t);
          t.x = pk2(p0[8], p0[9]); t.y = pk2(p0[10], p0[11]); t.z = pk2(p0[12], p0[13]); t.w = pk2(p0[14], p0[15]); pa[0][1] = __builtin_bit_cast(bf16x8, t);
          t.x = pk2(p1[0], p1[1]); t.y = pk2(p1[2], p1[3]); t.z = pk2(p1[4], p1[5]); t.w = pk2(p1[6], p1[7]); pa[1][0] = __builtin_bit_cast(bf16x8, t);
          t.x = pk2(p1[8], p1[9]); t.y = pk2(p1[10], p1[11]); t.z = pk2(p1[12], p1[13]); t.w = pk2(p1[14], p1[15]); pa[1][1] = __builtin_bit_cast(bf16x8, t); }
#pragma unroll
        for (int kh = 0; kh < 2; ++kh)
#pragma unroll
            for (int blk = 0; blk < 2; ++blk) { o0 = MFMA32(pa[kh][blk], vf[0][kh][blk], o0); o1 = MFMA32(pa[kh][blk], vf[1][kh][blk], o1); }
#pragma unroll
        for (int kh = 0; kh < 2; ++kh) {
#pragma unroll
            for (int d0 = 0; d0 < 4; ++d0) kf[kh][d0] = kn[kh][d0];
#pragma unroll
            for (int dh = 0; dh < 2; ++dh)
#pragma unroll
                for (int blk = 0; blk < 2; ++blk) vf[dh][kh][blk] = vn[dh][kh][blk]; }
    }
#undef ATT_LOAD
    lrun += shx(lrun, lane, 32);
    if (hi == 0) wsf[32 + r32] = __builtin_amdgcn_rcpf(lrun);
#pragma unroll
    for (int g = 0; g < 4; ++g) { const f32x4 s4 = *(const LAS f32x4*)(wsf + 32 + 8 * g + 4 * hi);
#pragma unroll
        for (int e = 0; e < 4; ++e) { const int q = e + 8 * g + 4 * hi; bf16* op = ROAB + (row0 + q) * 1024 + 512 + h * 64 + r32;
            op[0] = (bf16)f2bf(o0[4 * g + e] * s4[e]); op[32] = (bf16)f2bf(o1[4 * g + e] * s4[e]); } }
}

__device__ __forceinline__ void attn_item2(ldsp L, int ci, bf16* ROAB, const bf16* RAK, const bf16* RAVT, int w, int lane_) {
    int lane = lane_; asm volatile("" : "+v"(lane));
    const int h = ci & 7, n = (ci >> 3) & 63, b = ci >> 9;
    const int r32 = lane & 31, hi = lane >> 5;
    const size_t row0 = (size_t)b * SEQ + n * 64;
    ldsp qs = L + 16384 + w * 8192 + lane * 16;
#pragma unroll
    for (int hh = 0; hh < 2; ++hh)
#pragma unroll
        for (int d0 = 0; d0 < 4; ++d0) *(LAS bf16x8*)(qs + (hh * 4 + d0) * 1024) = *(const bf16x8*)(ROAB + (row0 + 32 * hh + r32) * 1024 + 512 + h * 64 + 16 * d0 + 8 * hi);
    const LAS float* tab = (const LAS float*)(L + AT_TAB) + h * 260;
    LAS float* wsf = (LAS float*)(L + AT_WS) + w * 64;
    f32x16 oa0, oa1, ob0, ob1;
#pragma unroll
    for (int r = 0; r < 16; ++r) { oa0[r] = 0.f; oa1[r] = 0.f; ob0[r] = 0.f; ob1[r] = 0.f; }
    float mrunA = -1e30f, lrunA = 0.f, mrunB = -1e30f, lrunB = 0.f;
    const bf16* kbase = RAK + ((size_t)(b * 8 + h) * 64) * 4096 + lane * 8;
    const bf16* vbase = RAVT + ((size_t)(b * 8 + h) * 64) * 4096 + lane * 8;
    const float cfar = tab[256];
    const int jstart = n >= 8 ? 0 : 8 - n;
    bf16x8 kf[2][4], vf[2][2][2];
#define AT2_LOADK(kc_) do { _Pragma("unroll") for (int kh = 0; kh < 2; ++kh) _Pragma("unroll") for (int d0 = 0; d0 < 4; ++d0) kf[kh][d0] = *(const bf16x8*)(kbase + (size_t)(kc_) * 4096 + (kh * 4 + d0) * 512); } while (0)
#define AT2_LOADV(kc_) do { _Pragma("unroll") for (int dh = 0; dh < 2; ++dh) _Pragma("unroll") for (int kh = 0; kh < 2; ++kh) _Pragma("unroll") for (int blk = 0; blk < 2; ++blk) \
            vf[dh][kh][blk] = *(const bf16x8*)(vbase + (size_t)(kc_) * 4096 + ((dh * 2 + kh) * 2 + blk) * 512); } while (0)
#define AT2_KH(HH, KH, O0, O1, MRUN, LRUN, LASTK) do { \
        f32x16 p; \
        _Pragma("unroll") for (int r = 0; r < 16; ++r) p[r] = 0.f; \
        _Pragma("unroll") for (int d0 = 0; d0 < 4; ++d0) { const bf16x8 qf = *(const LAS bf16x8*)(qs + (HH * 4 + d0) * 1024); p = MFMA32(kf[KH][d0], qf, p); } \
        if (LASTK) { AT2_LOADK(kcn); } \
        float sub; \
        if (j <= 5) { sub = MRUN - cfar; } \
        else { const int base = (32 * HH + r32) - ((j - 8) * 64 + 32 * KH + 16 * hi) + 128; \
            _Pragma("unroll") for (int r = 0; r < 16; ++r) { int i0 = base - r; i0 = i0 < 0 ? 0 : (i0 > 256 ? 256 : i0); p[r] += tab[i0]; } \
            sub = MRUN; } \
        if (KH == 0 && j == jstart) { float mx = p[0]; \
            _Pragma("unroll") for (int r = 1; r < 16; ++r) mx = fmaxf(mx, p[r]); \
            mx = fmaxf(mx, shx(mx, lane, 32)); \
            if (j <= 5) { MRUN = mx + cfar; sub = mx; } else { MRUN = mx; sub = mx; } }     \
        float rs = 0.f; \
        _Pragma("unroll") for (int r = 0; r < 16; ++r) { p[r] = __builtin_amdgcn_exp2f(p[r] - sub); rs += p[r]; } \
        LRUN += rs; \
        bf16x8 pa0, pa1; \
        { u32x4 t; \
          t.x = pk2(p[0], p[1]); t.y = pk2(p[2], p[3]); t.z = pk2(p[4], p[5]); t.w = pk2(p[6], p[7]); pa0 = __builtin_bit_cast(bf16x8, t); \
          t.x = pk2(p[8], p[9]); t.y = pk2(p[10], p[11]); t.z = pk2(p[12], p[13]); t.w = pk2(p[14], p[15]); pa1 = __builtin_bit_cast(bf16x8, t); } \
        O0 = MFMA32(pa0, vf[0][KH][0], O0); O1 = MFMA32(pa0, vf[1][KH][0], O1); O0 = MFMA32(pa1, vf[0][KH][1], O0); O1 = MFMA32(pa1, vf[1][KH][1], O1); \
        __builtin_amdgcn_sched_barrier(0); } while (0)
#define AT2_HALF(HH, O0, O1, MRUN, LRUN, LAST) do { AT2_KH(HH, 0, O0, O1, MRUN, LRUN, false); AT2_KH(HH, 1, O0, O1, MRUN, LRUN, LAST); if (LAST) { AT2_LOADV(kcn); } } while (0)
    AT2_LOADK(n - 8 + jstart); AT2_LOADV(n - 8 + jstart);
#pragma unroll 1
    for (int j = jstart; j <= 8; ++j) {
        const int kcn = j < 8 ? n - 8 + j + 1 : n;
        AT2_HALF(0, oa0, oa1, mrunA, lrunA, false);
        AT2_HALF(1, ob0, ob1, mrunB, lrunB, true);
    }
#undef AT2_LOADK
#undef AT2_LOADV
#undef AT2_HALF
#undef AT2_KH
#define AT2_OUT(HH, O0, O1, LRUN) do { float lr = LRUN; lr += shx(lr, lane, 32); \
        if (hi == 0) wsf[32 + r32] = __builtin_amdgcn_rcpf(lr); \
        _Pragma("unroll") for (int g = 0; g < 4; ++g) { const f32x4 s4 = *(const LAS f32x4*)(wsf + 32 + 8 * g + 4 * hi); \
            _Pragma("unroll") for (int e = 0; e < 4; ++e) { const int q = e + 8 * g + 4 * hi; bf16* op = ROAB + (row0 + 32 * HH + q) * 1024 + 512 + h * 64 + r32; \
                op[0] = (bf16)f2bf(O0[4 * g + e] * s4[e]); op[32] = (bf16)f2bf(O1[4 * g + e] * s4[e]); } } } while (0)
    AT2_OUT(0, oa0, oa1, lrunA);
    AT2_OUT(1, ob0, ob1, lrunB);
#undef AT2_OUT
}


#ifdef DBG_STOP
__device__ __forceinline__ void dbg_dump(const bf16* src, float* out, int tid) {
    const size_t n = (size_t)T * 1024; const size_t gt = (size_t)blockIdx.x * 512 + tid, NT = (size_t)gridDim.x * 512;
    for (size_t i = gt; i < n; i += NT) out[i] = b2f(src[i]);
}
#define DBG_AT(k, off) if (DBG_STOP == (k) && l == DBG_LAYER) { dbg_dump((const bf16*)(WSP() + (off)), OUTP(), MYTID()); return; }
#else
#define DBG_AT(k, off)
#endif
#ifndef DBG_LAYER
#define DBG_LAYER 0
#endif
#define XB_TMO      128
#define XB_XCNT(j)  (256  + 64 * (j))
#define XB_XSUB(j)  (1280 + 64 * (j))
#define XB_XGEN(j)  (2304 + 64 * (j))
#define XB_TOP      3328
#define XB_TOPGEN   3392
#define XCD_BAR_WORDS 3456
#define XB_SPIN_CAP (1u << 18)

__device__ __forceinline__ unsigned xb_ld(unsigned* p)              { return __hip_atomic_load(p, __ATOMIC_RELAXED, __HIP_MEMORY_SCOPE_AGENT); }
__device__ __forceinline__ unsigned xb_add(unsigned* p, unsigned v) { return __hip_atomic_fetch_add(p, v, __ATOMIC_RELAXED, __HIP_MEMORY_SCOPE_AGENT); }
__device__ __forceinline__ unsigned xb_xcc_id() { return (unsigned)__builtin_amdgcn_s_getreg((3 << 11) | 20) & 0xFu; }
#define XB_SPIN(cond, bar) do { unsigned _sp = 0; while (cond) { __builtin_amdgcn_s_sleep(1); \
    if ((++_sp & 255u) == 0u) { if (xb_ld(&(bar)[XB_TMO])) break; if (_sp > XB_SPIN_CAP) { atomicAdd(&(bar)[XB_TMO], 1u); break; } } } } while (0)

struct XcdBarrier {
    unsigned* bar; unsigned x;
    volatile LAS unsigned* st;
};

__device__ __forceinline__ XcdBarrier xcd_barrier_post(unsigned* bar, volatile LAS unsigned* st, int wave0) {
    XcdBarrier b; b.bar = bar; b.x = xb_xcc_id(); b.st = st;
    if (wave0 == 0 && lane_id_v() == 0) (void)xb_add(&bar[XB_XCNT(b.x)], 1u);
    return b;
}
__device__ __forceinline__ void xcd_barrier_complete(unsigned* bar, unsigned x, unsigned& nloc, unsigned& nx) {
    const unsigned G = gridDim.x * gridDim.y * gridDim.z;
    unsigned sum, cnt, mine, sp = 0u;
    for (;;) {
        sum = 0u; cnt = 0u; mine = 0u;
#pragma unroll
        for (unsigned j = 0; j < 16; ++j) { const unsigned c = xb_ld(&bar[XB_XCNT(j)]); sum += c; cnt += (c > 0u) ? 1u : 0u; mine = (j == x) ? c : mine; }
        if (sum == G) break;
        __builtin_amdgcn_s_sleep(1);
        if ((++sp & 255u) == 0u) { if (xb_ld(&bar[XB_TMO])) break; if (sp > XB_SPIN_CAP) { atomicAdd(&bar[XB_TMO], 1u); break; } }
    }
    nloc = mine > 0u ? mine : 1u; nx = cnt > 0u ? cnt : 1u;
}

__device__ __forceinline__ void xcd_barrier(const XcdBarrier& b, int wave0) {
    asm volatile("s_waitcnt vmcnt(0)" ::: "memory");
    __syncthreads();
    if (wave0 == 0 && lane_id_v() == 0) {
        unsigned* bar = b.bar;
        __builtin_amdgcn_s_waitcnt(0);
        unsigned nloc = b.st[0], nx = b.st[1];
        if (nloc == 0u) { xcd_barrier_complete(bar, b.x, nloc, nx); b.st[0] = nloc; b.st[1] = nx; }
        const unsigned old = xb_add(&bar[XB_XSUB(b.x)], 1u);
        const unsigned gen = old / nloc;
        if (old + 1u == (gen + 1u) * nloc) {
            __builtin_amdgcn_fence(__ATOMIC_RELEASE, "agent");
            asm volatile("s_waitcnt vmcnt(0)" ::: "memory");
            const unsigned og = xb_add(&bar[XB_TOP], 1u);
            const unsigned tg = og / nx;
            if (og + 1u == (tg + 1u) * nx) xb_add(&bar[XB_TOPGEN], 1u);
            else XB_SPIN(xb_ld(&bar[XB_TOPGEN]) == tg, bar);
            __builtin_amdgcn_fence(__ATOMIC_ACQUIRE, "agent");
            xb_add(&bar[XB_XGEN(b.x)], 1u);
            asm volatile("s_waitcnt vmcnt(0)" ::: "memory");
        } else {
            XB_SPIN(xb_ld(&bar[XB_XGEN(b.x)]) == gen, bar);
            __builtin_amdgcn_fence(__ATOMIC_ACQUIRE, "agent");
            asm volatile("s_waitcnt vmcnt(0)" ::: "memory");
        }
    }
    __syncthreads();
}

struct Args { const float* in[19]; float* out; unsigned char* ws; };
#ifdef PROBE_A
#define STAMP() do { if (bx == 0 && wave0 == 0) { const unsigned long long t_ = __builtin_amdgcn_s_memrealtime(); *(LAS unsigned long long*)(L + RING_BYTES + 512 + 8 * nstamp) = t_; } ++nstamp; } while (0)
#else
#define STAMP() do { } while (0)
#endif
#ifdef FLAT_BAR
#define GSYNC() do { ++nbar; grid_bar(bar_ctr, (unsigned)nbar * (unsigned)G, wave0); STAMP(); } while (0)
#else
#define GSYNC() do { xcd_barrier(xbar, wave0); STAMP(); } while (0)
#endif
#define MYTID() (wave0 * 64 + lane_id_v())
__device__ __forceinline__ void grid_bar(unsigned* ctr, unsigned target, int wave0) {
    asm volatile("s_waitcnt vmcnt(0)" ::: "memory");
    __syncthreads();
    if (wave0 == 0) {
        if (lane_id_v() == 0) {
            __builtin_amdgcn_fence(__ATOMIC_RELEASE, "agent");
            asm volatile("s_waitcnt vmcnt(0)" ::: "memory");
            __hip_atomic_fetch_add(ctr, 1u, __ATOMIC_RELAXED, __HIP_MEMORY_SCOPE_AGENT);
            const unsigned long long t0 = __builtin_amdgcn_s_memrealtime();
            while (__hip_atomic_load(ctr, __ATOMIC_RELAXED, __HIP_MEMORY_SCOPE_AGENT) < target) {
                __builtin_amdgcn_s_sleep(2);
                if (__builtin_amdgcn_s_memrealtime() - t0 > 200000000ull) break;
            }
            __builtin_amdgcn_fence(__ATOMIC_ACQUIRE, "agent");
            asm volatile("s_waitcnt vmcnt(0)" ::: "memory");
        }
    }
    __syncthreads();
}
__device__ __forceinline__ unsigned long long ld_ptr(ldsp L, int i) {
    unsigned off = RING_BYTES + 8 * i; asm volatile("" : "+v"(off));
    const unsigned lo = *(volatile LAS unsigned*)(L + off), hi = *(volatile LAS unsigned*)(L + off + 4);
    return ((unsigned long long)(unsigned)__builtin_amdgcn_readfirstlane(hi) << 32) | (unsigned)__builtin_amdgcn_readfirstlane(lo);
}
#define GASQ __attribute__((address_space(1)))
#define INP(i) ((const float*)(const GASQ float*)ld_ptr(L, (i)))
#define OUTP() ((float*)(GASQ float*)ld_ptr(L, 19))
#define WSP() ((unsigned char*)(GASQ unsigned char*)ld_ptr(L, 20))
__global__ void __launch_bounds__(512, 2) fwd_mega(Args args) {
    extern __shared__ __attribute__((aligned(16))) unsigned char lds_raw[];
    cg::grid_group grid = cg::this_grid();
    const ldsp L = (ldsp)lds_raw;
    const ldsp LG = L;
    const int G = gridDim.x, bx = blockIdx.x;
    const int wave0 = __builtin_amdgcn_readfirstlane((int)threadIdx.x >> 6);
    int nbar = 0;
    int nstamp = 0;
    unsigned* bar_ctr = (unsigned*)args.ws;
    if (threadIdx.x == 0) {
#pragma unroll
        for (int i = 0; i < 19; ++i) *(LAS unsigned long long*)(L + RING_BYTES + 8 * i) = (unsigned long long)args.in[i];
        *(LAS unsigned long long*)(L + RING_BYTES + 8 * 19) = (unsigned long long)args.out;
        *(LAS unsigned long long*)(L + RING_BYTES + 8 * 20) = (unsigned long long)args.ws;
    }
    __syncthreads();

    {   int tid = threadIdx.x; asm volatile("" : "+v"(tid)); const int lane = tid & 63, wave = __builtin_amdgcn_readfirstlane(tid >> 6);
        unsigned char* ws = WSP();
        Ins I;
#pragma unroll
        for (int i = 0; i < 19; ++i) I.in[i] = INP(i);
        cvt_weights(I, 0, (bf16*)(ws + WS_W0), L, wave, lane);
        cvt_p(I.in[1], (bf16*)(ws + WS_PB), tid);
        cvt_x(I.in[0], (bf16*)(ws + WS_BX), (float*)(ws + WS_SSQA), wave, lane);
        if (bx == 0) { const int j = tid; const float* lg = I.in[4]; float* LB = (float*)(ws + WS_LB);
            const float a0 = lg[j], a1 = lg[512 + j], a2 = lg[1024 + j], a3 = lg[1536 + j]; const float mx = fmaxf(fmaxf(a0, a1), fmaxf(a2, a3));
            const float e0 = __expf(a0 - mx), e1 = __expf(a1 - mx), e2 = __expf(a2 - mx), e3 = __expf(a3 - mx); const float inv = 1.f / (((e0 + e1) + e2) + e3);
            LB[j] = 0.f; LB[512 + j] = e1 * inv; LB[1024 + j] = (e1 + e2) * inv; LB[1536 + j] = ((e1 + e2) + e3) * inv; }
    }
    if (bx == 0 && threadIdx.x == 0) __hip_atomic_store(bar_ctr, 0u, __ATOMIC_RELAXED, __HIP_MEMORY_SCOPE_AGENT);
    if (bx == 0) for (int i = threadIdx.x; i < XCD_BAR_WORDS; i += 512) __hip_atomic_store(bar_ctr + 64 + i, 0u, __ATOMIC_RELAXED, __HIP_MEMORY_SCOPE_AGENT);
    if (threadIdx.x < 2) *(volatile LAS unsigned*)(L + RING_BYTES + 1024 + 4 * threadIdx.x) = 0u;
    STAMP();
    grid.sync();
    XcdBarrier xbar = xcd_barrier_post(bar_ctr + 64, (volatile LAS unsigned*)(L + RING_BYTES + 1024), wave0);
    STAMP();

#pragma unroll 1
    for (int l = 0; l < DEPTH; ++l) {
        { unsigned char* ws = WSP(); bf16* Wc = (bf16*)(ws + WS_W0 + (size_t)(l & 1) * WS_WSTRIDE); bf16* XA = (bf16*)(ws + ((l & 1) ? WS_BU : WS_BX));
          pg8::Gemm g{XA, Wc + WO_IN, T, 3584, 1024, 1024, 1024}; pg8::StaticOrder S; S.init(T, 3584, G, bx);
          pg8::EpiIn E{(float*)(ws + WS_SSQA), (float*)(ws + WS_LB) + l * 512, INP(6) + l * 64, INP(7) + l * 64, (bf16*)(ws + WS_RQ), (pg8::f16_t*)(ws + WS_RLF), (bf16*)(ws + WS_RI), (bf16*)(ws + WS_ROAB), (bf16*)(ws + WS_RAK), (bf16*)(ws + WS_RAVT), L + EPI_SCR};
          pg8::gemm_phase<pg8::EpiIn, pg8::StaticOrder, true, true>(LG, g, S, E, MYTID()); }
        GSYNC();
        DBG_AT(1, DBG_OFF)
        { unsigned char* ws = WSP();
          hgrn_stageA(L, bx, G, (bf16*)(ws + WS_RQ), (const f16*)(ws + WS_RLF), (bf16*)(ws + WS_RI), (bf16*)(ws + WS_RU), (float*)(ws + WS_ADEC), MYTID());
          __syncthreads();
#ifdef PROBE_A
          if (bx == 0 && wave0 == 0) { const unsigned long long t_ = __builtin_amdgcn_s_memrealtime(); *(LAS unsigned long long*)(L + RING_BYTES + 512 + 8 * (48 + l)) = t_; }
#endif
          if (l + 1 < DEPTH) { int tid = MYTID(); asm volatile("" : "+v"(tid)); const int lane = tid & 63, wave = wave0;
              Ins I;
#pragma unroll
              for (int i = 0; i < 19; ++i) I.in[i] = INP(i);
              cvt_weights(I, l + 1, (bf16*)(ws + WS_W0 + (size_t)((l + 1) & 1) * WS_WSTRIDE), L, wave, lane); } }
        GSYNC();
        DBG_AT(2, DBG_OFF)
        { unsigned char* ws = WSP();
          int tid = MYTID(); asm volatile("" : "+v"(tid)); const int lane = tid & 63, wave = wave0;
          const int sbh = (bx & 7) + 8 * ((bx >> 3) & 3), svs = bx >> 5;
#ifndef P3_CONCURRENT
#ifdef SCAN_128
          if (bx < 128) {
              const int sbh2 = (bx & 7) + 8 * ((bx >> 3) & 3), pair = bx >> 5;
              hgrn_scan_wave4<1>(L, (bf16*)(ws + ((l & 1) ? WS_BX : WS_BU)), sbh2, 2 * pair + (wave >> 2), wave & 3, (const bf16*)(ws + WS_RQ), (const bf16*)(ws + WS_RU), (const float*)(ws + WS_ADEC), lane);
          }
          if (0)
#endif
          if (wave < 4)
              hgrn_scan_wave4<0>(L, nullptr, sbh, svs, wave, (const bf16*)(ws + WS_RQ), (const bf16*)(ws + WS_RU), (const float*)(ws + WS_ADEC), lane);
          __syncthreads();
#ifdef PROBE_A
          if (bx == 0 && wave0 == 0) { const unsigned long long t_ = __builtin_amdgcn_s_memrealtime(); *(LAS unsigned long long*)(L + RING_BYTES + 512 + 8 * (44 + l)) = t_; }
#endif
#ifndef SCAN_128
          { bf16* OINT = (bf16*)(ws + ((l & 1) ? WS_BX : WS_BU));
            for (int p = tid; p < 8192; p += 512) { const int c = p >> 7, fr_ = (p >> 3) & 15, ts = p & 7;
                *(u32x4*)(OINT + ((size_t)(sbh * 64 + c)) * 8192 + (16 * svs + fr_) * 64 + 8 * ts) = *(const LAS u32x4*)(L + p * 16); } }
#endif
          __syncthreads();
#ifdef PROBE_A
          if (bx == 0 && wave0 == 0) { const unsigned long long t_ = __builtin_amdgcn_s_memrealtime(); *(LAS unsigned long long*)(L + RING_BYTES + 512 + 8 * (40 + l)) = t_; }
#endif
          const float* rb = INP(8) + (size_t)l * 8 * 257;
          for (int i = tid; i < 8 * 257; i += 512) { const int hh = i / 257, k = i - hh * 257; ((LAS float*)(L + AT_TAB))[hh * 260 + k] = rb[i] * 1.4426950408889634f; }
          __syncthreads();
#else
          { const float* rb = INP(8) + (size_t)l * 8 * 257;
            for (int i = tid; i < 8 * 257; i += 512) { const int hh = i / 257, k = i - hh * 257; ((LAS float*)(L + AT_TAB))[hh * 260 + k] = rb[i] * 1.4426950408889634f; }
            __syncthreads(); }
          if (wave == 0) {
              hgrn_scan_wave<1>(L, (bf16*)(ws + ((l & 1) ? WS_BX : WS_BU)), sbh, svs, (const bf16*)(ws + WS_RQ), (const bf16*)(ws + WS_RU), (const float*)(ws + WS_ADEC), lane);
          } else if (G == 256) {
              const int x = bx & 7, cu = bx >> 3, cg = cu & 15;
#pragma unroll 1
              for (int s = wave - 1; s < 32; s += 7) { const int r = s >> 3, sl = s & 7; const int ph = x * 8 + 2 * r + (cu >> 4); const int b = ph >> 3, h = ph & 7, n = 4 * cg + (sl >> 1), half = sl & 1;
                  attn_item(L, (((b * 64 + n) * 8 + h) << 1) | half, (bf16*)(ws + WS_ROAB), (const bf16*)(ws + WS_RAK), (const bf16*)(ws + WS_RAVT), wave, lane); }
          }
          if (0)
#endif
          if (G == 256) {
              const int x = bx & 7, cu = bx >> 3, cg = cu & 15;
#pragma unroll 1
#ifndef ATT_HALF_WAVES
              for (int it = 0; it < 2; ++it) { const int r = (wave >> 2) + 2 * it; const int ph = x * 8 + 2 * r + (cu >> 4); const int b = ph >> 3, h = ph & 7, n = 4 * cg + (wave & 3);
                  attn_item2(L, (b * 64 + n) * 8 + h, (bf16*)(ws + WS_ROAB), (const bf16*)(ws + WS_RAK), (const bf16*)(ws + WS_RAVT), wave, lane); }
#else
              for (int r = 0; r < 4; ++r) { const int ph = x * 8 + 2 * r + (cu >> 4); const int b = ph >> 3, h = ph & 7, n = 4 * cg + (wave >> 1), half = wave & 1;
                  attn_item(L, (((b * 64 + n) * 8 + h) << 1) | half, (bf16*)(ws + WS_ROAB), (const bf16*)(ws + WS_RAK), (const bf16*)(ws + WS_RAVT), wave, lane); }
#endif
          } else { const int NW = G * 8;
            for (int wi = bx * 8 + wave; wi < 8192; wi += NW) attn_item(L, wi, (bf16*)(ws + WS_ROAB), (const bf16*)(ws + WS_RAK), (const bf16*)(ws + WS_RAVT), wave, lane); } }
        GSYNC();
        DBG_AT(3, DBG_OFF)
        { unsigned char* ws = WSP(); int tid = MYTID(); asm volatile("" : "+v"(tid));
          hgrn_post(L, (const bf16*)(ws + ((l & 1) ? WS_BX : WS_BU)), (const bf16*)(ws + WS_RI), (bf16*)(ws + WS_ROAB), INP(5) + l * 128, wave0, tid & 63);
          __syncthreads(); }
        { unsigned char* ws = WSP(); bf16* Wc = (bf16*)(ws + WS_W0 + (size_t)(l & 1) * WS_WSTRIDE); bf16* XA = (bf16*)(ws + ((l & 1) ? WS_BU : WS_BX));
          pg8::Gemm g{XA, Wc + WO_IN + (size_t)3584 * 1024, T, 2048, 1024, 1024, 1024}; pg8::StaticOrder S; S.init(T, 2048, G, bx);
          pg8::EpiGate E{(float*)(ws + WS_SSQA), ws + WS_GA, ws + WS_GB};
          pg8::gemm_phase<pg8::EpiGate, pg8::StaticOrder, true, true>(LG, g, S, E, MYTID()); }
        GSYNC();
        DBG_AT(4, DBG_OFF)
#ifndef P4_NO_HOOK
        { unsigned char* ws = WSP(); bf16* Wc = (bf16*)(ws + WS_W0 + (size_t)(l & 1) * WS_WSTRIDE);
          pg8::Gemm g{(bf16*)(ws + WS_ROAB), Wc + WO_AB, T, 1024, 1024, 1024, 1024}; pg8::StaticOrder S; S.init(T, 1024, G, bx);
          pg8::EpiMerged E{ws + WS_GA, ws + WS_GB, (bf16*)(ws + WS_MERGED)};
          pg8::gemm_phase<pg8::EpiMerged, pg8::StaticOrder, true, true>(LG, g, S, E, MYTID()); }
#else
        { unsigned char* ws = WSP(); bf16* Wc = (bf16*)(ws + WS_W0 + (size_t)(l & 1) * WS_WSTRIDE);
          pg8::Gemm g{(bf16*)(ws + WS_ROAB), Wc + WO_AB, T, 1024, 512, 1024, 1024}; pg8::StaticOrder S; S.init(T, 1024, G, bx);
          pg8::EpiGated<0> E{(bf16*)(ws + WS_GA), (bf16*)(ws + WS_MERGED)};
          pg8::gemm_phase<pg8::EpiGated<0>, pg8::StaticOrder, true, true>(LG, g, S, E, MYTID()); }
        { unsigned char* ws = WSP(); bf16* Wc = (bf16*)(ws + WS_W0 + (size_t)(l & 1) * WS_WSTRIDE);
          pg8::Gemm g{(bf16*)(ws + WS_ROAB) + 512, Wc + WO_AB + 512, T, 1024, 512, 1024, 1024}; pg8::StaticOrder S; S.init(T, 1024, G, bx);
          pg8::EpiGated<1> E{(bf16*)(ws + WS_GB), (bf16*)(ws + WS_MERGED)};
          pg8::gemm_phase<pg8::EpiGated<1>, pg8::StaticOrder, true, true>(LG, g, S, E, MYTID()); }
#endif
        { unsigned char* ws = WSP(); bf16* Wc = (bf16*)(ws + WS_W0 + (size_t)(l & 1) * WS_WSTRIDE); bf16* XB = (bf16*)(ws + ((l & 1) ? WS_BX : WS_BU));
          pg8::Gemm g{(bf16*)(ws + WS_PB), Wc + WO_PE, T, 1024, 256, 256, 256}; pg8::StaticOrder S; S.init(T, 1024, G, bx);
          pg8::EpiBf E{XB, 1024};
          pg8::gemm_phase<pg8::EpiBf, pg8::StaticOrder, true, true>(LG, g, S, E, MYTID()); }
        GSYNC();
        DBG_AT(5, DBG_OFF)
        { unsigned char* ws = WSP(); bf16* Wc = (bf16*)(ws + WS_W0 + (size_t)(l & 1) * WS_WSTRIDE); bf16* XA = (bf16*)(ws + ((l & 1) ? WS_BU : WS_BX)); float* out = OUTP();
          pg8::Gemm g{(bf16*)(ws + WS_MERGED), Wc + WO_OUT, T, 1024, 1024, 1024, 1024}; pg8::StaticOrder S; S.init(T, 1024, G, bx);
          pg8::EpiRes<0> E{XA, nullptr, XA, (float*)(ws + WS_SSQB), nullptr};
          pg8::gemm_phase<pg8::EpiRes<0>, pg8::StaticOrder, true, true>(LG, g, S, E, MYTID());
          if (l + 1 < DEPTH) cvt_p(INP(1) + (size_t)(l + 1) * T * 256, (bf16*)(ws + WS_PB), MYTID()); }
        GSYNC();
        DBG_AT(6, DBG_OFF)
        { unsigned char* ws = WSP(); bf16* Wc = (bf16*)(ws + WS_W0 + (size_t)(l & 1) * WS_WSTRIDE); bf16* XA = (bf16*)(ws + ((l & 1) ? WS_BU : WS_BX));
          pg8::Gemm g{XA, Wc + WO_GU, T, DIN, 1024, 1024, 1024}; pg8::StaticOrder S; S.init(T, DIN, G, bx);
          pg8::EpiFfnUp E{(float*)(ws + WS_SSQB), (bf16*)(ws + WS_HB)};
          pg8::gemm_phase<pg8::EpiFfnUp, pg8::StaticOrder, true, true>(LG, g, S, E, MYTID()); }
        GSYNC();
        DBG_AT(7, DBG_OFF)
        { unsigned char* ws = WSP(); bf16* Wc = (bf16*)(ws + WS_W0 + (size_t)(l & 1) * WS_WSTRIDE); bf16* XA = (bf16*)(ws + ((l & 1) ? WS_BU : WS_BX)); float* out = OUTP();
          pg8::Gemm g{(bf16*)(ws + WS_HB), Wc + WO_D, T, 1024, DFF, DFF, DFF}; pg8::StaticOrder S; S.init(T, 1024, G, bx);
          pg8::EpiRes<0> E{XA, nullptr, XA, (float*)(ws + WS_SSQC), nullptr};
          pg8::gemm_phase<pg8::EpiRes<0>, pg8::StaticOrder, true, true>(LG, g, S, E, MYTID()); }
        GSYNC();
        DBG_AT(8, DBG_OFF)
        { unsigned char* ws = WSP(); bf16* Wc = (bf16*)(ws + WS_W0 + (size_t)(l & 1) * WS_WSTRIDE); bf16* XA = (bf16*)(ws + ((l & 1) ? WS_BU : WS_BX)); bf16* XB = (bf16*)(ws + ((l & 1) ? WS_BX : WS_BU)); float* out = OUTP();
          pg8::Gemm g{XA, Wc + WO_PG, T, 1024, 1024, 1024, 1024}; pg8::StaticOrder S; S.init(T, 1024, G, bx);
          pg8::EpiRes<1> E{XA, l == DEPTH - 1 ? out : nullptr, XB, (float*)(ws + WS_SSQA), (float*)(ws + WS_SSQC)};
          pg8::gemm_phase<pg8::EpiRes<1>, pg8::StaticOrder, true, true>(LG, g, S, E, MYTID()); }
        GSYNC();
        DBG_AT(9, DBG_OFF)
    }
#ifdef PROBE_A
    if (bx == 0) {
        __syncthreads();
        const LAS unsigned long long* st = (const LAS unsigned long long*)(L + RING_BYTES + 512);
        float tot = (float)(st[37] - st[0]); float fa = 0.f, fb = 0.f;
        for (int ll = 0; ll < 4; ++ll) {
            if (PROBE_A >= 1 && PROBE_A <= 9) fa += (float)(st[1 + 9 * ll + PROBE_A] - st[1 + 9 * ll + PROBE_A - 1]);
            if (PROBE_B >= 1 && PROBE_B <= 9) fb += (float)(st[1 + 9 * ll + PROBE_B] - st[1 + 9 * ll + PROBE_B - 1]);
        }
        if (PROBE_A == 11) { fa = 0.f; for (int ll = 0; ll < 4; ++ll) fa += (float)(st[40 + ll] - st[1 + 9 * ll + 2]); }
        if (PROBE_A == 0) fa = (float)(st[1] - st[0]);
        if (PROBE_B == 13) { fb = 0.f; for (int ll = 0; ll < 4; ++ll) fb += (float)(st[48 + ll] - st[1 + 9 * ll + 1]); }
        if (PROBE_B == 12) { fb = 0.f; for (int ll = 0; ll < 4; ++ll) fb += (float)(st[44 + ll] - st[1 + 9 * ll + 2]); }
        if (PROBE_B == 11) { fb = 0.f; for (int ll = 0; ll < 4; ++ll) fb += (float)(st[40 + ll] - st[1 + 9 * ll + 2]); }
        if (PROBE_B == 0) fb = (float)(st[1] - st[0]);
        if (PROBE_B == 10) fb = tot * (1.0f / 1000000.0f);
        fa /= tot; if (PROBE_B != 10) fb /= tot;
        float* out = OUTP(); const int tid = MYTID();
        if (tid == 0) out[0] += 0.22f + 0.3f * fa;
        const float wv = 0.05f * sqrtf(fb);
        for (int i = 1 + tid; i <= (1 << 20); i += 512) out[i] += wv;
    }
#endif
}

extern "C" void kernel_launch(void* const* d_in, const int* in_sizes, int n_in, void* d_out, int out_size, void* d_ws, size_t ws_size, hipStream_t stream) {
    static int grid = 0;
    if (grid == 0) {
        if (n_in != 19 || out_size != T * DM || ws_size < WS_END) { fprintf(stderr, "kernel_launch: unexpected problem (n_in %d out %d ws %zu)\n", n_in, out_size, ws_size); grid = -1; return; }
        int dev = 0, cus = 0, per_cu = 0;
        (void)hipGetDevice(&dev); (void)hipDeviceGetAttribute(&cus, hipDeviceAttributeMultiprocessorCount, dev);
        (void)hipFuncSetAttribute((const void*)fwd_mega, hipFuncAttributeMaxDynamicSharedMemorySize, LDS_BYTES);
        (void)hipOccupancyMaxActiveBlocksPerMultiprocessor(&per_cu, (const void*)fwd_mega, 512, LDS_BYTES);
        (void)hipGetLastError();
        grid = cus;
        fprintf(stderr, "kernel_launch: grid %d (occupancy query %d per CU), ws %zu\n", grid, per_cu, ws_size);
    }
    if (grid < 0) return;
    Args a{};
    for (int i = 0; i < 19; ++i) a.in[i] = (const float*)d_in[i];
    a.out = (float*)d_out; a.ws = (unsigned char*)d_ws;
    void* params[] = {&a};
    hipError_t e = hipLaunchCooperativeKernel((const void*)fwd_mega, dim3(grid), dim3(512), params, LDS_BYTES, stream);
    if (e != hipSuccess) fprintf(stderr, "kernel_launch: cooperative launch failed: %s\n", hipGetErrorString(e));
}
```

```cpp
#include <hip/hip_runtime.h>
#include <hip/hip_cooperative_groups.h>
#include <cstdio>
#include <cstdint>
namespace cg = cooperative_groups;
__device__ __forceinline__ float shx(float v, int lane, int mask) { return __builtin_bit_cast(float, __builtin_amdgcn_ds_bpermute((lane ^ mask) << 2, __builtin_bit_cast(int, v))); }
__device__ __forceinline__ float shsrc(float v, int src) { return __builtin_bit_cast(float, __builtin_amdgcn_ds_bpermute(src << 2, __builtin_bit_cast(int, v))); }
__device__ __forceinline__ int lane_id_v() { int r; asm volatile("v_mbcnt_lo_u32_b32 %0, -1, 0" : "=v"(r)); asm volatile("v_mbcnt_hi_u32_b32 %0, -1, %0" : "+v"(r)); return r; }
namespace pg8 {
#define PG8_LAS __attribute__((address_space(3)))
typedef unsigned short bf16_t;
typedef short bf16x8 __attribute__((ext_vector_type(8)));
typedef float f32x4 __attribute__((ext_vector_type(4)));
typedef unsigned u32x4 __attribute__((ext_vector_type(4)));
constexpr int BM = 256, BK = 64, HALF = 128, HTB = HALF * BK * 2  , STAGE_BYTES = 8 * HTB, NXCD = 8, WGM = 8;

__host__ __device__ __forceinline__ int lds_byte(int r, int c) { const int st = (r >> 4) * 2 + (c >> 5), rr = r & 15, cc = c & 31, ob = rr * 64 + cc * 2; return st * 1024 + (ob ^ (((ob >> 9) & 1) << 5)); }
__host__ __device__ __forceinline__ void stage_rc(int b, int& R, int& C) { const int st = b / 1024, sb = b % 1024, swz = sb ^ (((sb >> 9) & 1) << 5); R = (st >> 1) * 16 + swz / 64; C = (st & 1) * 32 + (swz % 64) / 2; }
__host__ __device__ __forceinline__ int perm32(int rho) { const int n = rho >> 4, i = rho & 15; return 8 * (i >> 2) + 4 * n + (i & 3); }

struct Unit { int pm, pn; };
struct Gemm { const bf16_t* A; const bf16_t* Bt; int M, N, K, lda, ldb; };

struct StaticOrder {
    int nM, nN, nwg, G, c;
    __host__ __device__ void init(int M, int N, int G_, int c_) { nM = M / BM; nN = N / BM; nwg = nM * nN; G = G_; c = c_; }
    __host__ __device__ bool next(int i, Unit& u) const {
        const long L = (long)i * G + c; if (L >= nwg) return false;
        int wgid = (int)L; { const int q = nwg / NXCD, r = nwg % NXCD, xcd = wgid % NXCD, off = wgid / NXCD; wgid = (xcd < r ? xcd * (q + 1) : r * (q + 1) + (xcd - r) * q) + off; }
        const int nig = WGM * nN, gid = wgid / nig, fm = gid * WGM, gsz = (nM - fm) < WGM ? (nM - fm) : WGM;
        u.pm = fm + ((wgid % nig) % gsz); u.pn = (wgid % nig) / gsz; return true;
    }
    __device__ __forceinline__ void a_ready(const Unit&) const {}
    __device__ __forceinline__ void done(const Unit&) const {}
};

typedef float f32x2_cv __attribute__((ext_vector_type(2))); typedef __bf16 bf16x2_cv __attribute__((ext_vector_type(2)));
__device__ __forceinline__ unsigned cvt_pk_bf16(float lo, float hi) { f32x2_cv v = {lo, hi}; bf16x2_cv b = __builtin_convertvector(v, bf16x2_cv); return __builtin_bit_cast(unsigned, b); }
#ifndef MERGED_HOOK_T
#define MERGED_HOOK_T 8
#endif
typedef _Float16 f16_t;
typedef float f32x2 __attribute__((ext_vector_type(2)));
typedef _Float16 f16x2 __attribute__((ext_vector_type(2)));
__device__ __forceinline__ float bf2f(unsigned h) { return __uint_as_float(h << 16); }
__device__ __forceinline__ float fsigmoid(float z) { return __builtin_amdgcn_rcpf(1.f + __expf(-z)); }
__device__ __forceinline__ u32x4 pack8(const f32x4 a, const f32x4 b) { u32x4 w; w.x = cvt_pk_bf16(a[0], a[1]); w.y = cvt_pk_bf16(a[2], a[3]); w.z = cvt_pk_bf16(b[0], b[1]); w.w = cvt_pk_bf16(b[2], b[3]); return w; }
__device__ __forceinline__ void unpack8(const u32x4 w, f32x4& a, f32x4& b) {
    a[0] = __uint_as_float(w.x << 16); a[1] = __uint_as_float(w.x & 0xffff0000u); a[2] = __uint_as_float(w.y << 16); a[3] = __uint_as_float(w.y & 0xffff0000u);
    b[0] = __uint_as_float(w.z << 16); b[1] = __uint_as_float(w.z & 0xffff0000u); b[2] = __uint_as_float(w.w << 16); b[3] = __uint_as_float(w.w & 0xffff0000u); }
__device__ __forceinline__ unsigned pk_f16(float lo, float hi) { f32x2 v = {lo, hi}; f16x2 h = __builtin_convertvector(v, f16x2); return __builtin_bit_cast(unsigned, h); }
__device__ __forceinline__ float row_rstd(const float* ssq, int row, int fr, int fq) {
    const f32x4 a = *(const f32x4*)(ssq + (size_t)row * 16 + 4 * fq);
    float s = (a[0] + a[1]) + (a[2] + a[3]);
    s += shx(s, fq * 16 + fr, 16); s += shx(s, fq * 16 + fr, 32);
    return __builtin_amdgcn_rsqf(s * (1.0f / 1024.0f) + 1e-6f);
}

__device__ __forceinline__ unsigned pack4_u8(const f32x4 v) { const f32x4 q = v * 255.0f + 0.5f; return (unsigned)q[0] | ((unsigned)q[1] << 8) | ((unsigned)q[2] << 16) | ((unsigned)q[3] << 24); }
__device__ __forceinline__ f32x4 unpack4_u8(unsigned w) { f32x4 r; r[0] = (float)(w & 255u); r[1] = (float)((w >> 8) & 255u); r[2] = (float)((w >> 16) & 255u); r[3] = (float)(w >> 24); return r * (1.0f / 255.0f); }
typedef unsigned u32x2g __attribute__((ext_vector_type(2)));
struct EpiIn {
    static constexpr bool PERM = true, AFTER_DRAIN = false; static constexpr int HOOK_T = 0;
    const float* ssq; const float* lb; const float* gq; const float* gk;
    bf16_t* RQ; f16_t* RLF; bf16_t* RI; bf16_t* ROAB; bf16_t* RAK; bf16_t* RAVT; PG8_LAS unsigned char* scr; unsigned char* GA8; unsigned char* GB8;
    __device__ __forceinline__ void mid(f32x4 (&acc)[2][2][4][2], const Unit& u, int wr, int wc, int fr, int fq) const {}
    __device__ __forceinline__ void operator()(const f32x4 (&acc)[2][2][4][2], const Unit& u, int wr, int wc, int fr, int fq) const {
        const int row0 = u.pm * BM + wr * 64 + fr;
        const int seg = u.pn >> 1;
        const int cseg = (u.pn & 1) * 256 + wc * 32 + 8 * fq;
        if (u.pn >= 14) {
            unsigned char* O = (u.pn < 18 ? GA8 : GB8) + ((u.pn - 14) & 3) * 256 + wc * 32 + 8 * fq;
#pragma unroll
            for (int ai = 0; ai < 2; ++ai)
#pragma unroll
                for (int m = 0; m < 4; ++m) { const int row = row0 + ai * HALF + m * 16; const float rs = row_rstd(ssq, row, fr, fq);
#pragma unroll
                    for (int bj = 0; bj < 2; ++bj) { f32x4 v0 = acc[ai][bj][m][0] * rs, v1 = acc[ai][bj][m][1] * rs;
#pragma unroll
                        for (int e = 0; e < 4; ++e) { v0[e] = fsigmoid(v0[e]); v1[e] = fsigmoid(v1[e]); }
                        u32x2g w; w.x = pack4_u8(v0); w.y = pack4_u8(v1);
                        *(u32x2g*)(O + (size_t)row * 1024 + bj * HALF) = w; } }
        } else if (seg == 0 || seg == 2) {
            bf16_t* O = seg == 0 ? RQ : RI;
#pragma unroll
            for (int ai = 0; ai < 2; ++ai)
#pragma unroll
                for (int m = 0; m < 4; ++m) { const int row = row0 + ai * HALF + m * 16; const float rs = row_rstd(ssq, row, fr, fq);
#pragma unroll
                    for (int bj = 0; bj < 2; ++bj) *(u32x4*)(O + (size_t)row * 512 + cseg + bj * HALF) = pack8(acc[ai][bj][m][0] * rs, acc[ai][bj][m][1] * rs); }
        } else if (seg == 1) {
            f32x4 l0[2], l1[2];
#pragma unroll
            for (int bj = 0; bj < 2; ++bj) { l0[bj] = *(const f32x4*)(lb + cseg + bj * HALF); l1[bj] = *(const f32x4*)(lb + cseg + bj * HALF + 4); }
#pragma unroll
            for (int ai = 0; ai < 2; ++ai)
#pragma unroll
                for (int m = 0; m < 4; ++m) { const int row = row0 + ai * HALF + m * 16; const float rs = row_rstd(ssq, row, fr, fq);
#pragma unroll
                    for (int bj = 0; bj < 2; ++bj) { float o[8];
#pragma unroll
                        for (int e = 0; e < 4; ++e) { const float z0 = acc[ai][bj][m][0][e] * rs, z1 = acc[ai][bj][m][1][e] * rs;
                            const float f0 = l0[bj][e] + (1.f - l0[bj][e]) * fsigmoid(z0), f1 = l1[bj][e] + (1.f - l1[bj][e]) * fsigmoid(z1);
                            o[e] = __logf(fmaxf(f0, 1e-30f)); o[4 + e] = __logf(fmaxf(f1, 1e-30f)); }
                        u32x4 w; w.x = pk_f16(o[0], o[1]); w.y = pk_f16(o[2], o[3]); w.z = pk_f16(o[4], o[5]); w.w = pk_f16(o[6], o[7]);
                        *(u32x4*)(RLF + (size_t)row * 512 + cseg + bj * HALF) = w; } }
        } else if (seg == 3) {
#pragma unroll
            for (int ai = 0; ai < 2; ++ai)
#pragma unroll
                for (int m = 0; m < 4; ++m) { const int row = row0 + ai * HALF + m * 16; const float rs = row_rstd(ssq, row, fr, fq);
#pragma unroll
                    for (int bj = 0; bj < 2; ++bj) { f32x4 v0 = acc[ai][bj][m][0] * rs, v1 = acc[ai][bj][m][1] * rs;
#pragma unroll
                        for (int e = 0; e < 4; ++e) { v0[e] = v0[e] * fsigmoid(v0[e]); v1[e] = v1[e] * fsigmoid(v1[e]); }
                        *(u32x4*)(ROAB + (size_t)row * 1024 + cseg + bj * HALF) = pack8(v0, v1); } }
        } else if (seg == 4 || seg == 5) {
            const float* gg = seg == 4 ? gq : gk; const float sc = seg == 4 ? 0.18033688011112042f : 1.0f;
            f32x4 g0[2], g1[2];
#pragma unroll
            for (int bj = 0; bj < 2; ++bj) { g0[bj] = *(const f32x4*)(gg + 32 * bj + 8 * fq) * sc; g1[bj] = *(const f32x4*)(gg + 32 * bj + 8 * fq + 4) * sc; }
            const int head = (u.pn & 1) * 4 + wc;
            bf16_t* O = seg == 4 ? (ROAB + 512) : RAK; const int ld = seg == 4 ? 1024 : 512;
#pragma unroll
            for (int ai = 0; ai < 2; ++ai)
#pragma unroll
                for (int m = 0; m < 4; ++m) { const int row = row0 + ai * HALF + m * 16; const float rs = row_rstd(ssq, row, fr, fq);
                    float s = 0.f;
#pragma unroll
                    for (int bj = 0; bj < 2; ++bj)
#pragma unroll
                        for (int n = 0; n < 2; ++n) { const f32x4 x = acc[ai][bj][m][n]; s += (x[0] * x[0] + x[1] * x[1]) + (x[2] * x[2] + x[3] * x[3]); }
                    s += shx(s, fq * 16 + fr, 16); s += shx(s, fq * 16 + fr, 32);
                    const float rr = rs * __builtin_amdgcn_rsqf(rs * rs * s * (1.0f / 64.0f) + 1e-6f);
                    if (seg == 4) {
#pragma unroll
                        for (int bj = 0; bj < 2; ++bj) *(u32x4*)(O + (size_t)row * ld + head * 64 + 32 * bj + 8 * fq) = pack8(acc[ai][bj][m][0] * rr * g0[bj], acc[ai][bj][m][1] * rr * g1[bj]);
                    } else {
                        const int b = row >> 12, t = row & 4095, kc = t >> 6, key = t & 63, kh = key >> 5, p = key & 31, r16 = p & 15;
                        const int mrow = (r16 & 3) + 4 * (p >> 4) + 8 * (r16 >> 2);
                        bf16_t* kb_ = RAK + ((size_t)((b * 8 + head) * 64 + kc)) * 4096;
#pragma unroll
                        for (int bj = 0; bj < 2; ++bj) { const int d0 = 2 * bj + (fq >> 1), hi = fq & 1;
                            *(u32x4*)(kb_ + ((kh * 4 + d0) * 64 + hi * 32 + mrow) * 8) = pack8(acc[ai][bj][m][0] * rr * g0[bj], acc[ai][bj][m][1] * rr * g1[bj]); } } }
        } else {
            PG8_LAS unsigned char* sw = scr + (wr * 4 + wc) * 2048;
            const int lane = fq * 16 + fr, r32 = lane & 31, blk = lane >> 5;
#pragma unroll
            for (int ai = 0; ai < 2; ++ai)
#pragma unroll
                for (int m = 0; m < 4; ++m) { const int trow = u.pm * BM + wr * 64 + ai * HALF + m * 16;
                    const float rs = row_rstd(ssq, trow + fr, fr, fq);
                    const int b = trow >> 12, t = trow & 4095, kc = t >> 6, tt = t & 63, kh = tt >> 5, hi = (tt >> 4) & 1;
#pragma unroll
                    for (int bj = 0; bj < 2; ++bj) { const int col = (u.pn & 1) * 256 + bj * HALF + wc * 32; const int h = col >> 6, dh = (col >> 5) & 1;
                        *(PG8_LAS u32x4*)(sw + fr * 80 + fq * 16) = pack8(acc[ai][bj][m][0] * rs, acc[ai][bj][m][1] * rs);
                        unsigned short c8[8];
#pragma unroll
                        for (int j = 0; j < 8; ++j) c8[j] = *(const PG8_LAS unsigned short*)(sw + (8 * blk + j) * 80 + r32 * 2);
                        u32x4 w; w.x = c8[0] | ((unsigned)c8[1] << 16); w.y = c8[2] | ((unsigned)c8[3] << 16); w.z = c8[4] | ((unsigned)c8[5] << 16); w.w = c8[6] | ((unsigned)c8[7] << 16);
                        *(u32x4*)(RAVT + ((size_t)((b * 8 + h) * 64 + kc)) * 4096 + ((((dh * 2 + kh) * 2 + blk) * 64 + hi * 32 + r32) * 8)) = w; } }
        }
    }
};
struct EpiGate {
    static constexpr bool PERM = true, AFTER_DRAIN = false; static constexpr int HOOK_T = 0;
    const float* ssq; unsigned char* GA; unsigned char* GB;
    __device__ __forceinline__ void mid(f32x4 (&acc)[2][2][4][2], const Unit& u, int wr, int wc, int fr, int fq) const {}
    __device__ __forceinline__ void operator()(const f32x4 (&acc)[2][2][4][2], const Unit& u, int wr, int wc, int fr, int fq) const {
        const int row0 = u.pm * BM + wr * 64 + fr;
        unsigned char* O = (u.pn < 4 ? GA : GB) + (u.pn & 3) * 256 + wc * 32 + 8 * fq;
#pragma unroll
        for (int ai = 0; ai < 2; ++ai)
#pragma unroll
            for (int m = 0; m < 4; ++m) { const int row = row0 + ai * HALF + m * 16; const float rs = row_rstd(ssq, row, fr, fq);
#pragma unroll
                for (int bj = 0; bj < 2; ++bj) { f32x4 v0 = acc[ai][bj][m][0] * rs, v1 = acc[ai][bj][m][1] * rs;
#pragma unroll
                    for (int e = 0; e < 4; ++e) { v0[e] = fsigmoid(v0[e]); v1[e] = fsigmoid(v1[e]); }
                    u32x2g w; w.x = pack4_u8(v0); w.y = pack4_u8(v1);
                    *(u32x2g*)(O + (size_t)row * 1024 + bj * HALF) = w; } }
    }
};
template <int MODE> struct EpiGated {
    static constexpr bool PERM = true, AFTER_DRAIN = false; static constexpr int HOOK_T = 0;
    const bf16_t* Gt; bf16_t* O;
    __device__ __forceinline__ void mid(f32x4 (&acc)[2][2][4][2], const Unit& u, int wr, int wc, int fr, int fq) const {}
    __device__ __forceinline__ void operator()(const f32x4 (&acc)[2][2][4][2], const Unit& u, int wr, int wc, int fr, int fq) const {
        const int row0 = u.pm * BM + wr * 64 + fr; const int col0 = u.pn * BM + wc * 32 + 8 * fq;
#pragma unroll
        for (int ai = 0; ai < 2; ++ai)
#pragma unroll
            for (int m = 0; m < 4; ++m) { const size_t ro = (size_t)(row0 + ai * HALF + m * 16) * 1024 + col0;
#pragma unroll
                for (int bj = 0; bj < 2; ++bj) { f32x4 g0, g1; unpack8(*(const u32x4*)(Gt + ro + bj * HALF), g0, g1);
                    f32x4 v0 = acc[ai][bj][m][0] * g0, v1 = acc[ai][bj][m][1] * g1;
                    if (MODE == 1) { f32x4 p0, p1; unpack8(*(const u32x4*)(O + ro + bj * HALF), p0, p1); v0 += p0; v1 += p1; }
                    *(u32x4*)(O + ro + bj * HALF) = pack8(v0, v1); }
                if (m & 1) asm volatile("" ::: "memory"); }
    }
};
struct EpiMerged {
    static constexpr bool PERM = true, AFTER_DRAIN = false; static constexpr int HOOK_T = 8;
    const unsigned char* GA; const unsigned char* GB; bf16_t* O;
    __device__ __forceinline__ void mid(f32x4 (&acc)[2][2][4][2], const Unit& u, int wr, int wc, int fr, int fq) const {
        const int row0 = u.pm * BM + wr * 64 + fr; const int col0 = u.pn * BM + wc * 32 + 8 * fq;
#pragma unroll
        for (int ai = 0; ai < 2; ++ai)
#pragma unroll
            for (int m = 0; m < 4; ++m) { const size_t ro = (size_t)(row0 + ai * HALF + m * 16) * 1024 + col0;
#pragma unroll
                for (int bj = 0; bj < 2; ++bj) { const u32x2g wa = *(const u32x2g*)(GA + ro + bj * HALF), wb = *(const u32x2g*)(GB + ro + bj * HALF); const f32x4 a0 = unpack4_u8(wa.x), a1 = unpack4_u8(wa.y); f32x4 b0 = unpack4_u8(wb.x), b1 = unpack4_u8(wb.y);
#pragma unroll
                    for (int e = 0; e < 4; ++e) { acc[ai][bj][m][0][e] *= a0[e] * __builtin_amdgcn_rcpf(fmaxf(b0[e], 1e-20f)); acc[ai][bj][m][1][e] *= a1[e] * __builtin_amdgcn_rcpf(fmaxf(b1[e], 1e-20f)); } }
                if (m & 1) asm volatile("" ::: "memory"); }
    }
    __device__ __forceinline__ void operator()(const f32x4 (&acc)[2][2][4][2], const Unit& u, int wr, int wc, int fr, int fq) const {
        const int row0 = u.pm * BM + wr * 64 + fr; const int col0 = u.pn * BM + wc * 32 + 8 * fq;
#pragma unroll
        for (int ai = 0; ai < 2; ++ai)
#pragma unroll
            for (int m = 0; m < 4; ++m) { const size_t ro = (size_t)(row0 + ai * HALF + m * 16) * 1024 + col0;
#pragma unroll
                for (int bj = 0; bj < 2; ++bj) { const u32x2g wb = *(const u32x2g*)(GB + ro + bj * HALF); f32x4 b0 = unpack4_u8(wb.x), b1 = unpack4_u8(wb.y);
#pragma unroll
                    for (int e = 0; e < 4; ++e) { b0[e] = fmaxf(b0[e], 1e-20f); b1[e] = fmaxf(b1[e], 1e-20f); }
                    *(u32x4*)(O + ro + bj * HALF) = pack8(acc[ai][bj][m][0] * b0, acc[ai][bj][m][1] * b1); }
                if (m & 1) asm volatile("" ::: "memory"); }
    }
};
struct EpiBf {
    static constexpr bool PERM = true, AFTER_DRAIN = false; static constexpr int HOOK_T = 0;
    bf16_t* O; int ldc;
    __device__ __forceinline__ void mid(f32x4 (&acc)[2][2][4][2], const Unit& u, int wr, int wc, int fr, int fq) const {}
    __device__ __forceinline__ void operator()(const f32x4 (&acc)[2][2][4][2], const Unit& u, int wr, int wc, int fr, int fq) const {
        const int row0 = u.pm * BM + wr * 64 + fr; const int col0 = u.pn * BM + wc * 32 + 8 * fq;
#pragma unroll
        for (int ai = 0; ai < 2; ++ai)
#pragma unroll
            for (int m = 0; m < 4; ++m)
#pragma unroll
                for (int bj = 0; bj < 2; ++bj) *(u32x4*)(O + (size_t)(row0 + ai * HALF + m * 16) * ldc + col0 + bj * HALF) = pack8(acc[ai][bj][m][0], acc[ai][bj][m][1]);
    }
};
template <int MODE> struct EpiRes {
    static constexpr bool PERM = true, AFTER_DRAIN = false; static constexpr int HOOK_T = 0;
    const bf16_t* XI; float* out32; bf16_t* XB; float* ssq_out; const float* ssq_in;
    __device__ __forceinline__ void mid(f32x4 (&acc)[2][2][4][2], const Unit& u, int wr, int wc, int fr, int fq) const {}
    __device__ __forceinline__ void operator()(const f32x4 (&acc)[2][2][4][2], const Unit& u, int wr, int wc, int fr, int fq) const {
        const int row0 = u.pm * BM + wr * 64 + fr; const int col0 = u.pn * BM + wc * 32 + 8 * fq;
#pragma unroll
        for (int ai = 0; ai < 2; ++ai)
#pragma unroll
            for (int m = 0; m < 4; ++m) { const int row = row0 + ai * HALF + m * 16; const size_t ro = (size_t)row * 1024 + col0;
                float rs = 1.f; if (MODE == 1) rs = row_rstd(ssq_in, row, fr, fq);
                float s = 0.f;
#pragma unroll
                for (int bj = 0; bj < 2; ++bj) { f32x4 v0, v1; unpack8(*(const u32x4*)(XI + ro + bj * HALF), v0, v1);
                    if (MODE == 1) { f32x4 u0, u1; unpack8(*(const u32x4*)(XB + ro + bj * HALF), u0, u1);
#pragma unroll
                        for (int e = 0; e < 4; ++e) { v0[e] += fsigmoid(acc[ai][bj][m][0][e] * rs) * u0[e]; v1[e] += fsigmoid(acc[ai][bj][m][1][e] * rs) * u1[e]; }
                    } else { v0 += acc[ai][bj][m][0]; v1 += acc[ai][bj][m][1]; }
                    if (out32) { *(f32x4*)(out32 + ro + bj * HALF) = v0; *(f32x4*)(out32 + ro + bj * HALF + 4) = v1; }
                    *(u32x4*)(XB + ro + bj * HALF) = pack8(v0, v1);
                    s += ((v0[0] * v0[0] + v0[1] * v0[1]) + (v0[2] * v0[2] + v0[3] * v0[3])) + ((v1[0] * v1[0] + v1[1] * v1[1]) + (v1[2] * v1[2] + v1[3] * v1[3])); }
                s += shx(s, fq * 16 + fr, 16); s += shx(s, fq * 16 + fr, 32);
                if (fq == 0) ssq_out[(size_t)row * 16 + u.pn * 4 + wc] = s;
                if (m & 1) asm volatile("" ::: "memory"); }
    }
};
struct EpiFfnUp {
    static constexpr bool PERM = true, AFTER_DRAIN = false; static constexpr int HOOK_T = 0;
    const float* ssq; bf16_t* H;
    __device__ __forceinline__ void mid(f32x4 (&acc)[2][2][4][2], const Unit& u, int wr, int wc, int fr, int fq) const {}
    __device__ __forceinline__ void operator()(const f32x4 (&acc)[2][2][4][2], const Unit& u, int wr, int wc, int fr, int fq) const {
        const int row0 = u.pm * BM + wr * 64 + fr; const int col0 = u.pn * HALF + wc * 32 + 8 * fq;
#pragma unroll
        for (int ai = 0; ai < 2; ++ai)
#pragma unroll
            for (int m = 0; m < 4; ++m) { const int row = row0 + ai * HALF + m * 16; const float rs = row_rstd(ssq, row, fr, fq);
                f32x4 v0 = acc[ai][0][m][0] * rs, v1 = acc[ai][0][m][1] * rs; const f32x4 w0 = acc[ai][1][m][0] * rs, w1 = acc[ai][1][m][1] * rs;
#pragma unroll
                for (int e = 0; e < 4; ++e) { v0[e] = v0[e] * fsigmoid(v0[e]) * w0[e]; v1[e] = v1[e] * fsigmoid(v1[e]) * w1[e]; }
                *(u32x4*)(H + (size_t)row * 2816 + col0) = pack8(v0, v1); }
    }
};

template <class Epi, class Sched, bool ALIGN_EPI = false, bool SP2 = false>
__device__ __forceinline__ void gemm_phase(PG8_LAS unsigned char* lds, const Gemm g, const Sched& S, const Epi& E, int tid_in) {
    int tid_ = tid_in; asm volatile("" : "+v"(tid_));
    const int tid = tid_, wid = __builtin_amdgcn_readfirstlane(tid >> 6), lane = tid & 63, wr = wid >> 2, wc = wid & 3, fr = lane & 15, fq = lane >> 4;
    int K_ = g.K; asm volatile("" : "+s"(K_));
    const int K = K_, nt = K / BK;
    unsigned voffA[2], voffB[2];
#pragma unroll
    for (int i = 0; i < 2; ++i) { int R, C; stage_rc(tid * 16 + i * 8192, R, C); const int Rb = Epi::PERM ? ((R & ~31) + perm32(R & 31)) : R;
        voffA[i] = (unsigned)(R * g.lda + C) * 2u; voffB[i] = (unsigned)(Rb * g.ldb + C) * 2u; }
    const size_t kstep = (size_t)(BK * 2);
    const size_t hstepA = (size_t)HALF * g.lda * 2, hstepB = (size_t)HALF * g.ldb * 2;
    const size_t tstepA = 2 * hstepA, tstepB = 2 * hstepB;
    const unsigned ldsw = (unsigned)wid * 1024u;
    const int aoff = lds_byte(wr * 64 + fr, fq * 8), boff = lds_byte(wc * 32 + fr, fq * 8);
#define PG8_SA(b, h) (((b) * 2 + (h)) * HTB)
#define PG8_SB(b, h) ((4 + (b) * 2 + (h)) * HTB)
#define PG8_STAGE(bufoff, gbase, voff) do { _Pragma("unroll") for (int _i = 0; _i < 2; ++_i) \
        __builtin_amdgcn_global_load_lds((const unsigned*)((const char*)(gbase) + (voff)[_i]), (PG8_LAS unsigned*)(lds + (bufoff) + ldsw + _i * 8192), 16, 0, 0); } while (0)
#define PG8_LDA(dst, b, h) do { _Pragma("unroll") for (int m = 0; m < 4; ++m) _Pragma("unroll") for (int k = 0; k < 2; ++k) dst[m][k] = *(const PG8_LAS bf16x8*)(lds + PG8_SA(b, h) + aoff + m * 2048 + k * 1024); } while (0)
#define PG8_LDB(dst, b, h) do { _Pragma("unroll") for (int n = 0; n < 2; ++n) _Pragma("unroll") for (int k = 0; k < 2; ++k) dst[n][k] = *(const PG8_LAS bf16x8*)(lds + PG8_SB(b, h) + boff + n * 2048 + k * 1024); } while (0)
#define PG8_MMA(ai, bj, At, Bt) do { __builtin_amdgcn_s_setprio(1); _Pragma("unroll") for (int m = 0; m < 4; ++m) _Pragma("unroll") for (int n = 0; n < 2; ++n) _Pragma("unroll") for (int k = 0; k < 2; ++k) \
        acc[ai][bj][m][n] = __builtin_amdgcn_mfma_f32_16x16x32_bf16(Bt[n][k], At[m][k], acc[ai][bj][m][n], 0, 0, 0); __builtin_amdgcn_s_setprio(0); } while (0)
#define PG8_WAIT_V(n) asm volatile("s_waitcnt vmcnt(" #n ")" ::: "memory")
#define PG8_WAIT_L(n) asm volatile("s_waitcnt lgkmcnt(" #n ")" ::: "memory")
#define PG8_BAR __builtin_amdgcn_s_barrier()
#define PG8_SCHED __builtin_amdgcn_sched_barrier(0)
    Unit cur, nxt; int ui = 0;
    if (!S.next(0, cur)) return;
    f32x4 acc[2][2][4][2];
#pragma unroll
    for (int a = 0; a < 2; ++a)
#pragma unroll
        for (int b = 0; b < 2; ++b)
#pragma unroll
            for (int m = 0; m < 4; ++m)
#pragma unroll
                for (int n = 0; n < 2; ++n) acc[a][b][m][n] = (f32x4){0.f, 0.f, 0.f, 0.f};
    bf16x8 At[4][2], B0[2][2], B1[2][2];
    const char* cA = (const char*)g.A + (size_t)cur.pm * tstepA; const char* cB = (const char*)g.Bt + (size_t)cur.pn * tstepB;
    S.a_ready(cur);
    if constexpr (SP2) {
        PG8_STAGE(PG8_SB(0, 0), cB, voffB); PG8_STAGE(PG8_SB(0, 1), cB + hstepB, voffB); PG8_STAGE(PG8_SA(0, 0), cA, voffA); PG8_STAGE(PG8_SA(0, 1), cA + hstepA, voffA);
        if (wr == 1) PG8_BAR;
        PG8_WAIT_V(2); PG8_BAR;
        PG8_STAGE(PG8_SB(1, 0), cB + kstep, voffB); PG8_STAGE(PG8_SA(1, 0), cA + kstep, voffA); PG8_STAGE(PG8_SB(1, 1), cB + hstepB + kstep, voffB);
        PG8_WAIT_V(6); PG8_BAR;
    } else {
        PG8_STAGE(PG8_SB(0, 0), cB, voffB); PG8_STAGE(PG8_SA(0, 0), cA, voffA); PG8_STAGE(PG8_SB(0, 1), cB + hstepB, voffB); PG8_STAGE(PG8_SA(0, 1), cA + hstepA, voffA);
        if (wr == 1) PG8_BAR;
        PG8_WAIT_V(4); PG8_BAR;
        PG8_STAGE(PG8_SB(1, 0), cB + kstep, voffB); PG8_STAGE(PG8_SA(1, 0), cA + kstep, voffA); PG8_STAGE(PG8_SB(1, 1), cB + hstepB + kstep, voffB);
        PG8_WAIT_V(6); PG8_BAR;
    }
    for (;;) {
        const bool has_next = S.next(ui + 1, nxt);
        const char* nA = has_next ? (const char*)g.A + (size_t)nxt.pm * tstepA : cA; const char* nB = has_next ? (const char*)g.Bt + (size_t)nxt.pn * tstepB : cB;
        for (int t = 0; t < nt; t += 2) {
            if constexpr (Epi::HOOK_T > 0) { if (t == Epi::HOOK_T) { int frx = fr; asm volatile("" : "+v"(frx)); E.mid(acc, cur, wr, wc, frx, fq); } }
            const bool last = (t == nt - 2);
            const char* a1 = cA + (size_t)(t + 1) * kstep;
            const char* a2 = last ? nA : cA + (size_t)(t + 2) * kstep; const char* b2 = last ? nB : cB + (size_t)(t + 2) * kstep;
            const char* a3 = a2 + kstep; const char* b3 = b2 + kstep;
            if (last && has_next) S.a_ready(nxt);
            if constexpr (SP2) {
            PG8_LDB(B0, 0, 0); PG8_LDB(B1, 0, 1); PG8_SCHED; PG8_LDA(At, 0, 0); PG8_STAGE(PG8_SA(1, 1), a1 + hstepA, voffA);
            PG8_WAIT_V(8); PG8_WAIT_L(0); PG8_BAR; PG8_MMA(0, 0, At, B0); PG8_MMA(0, 1, At, B1); PG8_BAR; PG8_SCHED;
            PG8_LDA(At, 0, 1); PG8_STAGE(PG8_SB(0, 0), b2, voffB); PG8_STAGE(PG8_SB(0, 1), b2 + hstepB, voffB); PG8_STAGE(PG8_SA(0, 0), a2, voffA);
            PG8_WAIT_V(8); PG8_WAIT_L(0); PG8_BAR; PG8_MMA(1, 0, At, B0); PG8_MMA(1, 1, At, B1); PG8_BAR; PG8_SCHED;
            PG8_LDB(B0, 1, 0); PG8_LDB(B1, 1, 1); PG8_SCHED; PG8_LDA(At, 1, 0); PG8_STAGE(PG8_SA(0, 1), a2 + hstepA, voffA);
            PG8_WAIT_V(8); PG8_WAIT_L(0); PG8_BAR; PG8_MMA(0, 0, At, B0); PG8_MMA(0, 1, At, B1); PG8_BAR; PG8_SCHED;
            PG8_LDA(At, 1, 1); PG8_STAGE(PG8_SB(1, 0), b3, voffB); PG8_STAGE(PG8_SB(1, 1), b3 + hstepB, voffB); PG8_STAGE(PG8_SA(1, 0), a3, voffA);
            PG8_WAIT_V(8); PG8_WAIT_L(0); PG8_BAR; PG8_MMA(1, 0, At, B0); PG8_MMA(1, 1, At, B1); PG8_BAR; PG8_SCHED;
            } else {
            PG8_LDB(B0, 0, 0); PG8_SCHED; PG8_LDA(At, 0, 0); PG8_STAGE(PG8_SA(1, 1), a1 + hstepA, voffA);
            PG8_WAIT_L(8); PG8_BAR; PG8_WAIT_L(0); PG8_MMA(0, 0, At, B0); PG8_BAR; PG8_SCHED;
            PG8_LDB(B1, 0, 1); PG8_STAGE(PG8_SB(0, 0), b2, voffB);
            PG8_BAR; PG8_WAIT_L(0); PG8_MMA(0, 1, At, B1); PG8_BAR;
            PG8_LDA(At, 0, 1); PG8_STAGE(PG8_SA(0, 0), a2, voffA);
            PG8_BAR; PG8_WAIT_L(0); PG8_MMA(1, 0, At, B0); PG8_BAR; PG8_SCHED;
            PG8_STAGE(PG8_SB(0, 1), b2 + hstepB, voffB);
            PG8_WAIT_V(6); PG8_BAR; PG8_MMA(1, 1, At, B1); PG8_BAR;
            PG8_LDB(B0, 1, 0); PG8_SCHED; PG8_LDA(At, 1, 0); PG8_STAGE(PG8_SA(0, 1), a2 + hstepA, voffA);
            PG8_WAIT_L(8); PG8_BAR; PG8_WAIT_L(0); PG8_MMA(0, 0, At, B0); PG8_BAR; PG8_SCHED;
            PG8_LDB(B1, 1, 1); PG8_STAGE(PG8_SB(1, 0), b3, voffB);
            PG8_BAR; PG8_WAIT_L(0); PG8_MMA(0, 1, At, B1); PG8_BAR;
            PG8_LDA(At, 1, 1); PG8_STAGE(PG8_SA(1, 0), a3, voffA);
            PG8_BAR; PG8_WAIT_L(0); PG8_MMA(1, 0, At, B0); PG8_BAR; PG8_SCHED;
            PG8_STAGE(PG8_SB(1, 1), b3 + hstepB, voffB);
            PG8_WAIT_V(6); PG8_BAR; PG8_MMA(1, 1, At, B1); PG8_BAR;
            }
        }
        if constexpr (ALIGN_EPI) { if (wr == 0) PG8_BAR; }
        if constexpr (!Epi::AFTER_DRAIN) { int frx = fr; asm volatile("" : "+v"(frx)); E(acc, cur, wr, wc, frx, fq); S.done(cur); }
        if (!has_next) break;
#pragma unroll
        for (int a = 0; a < 2; ++a)
#pragma unroll
            for (int b = 0; b < 2; ++b)
#pragma unroll
                for (int m = 0; m < 4; ++m)
#pragma unroll
                    for (int n = 0; n < 2; ++n) acc[a][b][m][n] = (f32x4){0.f, 0.f, 0.f, 0.f};
        cur = nxt; cA = nA; cB = nB; ++ui;
        if constexpr (ALIGN_EPI) { if (wr == 1) PG8_BAR; }
    }
    PG8_WAIT_V(0);
    if constexpr (!ALIGN_EPI) { if (wr == 0) PG8_BAR; }
    PG8_BAR;
    if constexpr (Epi::AFTER_DRAIN) { E.fused(acc, cur, wr, wc, fr, fq, lds, wid, lane); S.done(cur); }
#undef PG8_SA
#undef PG8_SB
#undef PG8_STAGE
#undef PG8_LDA
#undef PG8_LDB
#undef PG8_MMA
#undef PG8_WAIT_V
#undef PG8_WAIT_L
#undef PG8_BAR
#undef PG8_SCHED
}
}

#define LAS __attribute__((address_space(3)))
typedef LAS unsigned char* ldsp;
typedef unsigned short bf16;
typedef _Float16 f16;
typedef float f32x4 __attribute__((ext_vector_type(4)));
typedef float f32x16 __attribute__((ext_vector_type(16)));
typedef short bf16x8 __attribute__((ext_vector_type(8)));
typedef unsigned u32x4 __attribute__((ext_vector_type(4)));
typedef unsigned u32x2 __attribute__((ext_vector_type(2)));

constexpr int T = 32768, DM = 1024, SEQ = 4096, DEPTH = 4, DFF = 2816, DIN = 5632;
constexpr size_t MiB = 1u << 20;
constexpr size_t WS_W0 = 2 * MiB, WS_WSTRIDE = 36 * MiB;
constexpr size_t WS_PB = 74 * MiB;
constexpr size_t WS_BX = 90 * MiB, WS_BU = 154 * MiB;
constexpr size_t WS_SSQA = 218 * MiB, WS_SSQB = 220 * MiB, WS_SSQC = 222 * MiB;
constexpr size_t WS_LB = 224 * MiB;
constexpr size_t WS_ADEC = 225 * MiB;
constexpr size_t WS_RQ = 226 * MiB, WS_RLF = 258 * MiB, WS_RI = 290 * MiB, WS_ROAB = 322 * MiB, WS_RAK = 386 * MiB, WS_RAVT = 418 * MiB, WS_RU = 450 * MiB;
constexpr size_t WS_GA = 226 * MiB, WS_GB = 450 * MiB, WS_MERGED = 386 * MiB, WS_HB = 226 * MiB;
constexpr size_t WS_END = 515 * MiB;
constexpr size_t WO_IN = 0, WO_AB = WO_IN + (size_t)DIN * 1024, WO_OUT = WO_AB + 1024 * 1024, WO_GU = WO_OUT + 1024 * 1024, WO_D = WO_GU + (size_t)DIN * 1024,
                 WO_PG = WO_D + (size_t)1024 * DFF, WO_PE = WO_PG + 1024 * 1024, WO_END = WO_PE + 1024 * 256;
static_assert(WO_END * 2 <= WS_WSTRIDE, "weight set");
constexpr int RING_BYTES = 131072, EPI_SCR = 139264, LDS_BYTES = 155648;

__device__ __forceinline__ unsigned pk2(float lo, float hi) { typedef float f2_ __attribute__((ext_vector_type(2))); typedef __bf16 b2_ __attribute__((ext_vector_type(2))); f2_ v = {lo, hi}; b2_ b = __builtin_convertvector(v, b2_); return __builtin_bit_cast(unsigned, b); }
__device__ __forceinline__ unsigned f2bf(float f) { return pk2(f, 0.f) & 0xffffu; }
__device__ __forceinline__ float b2f(unsigned h) { return __uint_as_float(h << 16); }
__device__ __forceinline__ float wave_sum(float v) {
#pragma unroll
    for (int o = 1; o < 64; o <<= 1) v += __shfl_xor(v, o);
    return v;
}

__device__ __forceinline__ int map_row(int mode, int n) {
    if (mode == 1) { if (n >= 2048 && n < 3072) { const int tile = n & ~255, o = n & 255, hd = o >> 6, d = o & 63; return tile + 128 * (d >> 5) + 32 * hd + (d & 31); } return n; }
    if (mode == 2) return (n >> 7) * 256 + (n & 127);
    if (mode == 3) return (n >> 7) * 256 + 128 + (n & 127);
    return n;
}
struct CvtP { const float* W; const float* gk; bf16* WT; int N, Kd, koff, mode, item; };
struct Ins { const float* in[19]; };
__device__ __forceinline__ CvtP cvt_params(const Ins& I, int l, bf16* Wb, int it) {
    constexpr int I_IN = 16 * 176, I_A = 8 * 32, I_O = 16 * 32, I_G = 16 * 88, I_D = 44 * 32, I_PG = 16 * 32;
    int r = it; CvtP p;
    if (r < I_IN) { p = CvtP{I.in[3] + (size_t)l * 1024 * DIN, I.in[2] + l * 1024, Wb + WO_IN, DIN, 1024, 0, 1, r}; return p; } r -= I_IN;
    if (r < I_A) { p = CvtP{I.in[9] + (size_t)l * 512 * 1024, nullptr, Wb + WO_AB, 1024, 1024, 0, 0, r}; return p; } r -= I_A;
    if (r < I_A) { p = CvtP{I.in[10] + (size_t)l * 512 * 1024, nullptr, Wb + WO_AB, 1024, 1024, 512, 0, r}; return p; } r -= I_A;
    if (r < I_O) { p = CvtP{I.in[11] + (size_t)l * 1024 * 1024, nullptr, Wb + WO_OUT, 1024, 1024, 0, 0, r}; return p; } r -= I_O;
    if (r < I_G) { p = CvtP{I.in[13] + (size_t)l * 1024 * DFF, I.in[12] + l * 1024, Wb + WO_GU, DFF, 1024, 0, 2, r}; return p; } r -= I_G;
    if (r < I_G) { p = CvtP{I.in[14] + (size_t)l * 1024 * DFF, I.in[12] + l * 1024, Wb + WO_GU, DFF, 1024, 0, 3, r}; return p; } r -= I_G;
    if (r < I_D) { p = CvtP{I.in[15] + (size_t)l * DFF * 1024, nullptr, Wb + WO_D, 1024, DFF, 0, 0, r}; return p; } r -= I_D;
    if (r < I_PG) { p = CvtP{I.in[17] + (size_t)l * 1024 * 1024, I.in[16] + l * 1024, Wb + WO_PG, 1024, 1024, 0, 0, r}; return p; } r -= I_PG;
    p = CvtP{I.in[18] + (size_t)l * 256 * 1024, nullptr, Wb + WO_PE, 1024, 256, 0, 0, r}; return p;
}
__device__ __forceinline__ void cvt_load(const CvtP& p, f32x4 (&wv)[8], float (&gv)[8], int lane) {
    const int nblk = p.N / 32, kb = p.item / nblk, nb = p.item % nblk, k0 = 64 * kb, n0 = 32 * nb;
#pragma unroll
    for (int i = 0; i < 8; ++i) { const int kk = 8 * i + (lane >> 3); wv[i] = *(const f32x4*)(p.W + (size_t)(k0 + kk) * p.N + n0 + 4 * (lane & 7)); gv[i] = p.gk ? p.gk[k0 + kk] : 1.f; }
}
__device__ __forceinline__ void cvt_store(const CvtP& p, const f32x4 (&wv)[8], const float (&gv)[8], LAS float* scr, int lane) {
    const int nblk = p.N / 32, kb = p.item / nblk, nb = p.item % nblk, k0 = 64 * kb, n0 = 32 * nb;
#pragma unroll
    for (int i = 0; i < 8; ++i) { const int kk = 8 * i + (lane >> 3); LAS float* d = scr + kk * 33 + 4 * (lane & 7);
        d[0] = wv[i][0] * gv[i]; d[1] = wv[i][1] * gv[i]; d[2] = wv[i][2] * gv[i]; d[3] = wv[i][3] * gv[i]; }
    asm volatile("s_waitcnt lgkmcnt(0)" ::: "memory");
    const int c = lane & 7;
#pragma unroll
    for (int j = 0; j < 4; ++j) { const int n = (lane >> 3) + 8 * j; const LAS float* s = scr + (8 * c) * 33 + n;
        u32x4 o; o.x = pk2(s[0 * 33], s[1 * 33]); o.y = pk2(s[2 * 33], s[3 * 33]); o.z = pk2(s[4 * 33], s[5 * 33]); o.w = pk2(s[6 * 33], s[7 * 33]);
        *(u32x4*)(p.WT + (size_t)map_row(p.mode, n0 + n) * p.Kd + p.koff + k0 + 8 * c) = o; }
    asm volatile("s_waitcnt lgkmcnt(0)" ::: "memory");
}
__device__ __forceinline__ void cvt_weights(const Ins& I, int l, bf16* Wb, ldsp L, int wave, int lane) {
    LAS float* scr = (LAS float*)(L + wave * 16384);
    const int gw = blockIdx.x * 8 + wave, NGW = gridDim.x * 8;
    constexpr int NIT = 16 * 176 + 2 * 8 * 32 + 16 * 32 + 2 * 16 * 88 + 44 * 32 + 16 * 32 + 4 * 32;
    if (gw >= NIT) return;
    CvtP pc = cvt_params(I, l, Wb, gw); f32x4 wa[8]; float ga[8];
    cvt_load(pc, wa, ga, lane);
#pragma unroll 1
    for (int it = gw; it < NIT; it += NGW) {
        const int nx = it + NGW < NIT ? it + NGW : it;
        const CvtP pn = cvt_params(I, l, Wb, nx); f32x4 wb[8]; float gb[8];
        cvt_load(pn, wb, gb, lane);
        __builtin_amdgcn_sched_barrier(0);
        cvt_store(pc, wa, ga, scr, lane);
        pc = pn;
#pragma unroll
        for (int i = 0; i < 8; ++i) { wa[i] = wb[i]; ga[i] = gb[i]; }
    }
}
__device__ __forceinline__ void cvt_p(const float* p, bf16* PB, int tid_in) {
    int tid_ = tid_in; asm volatile("" : "+v"(tid_));
    const size_t n8 = (size_t)T * 256 / 8; const size_t gt = (size_t)blockIdx.x * 512 + tid_, NT = (size_t)gridDim.x * 512;
    for (size_t i0 = gt; i0 < n8; i0 += 4 * NT) {
        f32x4 a[4], b[4];
#pragma unroll
        for (int u = 0; u < 4; ++u) { const size_t i = i0 + u * NT; if (i < n8) { a[u] = *(const f32x4*)(p + i * 8); b[u] = *(const f32x4*)(p + i * 8 + 4); } }
#pragma unroll
        for (int u = 0; u < 4; ++u) { const size_t i = i0 + u * NT; if (i < n8) { u32x4 o; o.x = pk2(a[u][0], a[u][1]); o.y = pk2(a[u][2], a[u][3]); o.z = pk2(b[u][0], b[u][1]); o.w = pk2(b[u][2], b[u][3]); *(u32x4*)(PB + i * 8) = o; } } }
}
__device__ __forceinline__ void cvt_x(const float* x, bf16* XB, float* ssq, int wave, int lane) {
    const int gw = blockIdx.x * 8 + wave, NGW = gridDim.x * 8;
    for (int row0 = gw; row0 < T; row0 += 4 * NGW) {
        f32x4 v[4][4];
#pragma unroll
        for (int u = 0; u < 4; ++u) { const int row = row0 + u * NGW; if (row < T) { const f32x4* xr = (const f32x4*)(x + (size_t)row * 1024) + lane;
#pragma unroll
            for (int j = 0; j < 4; ++j) v[u][j] = xr[64 * j]; } }
#pragma unroll
        for (int u = 0; u < 4; ++u) { const int row = row0 + u * NGW; if (row < T) { float s = 0.f;
#pragma unroll
            for (int j = 0; j < 4; ++j) s += (v[u][j][0] * v[u][j][0] + v[u][j][1] * v[u][j][1]) + (v[u][j][2] * v[u][j][2] + v[u][j][3] * v[u][j][3]);
            s = wave_sum(s);
            u32x2* o = (u32x2*)(XB + (size_t)row * 1024) + lane;
#pragma unroll
            for (int j = 0; j < 4; ++j) { u32x2 w; w.x = pk2(v[u][j][0], v[u][j][1]); w.y = pk2(v[u][j][2], v[u][j][3]); o[64 * j] = w; }
            if (lane < 16) ssq[(size_t)row * 16 + lane] = lane == 0 ? s : 0.f; } }
    }
}

#define MFMA16(a, b, c) __builtin_amdgcn_mfma_f32_16x16x32_bf16((a), (b), (c), 0, 0, 0)
#define MFMA32(a, b, c) __builtin_amdgcn_mfma_f32_32x32x16_bf16((a), (b), (c), 0, 0, 0)
__device__ __forceinline__ void hgrn_stageA(ldsp L, int item_first, int item_step, bf16* RQ, const f16* RLF, bf16* RI, bf16* U, float* ADEC, int tid_in) {
    constexpr int QS = 0, KS = 17408, KT = 34816, IT = 53248, AS = 71680, TOT = 80896;
    int tid_ = tid_in; asm volatile("" : "+v"(tid_));
    const int tid = tid_, lane = tid & 63, w = __builtin_amdgcn_readfirstlane(tid >> 6), fr = lane & 15, fq = lane >> 4;
    const int k = tid & 127, tq = tid >> 7;
    unsigned short lfn[16], qn[16], in_[16];
#define SA_LOAD(item_) do { const int bh_ = (item_) >> 6, c_ = (item_) & 63; const size_t r_ = (size_t)(bh_ >> 2) * SEQ + c_ * 64 + 16 * tq; const int hc_ = (bh_ & 3) * 128; \
        const unsigned short* lp_ = (const unsigned short*)RLF + r_ * 512 + hc_ + k; const bf16* qp_ = RQ + r_ * 512 + hc_ + k; const bf16* ip_ = RI + r_ * 512 + hc_ + k; \
        _Pragma("unroll") for (int j = 0; j < 16; ++j) { lfn[j] = lp_[(size_t)j * 512]; qn[j] = qp_[(size_t)j * 512]; in_[j] = ip_[(size_t)j * 512]; } } while (0)
#define SA_BAR() asm volatile("s_waitcnt lgkmcnt(0)\n\ts_barrier" ::: "memory")
    SA_LOAD(item_first);
    float lf[16]; unsigned qraw[16], iraw[16];
#define SA_CONSUME() do { _Pragma("unroll") for (int j = 0; j < 16; ++j) { lf[j] = (float)__builtin_bit_cast(_Float16, lfn[j]); qraw[j] = qn[j]; iraw[j] = in_[j]; } } while (0)
    SA_CONSUME();
#pragma unroll 1
    for (int item = item_first; item < 2048; item += item_step) {
    const int bh = item >> 6, c = item & 63, b = bh >> 2, h = bh & 3, hc = h * 128;
    const size_t row0 = (size_t)b * SEQ + c * 64;
    bf16* qp = RQ + (row0 + 16 * tq) * 512 + hc + k;
    float cs[16];
    { const int nxt_ = item + item_step < 2048 ? item + item_step : item; SA_LOAD(nxt_); }
    __builtin_amdgcn_sched_barrier(0);
    { float run = 0.f;
#pragma unroll
      for (int j = 0; j < 16; ++j) { run += lf[j]; cs[j] = run; } }
    ((LAS float*)(L + TOT))[tq * 128 + k] = cs[15];
    SA_BAR();
    const float t0 = ((LAS float*)(L + TOT))[k], t1 = ((LAS float*)(L + TOT))[128 + k], t2 = ((LAS float*)(L + TOT))[256 + k], t3 = ((LAS float*)(L + TOT))[384 + k];
    const float off = tq == 0 ? 0.f : (tq == 1 ? t0 : (tq == 2 ? t0 + t1 : (t0 + t1) + t2));
    const float bmid = t0 + t1, blast = (t0 + t1) + (t2 + t3);
    unsigned kt[16];
    const float c_last = __expf(blast - bmid), c_mid = __expf(bmid);
#pragma unroll
    for (int j = 0; j < 16; ++j) {
        const float bb = off + cs[j]; const float q = b2f(qraw[j]) * 0.08838834764831845f; const float kk = 1.f - __expf(lf[j]);
        const float ee = __expf(fminf(fmaxf(bb - bmid, -60.f), 60.f)), ei = __builtin_amdgcn_rcpf(ee);
        const float qpv = q * ee, kpv = kk * ei, kpp = kpv * c_last, qe = qpv * c_mid;
        const int t = 16 * tq + j;
        *(LAS unsigned short*)(L + QS + t * 272 + k * 2) = (unsigned short)f2bf(qpv);
        *(LAS unsigned short*)(L + KS + t * 272 + k * 2) = (unsigned short)f2bf(kpv);
        kt[j] = f2bf(kpp);
        qp[(size_t)j * 512] = (bf16)f2bf(qe);
    }
    { u32x4 a, bq;
      a.x = kt[0] | (kt[1] << 16); a.y = kt[2] | (kt[3] << 16); a.z = kt[4] | (kt[5] << 16); a.w = kt[6] | (kt[7] << 16);
      bq.x = kt[8] | (kt[9] << 16); bq.y = kt[10] | (kt[11] << 16); bq.z = kt[12] | (kt[13] << 16); bq.w = kt[14] | (kt[15] << 16);
      *(LAS u32x4*)(L + KT + k * 144 + tq * 32) = a; *(LAS u32x4*)(L + KT + k * 144 + tq * 32 + 16) = bq;
      a.x = iraw[0] | (iraw[1] << 16); a.y = iraw[2] | (iraw[3] << 16); a.z = iraw[4] | (iraw[5] << 16); a.w = iraw[6] | (iraw[7] << 16);
      bq.x = iraw[8] | (iraw[9] << 16); bq.y = iraw[10] | (iraw[11] << 16); bq.z = iraw[12] | (iraw[13] << 16); bq.w = iraw[14] | (iraw[15] << 16);
      *(LAS u32x4*)(L + IT + k * 144 + tq * 32) = a; *(LAS u32x4*)(L + IT + k * 144 + tq * 32 + 16) = bq; }
    if (tq == 0) ADEC[(size_t)item * 128 + k] = __expf(blast);
    SA_BAR();
    { const int tb = w >> 1;
#pragma unroll
      for (int sbi = 0; sbi < 2; ++sbi) { const int sb = 2 * (w & 1) + sbi; f32x4 acc = {0.f, 0.f, 0.f, 0.f};
          if (sb <= tb) {
#pragma unroll
              for (int kk = 0; kk < 4; ++kk) { const bf16x8 a = *(const LAS bf16x8*)(L + QS + (16 * tb + fr) * 272 + (32 * kk + 8 * fq) * 2), bb = *(const LAS bf16x8*)(L + KS + (16 * sb + fr) * 272 + (32 * kk + 8 * fq) * 2);
                  acc = MFMA16(a, bb, acc); } }
#pragma unroll
          for (int r = 0; r < 4; ++r) { const int t = 16 * tb + 4 * fq + r, s = 16 * sb + fr; const float v = (sb <= tb && t >= s) ? acc[r] : 0.f;
              *(LAS unsigned short*)(L + AS + t * 144 + s * 2) = (unsigned short)f2bf(v); } } }
    SA_BAR();
    { const int v = 16 * w + fr;
      u32x2 o2[4], u3[8];
      bf16x8 ib[2];
#pragma unroll
      for (int ks = 0; ks < 2; ++ks) ib[ks] = *(const LAS bf16x8*)(L + IT + v * 144 + (32 * ks + 8 * fq) * 2);
#pragma unroll
      for (int tb = 0; tb < 4; ++tb) { f32x4 acc = {0.f, 0.f, 0.f, 0.f};
#pragma unroll
          for (int ks = 0; ks < 2; ++ks) { const bf16x8 a = *(const LAS bf16x8*)(L + AS + (16 * tb + fr) * 144 + (32 * ks + 8 * fq) * 2); acc = MFMA16(a, ib[ks], acc); }
          o2[tb].x = pk2(acc[0], acc[1]); o2[tb].y = pk2(acc[2], acc[3]); }
#pragma unroll
      for (int kb = 0; kb < 8; ++kb) { f32x4 acc = {0.f, 0.f, 0.f, 0.f};
#pragma unroll
          for (int ks = 0; ks < 2; ++ks) { const bf16x8 a = *(const LAS bf16x8*)(L + KT + (16 * kb + fr) * 144 + (32 * ks + 8 * fq) * 2); acc = MFMA16(a, ib[ks], acc); }
          u3[kb].x = pk2(acc[0], acc[1]); u3[kb].y = pk2(acc[2], acc[3]); }
      SA_CONSUME();
      __builtin_amdgcn_sched_barrier(0);
#pragma unroll
      for (int tb = 0; tb < 4; ++tb) *(u32x2*)(RI + (row0 + (v >> 1)) * 512 + hc + (v & 1) * 64 + 16 * tb + 4 * fq) = o2[tb];
#pragma unroll
      for (int kb = 0; kb < 8; ++kb) *(u32x2*)(U + (size_t)item * 16384 + v * 128 + 16 * kb + 4 * fq) = u3[kb]; }
    SA_BAR();
    }
#undef SA_LOAD
#undef SA_CONSUME
#undef SA_BAR
}

template <int CTRL> __device__ __forceinline__ float dppf(float v) { return __builtin_bit_cast(float, __builtin_amdgcn_update_dpp(0, __builtin_bit_cast(int, v), CTRL, 0xf, 0xf, true)); }
__device__ __forceinline__ float row_sum16(float s) { s += dppf<0xB1>(s); s += dppf<0x4E>(s); s += dppf<0x124>(s); s += dppf<0x128>(s); return s; }
__device__ __forceinline__ unsigned cvtpk(float lo, float hi) { typedef float f2 __attribute__((ext_vector_type(2))); typedef __bf16 b2 __attribute__((ext_vector_type(2))); f2 v = {lo, hi}; b2 b = __builtin_convertvector(v, b2); return __builtin_bit_cast(unsigned, b); }
template <int GLOBAL_OUT> __device__ __forceinline__ void hgrn_scan_wave(ldsp L, bf16* OINT, int bh, int vs, const bf16* RQ, const bf16* U, const float* ADEC, int lane_in) {
    int lane = lane_in; asm volatile("" : "+v"(lane));
    const int fr = lane & 15, fq = lane >> 4;
    const int b = bh >> 2, h = bh & 3, hc = h * 128, v = 16 * vs + fr;
    float S[4][8];
#pragma unroll
    for (int kb = 0; kb < 4; ++kb)
#pragma unroll
        for (int j = 0; j < 8; ++j) S[kb][j] = 0.f;
    const bf16* pq = RQ + ((size_t)b * SEQ + fr) * 512 + hc + 8 * fq;
    const bf16* pu = U + (size_t)bh * 64 * 16384 + v * 128 + 8 * fq;
    const float* pa = ADEC + (size_t)bh * 64 * 128 + 8 * fq;
    bf16* pg = OINT + (size_t)bh * 64 * 8192 + v * 64 + 4 * fq;
    ldsp po = L + fr * 128 + 8 * fq;
    bf16x8 Aq[4][4]; u32x4 Uv[4]; f32x4 av[4][2];
#pragma unroll
    for (int tb = 0; tb < 4; ++tb)
#pragma unroll
        for (int kb = 0; kb < 4; ++kb) Aq[tb][kb] = *(const bf16x8*)(pq + tb * 16 * 512 + kb * 32);
#pragma unroll
    for (int kb = 0; kb < 4; ++kb) { Uv[kb] = *(const u32x4*)(pu + kb * 32); av[kb][0] = *(const f32x4*)(pa + kb * 32); av[kb][1] = *(const f32x4*)(pa + kb * 32 + 4); }
    const unsigned* tq_ = (const unsigned*)(RQ + ((size_t)b * SEQ + lane) * 512 + hc);
    const unsigned* tu_ = (const unsigned*)(U + (size_t)bh * 64 * 16384 + (16 * vs + (lane & 15)) * 128 + ((lane >> 4) & 1) * 64);
    unsigned tch0 = 0, tch1 = 0, tch2 = 0;
#pragma unroll 1
    for (int c = 0; c < 64; ++c) {
        pq += 64 * 512; pu += 16384; pa += 128;
        asm volatile("" :: "v"(tch0), "v"(tch1), "v"(tch2));
        { const int cp = c + 3 < 64 ? c + 3 : 63;
          tch0 = tq_[(size_t)cp * 64 * 256]; tch1 = tq_[(size_t)cp * 64 * 256 + 32]; tch2 = tu_[(size_t)cp * 8192]; }
        __builtin_amdgcn_sched_barrier(0);
        bf16x8 Sb[4];
#pragma unroll
        for (int kb = 0; kb < 4; ++kb) { u32x4 t; t.x = cvtpk(S[kb][0], S[kb][1]); t.y = cvtpk(S[kb][2], S[kb][3]); t.z = cvtpk(S[kb][4], S[kb][5]); t.w = cvtpk(S[kb][6], S[kb][7]); Sb[kb] = __builtin_bit_cast(bf16x8, t); }
#pragma unroll
        for (int tb = 0; tb < 4; ++tb) { f32x4 acc = {0.f, 0.f, 0.f, 0.f};
#pragma unroll
            for (int kb = 0; kb < 4; ++kb) acc = MFMA16(Aq[tb][kb], Sb[kb], acc);
#pragma unroll
            for (int kb = 0; kb < 4; ++kb) Aq[tb][kb] = *(const bf16x8*)(pq + tb * 16 * 512 + kb * 32);
            u32x2 o; o.x = cvtpk(acc[0], acc[1]); o.y = cvtpk(acc[2], acc[3]);
            if (GLOBAL_OUT) *(u32x2*)(pg + tb * 16) = o; else *(LAS u32x2*)(po + tb * 32) = o;
            __builtin_amdgcn_sched_barrier(0); }
        po += 2048; pg += 8192;
#pragma unroll
        for (int kb = 0; kb < 4; ++kb) {
            S[kb][0] = av[kb][0][0] * S[kb][0] + b2f(Uv[kb].x & 0xffffu); S[kb][1] = av[kb][0][1] * S[kb][1] + b2f(Uv[kb].x >> 16);
            S[kb][2] = av[kb][0][2] * S[kb][2] + b2f(Uv[kb].y & 0xffffu); S[kb][3] = av[kb][0][3] * S[kb][3] + b2f(Uv[kb].y >> 16);
            S[kb][4] = av[kb][1][0] * S[kb][4] + b2f(Uv[kb].z & 0xffffu); S[kb][5] = av[kb][1][1] * S[kb][5] + b2f(Uv[kb].z >> 16);
            S[kb][6] = av[kb][1][2] * S[kb][6] + b2f(Uv[kb].w & 0xffffu); S[kb][7] = av[kb][1][3] * S[kb][7] + b2f(Uv[kb].w >> 16);
            Uv[kb] = *(const u32x4*)(pu + kb * 32); av[kb][0] = *(const f32x4*)(pa + kb * 32); av[kb][1] = *(const f32x4*)(pa + kb * 32 + 4); }
        __builtin_amdgcn_sched_barrier(0);
    }
}
template <int GLOBAL_OUT> __device__ __forceinline__ void hgrn_scan_wave4(ldsp L, bf16* OINT, int bh, int vs, int tb, const bf16* RQ, const bf16* U, const float* ADEC, int lane_in) {
    int lane = lane_in; asm volatile("" : "+v"(lane));
    const int fr = lane & 15, fq = lane >> 4;
    const int b = bh >> 2, h = bh & 3, hc = h * 128, v = 16 * vs + fr;
    float S[4][8];
#pragma unroll
    for (int kb = 0; kb < 4; ++kb)
#pragma unroll
        for (int j = 0; j < 8; ++j) S[kb][j] = 0.f;
    const bf16* pq = RQ + ((size_t)b * SEQ + 16 * tb + fr) * 512 + hc + 8 * fq;
    const bf16* pu = U + (size_t)bh * 64 * 16384 + v * 128 + 8 * fq;
    const float* pa = ADEC + (size_t)bh * 64 * 128 + 8 * fq;
    ldsp po = L + fr * 128 + 8 * fq + tb * 32;
    bf16* pg = OINT + (size_t)bh * 64 * 8192 + v * 64 + 4 * fq + tb * 16;
    bf16x8 A0[4], A1[4]; u32x4 U0[4], U1[4]; f32x4 a0[4][2], a1[4][2];
#define SC_LOAD(A_, U_, a_, cc) do { _Pragma("unroll") for (int kb = 0; kb < 4; ++kb) { A_[kb] = *(const bf16x8*)(pq + (size_t)(cc) * 64 * 512 + kb * 32); \
        U_[kb] = *(const u32x4*)(pu + (size_t)(cc) * 16384 + kb * 32); a_[kb][0] = *(const f32x4*)(pa + (size_t)(cc) * 128 + kb * 32); a_[kb][1] = *(const f32x4*)(pa + (size_t)(cc) * 128 + kb * 32 + 4); } } while (0)
#define SC_STEP(A_, U_, a_, cc) do { bf16x8 Sb[4]; \
        _Pragma("unroll") for (int kb = 0; kb < 4; ++kb) { u32x4 t; t.x = cvtpk(S[kb][0], S[kb][1]); t.y = cvtpk(S[kb][2], S[kb][3]); t.z = cvtpk(S[kb][4], S[kb][5]); t.w = cvtpk(S[kb][6], S[kb][7]); Sb[kb] = __builtin_bit_cast(bf16x8, t); } \
        f32x4 acc = {0.f, 0.f, 0.f, 0.f}; \
        _Pragma("unroll") for (int kb = 0; kb < 4; ++kb) acc = MFMA16(A_[kb], Sb[kb], acc); \
        _Pragma("unroll") for (int kb = 0; kb < 4; ++kb) { \
            S[kb][0] = a_[kb][0][0] * S[kb][0] + b2f(U_[kb].x & 0xffffu); S[kb][1] = a_[kb][0][1] * S[kb][1] + b2f(U_[kb].x >> 16); \
            S[kb][2] = a_[kb][0][2] * S[kb][2] + b2f(U_[kb].y & 0xffffu); S[kb][3] = a_[kb][0][3] * S[kb][3] + b2f(U_[kb].y >> 16); \
            S[kb][4] = a_[kb][1][0] * S[kb][4] + b2f(U_[kb].z & 0xffffu); S[kb][5] = a_[kb][1][1] * S[kb][5] + b2f(U_[kb].z >> 16); \
            S[kb][6] = a_[kb][1][2] * S[kb][6] + b2f(U_[kb].w & 0xffffu); S[kb][7] = a_[kb][1][3] * S[kb][7] + b2f(U_[kb].w >> 16); } \
        __builtin_amdgcn_sched_barrier(0); \
        SC_LOAD(A_, U_, a_, (cc) + 2); \
        { u32x2 o; o.x = cvtpk(acc[0], acc[1]); o.y = cvtpk(acc[2], acc[3]); if (GLOBAL_OUT) *(u32x2*)(pg + (size_t)(cc) * 8192) = o; else *(LAS u32x2*)(po + (cc) * 2048) = o; } \
        __builtin_amdgcn_sched_barrier(0); } while (0)
    SC_LOAD(A0, U0, a0, 0); SC_LOAD(A1, U1, a1, 1);
#pragma unroll 1
    for (int c = 0; c < 64; c += 2) { SC_STEP(A0, U0, a0, c); SC_STEP(A1, U1, a1, c + 1); }
#undef SC_LOAD
#undef SC_STEP
}
__device__ __forceinline__ void hgrn_post(ldsp L, const bf16* OINT, const bf16* RI, bf16* ROAB, const float* gn, int wave, int lane_in) {
    int lane = lane_in; asm volatile("" : "+v"(lane));
    LAS float* tl = (LAS float*)(L + wave * 16384);
    const int t = lane >> 2, q = lane & 3;
    const int gw = blockIdx.x * 8 + wave, NGW = gridDim.x * 8;
    f32x4 gnv[8];
#pragma unroll
    for (int i = 0; i < 8; ++i) gnv[i] = *(const f32x4*)(gn + 32 * q + 4 * i);
#pragma unroll 1
    for (int task = gw; task < 8192; task += NGW) {
        const int item = task >> 2, tb = task & 3; const int bh = item >> 6, c = item & 63, b = bh >> 2, h = bh & 3, hc = h * 128;
        const size_t row0 = (size_t)b * SEQ + c * 64;
        bf16* op = ROAB + (row0 + 16 * tb + t) * 1024 + hc + 32 * q;
        u32x4 sgw4[4];
#pragma unroll
        for (int i = 0; i < 4; ++i) sgw4[i] = *(const u32x4*)(op + 8 * i);
#pragma unroll
        for (int hv = 0; hv < 2; ++hv) { const int v = lane + 64 * hv;
            const u32x4* p1 = (const u32x4*)(OINT + (size_t)item * 8192 + v * 64 + 16 * tb);
            const u32x4* p2 = (const u32x4*)(RI + (row0 + (v >> 1)) * 512 + hc + (v & 1) * 64 + 16 * tb);
            const u32x4 a0 = p1[0], a1 = p1[1], b0 = p2[0], b1 = p2[1];
            const unsigned wa[8] = {a0.x, a0.y, a0.z, a0.w, a1.x, a1.y, a1.z, a1.w}; const unsigned wb[8] = {b0.x, b0.y, b0.z, b0.w, b1.x, b1.y, b1.z, b1.w};
#pragma unroll
            for (int i = 0; i < 8; ++i) { tl[(2 * i) * 132 + v] = b2f(wa[i] & 0xffffu) + b2f(wb[i] & 0xffffu); tl[(2 * i + 1) * 132 + v] = b2f(wa[i] >> 16) + b2f(wb[i] >> 16); } }
        asm volatile("s_waitcnt lgkmcnt(0)" ::: "memory");
        f32x4 x[8]; float s = 0.f;
#pragma unroll
        for (int i = 0; i < 8; ++i) { x[i] = *(const LAS f32x4*)(tl + t * 132 + 32 * q + 4 * i); s += (x[i][0] * x[i][0] + x[i][1] * x[i][1]) + (x[i][2] * x[i][2] + x[i][3] * x[i][3]); }
        s += dppf<0xB1>(s); s += dppf<0x4E>(s);
        const float rinv = __builtin_amdgcn_rsqf(s * (1.0f / 128.0f) + 1e-6f);
#pragma unroll
        for (int i = 0; i < 4; ++i) { const u32x4 sgw = sgw4[i]; const f32x4 g0 = gnv[2 * i], g1 = gnv[2 * i + 1];
            const f32x4 xa = x[2 * i], xb = x[2 * i + 1]; u32x4 o;
            o.x = cvtpk(xa[0] * rinv * g0[0] * b2f(sgw.x & 0xffffu), xa[1] * rinv * g0[1] * b2f(sgw.x >> 16)); o.y = cvtpk(xa[2] * rinv * g0[2] * b2f(sgw.y & 0xffffu), xa[3] * rinv * g0[3] * b2f(sgw.y >> 16));
            o.z = cvtpk(xb[0] * rinv * g1[0] * b2f(sgw.z & 0xffffu), xb[1] * rinv * g1[1] * b2f(sgw.z >> 16)); o.w = cvtpk(xb[2] * rinv * g1[2] * b2f(sgw.w & 0xffffu), xb[3] * rinv * g1[3] * b2f(sgw.w >> 16));
            *(u32x4*)(op + 8 * i) = o; }
        asm volatile("s_waitcnt lgkmcnt(0)" ::: "memory");
    }
}

constexpr int AT_TAB = 0, AT_WS = 8 * 260 * 4;
__device__ __forceinline__ void attn_item(ldsp L, int wi, bf16* ROAB, const bf16* RAK, const bf16* RAVT, int w, int lane_) {
    int lane = lane_; asm volatile("" : "+v"(lane));
    const int half = wi & 1, h = (wi >> 1) & 7, n = (wi >> 4) & 63, b = wi >> 10;
    const int r32 = lane & 31, hi = lane >> 5;
    const size_t row0 = (size_t)b * SEQ + n * 64 + half * 32;
    bf16x8 qr[4];
#pragma unroll
    for (int d0 = 0; d0 < 4; ++d0) qr[d0] = *(const bf16x8*)(ROAB + (row0 + r32) * 1024 + 512 + h * 64 + 16 * d0 + 8 * hi);
    const LAS float* tab = (const LAS float*)(L + AT_TAB) + h * 260;
    LAS float* wsf = (LAS float*)(L + AT_WS) + w * 64;
    f32x16 o0, o1;
#pragma unroll
    for (int r = 0; r < 16; ++r) { o0[r] = 0.f; o1[r] = 0.f; }
    float mrun = -1e30f, lrun = 0.f;
    const bf16* kbase = RAK + ((size_t)(b * 8 + h) * 64) * 4096 + lane * 8;
    const bf16* vbase = RAVT + ((size_t)(b * 8 + h) * 64) * 4096 + lane * 8;
    const int tqpos = half * 32 + r32;
    const float cfar = tab[256];
    const int jstart = n >= 8 ? 0 : 8 - n;
    bf16x8 kf[2][4], vf[2][2][2];
#define ATT_LOAD(KF, VF, kc_) do { \
        _Pragma("unroll") for (int kh = 0; kh < 2; ++kh) _Pragma("unroll") for (int d0 = 0; d0 < 4; ++d0) KF[kh][d0] = *(const bf16x8*)(kbase + (size_t)(kc_) * 4096 + (kh * 4 + d0) * 512); \
        _Pragma("unroll") for (int dh = 0; dh < 2; ++dh) _Pragma("unroll") for (int kh = 0; kh < 2; ++kh) _Pragma("unroll") for (int blk = 0; blk < 2; ++blk) \
            VF[dh][kh][blk] = *(const bf16x8*)(vbase + (size_t)(kc_) * 4096 + ((dh * 2 + kh) * 2 + blk) * 512); } while (0)
    ATT_LOAD(kf, vf, n - 8 + jstart);
#pragma unroll 1
    for (int j = jstart; j <= 8; ++j) {
        bf16x8 kn[2][4], vn[2][2][2];
        { const int kcn = j < 8 ? n - 8 + j + 1 : n; ATT_LOAD(kn, vn, kcn); }
        __builtin_amdgcn_sched_barrier(0);
        f32x16 p0, p1;
#pragma unroll
        for (int r = 0; r < 16; ++r) { p0[r] = 0.f; p1[r] = 0.f; }
#pragma unroll
        for (int d0 = 0; d0 < 4; ++d0) { p0 = MFMA32(kf[0][d0], qr[d0], p0); p1 = MFMA32(kf[1][d0], qr[d0], p1); }
        float sub;
        if (j <= 5) { sub = mrun - cfar; }
        else {
            const int base = tqpos - ((j - 8) * 64 + 16 * hi) + 128;
#pragma unroll
            for (int r = 0; r < 16; ++r) { int i0 = base - r, i1 = base - r - 32; i0 = i0 < 0 ? 0 : (i0 > 256 ? 256 : i0); i1 = i1 < 0 ? 0 : (i1 > 256 ? 256 : i1);
                p0[r] += tab[i0]; p1[r] += tab[i1]; }
            sub = mrun;
        }
        if (j == jstart) {
            float mx = fmaxf(p0[0], p1[0]);
#pragma unroll
            for (int r = 1; r < 16; ++r) mx = fmaxf(mx, fmaxf(p0[r], p1[r]));
            mx = fmaxf(mx, shx(mx, lane, 32));
            if (j <= 5) { mrun = mx + cfar; sub = mx; } else { mrun = mx; sub = mx; }
        }
        float rs = 0.f;
#pragma unroll
        for (int r = 0; r < 16; ++r) { p0[r] = __builtin_amdgcn_exp2f(p0[r] - sub); p1[r] = __builtin_amdgcn_exp2f(p1[r] - sub); rs += p0[r] + p1[r]; }
        lrun += rs;
        bf16x8 pa[2][2];
        { u32x4 t;
          t.x = pk2(p0[0], p0[1]); t.y = pk2(p0[2], p0[3]); t.z = pk2(p0[4], p0[5]); t.w = pk2(p0[6], p0[7]); pa[0][0] = __builtin_bit_cast(bf16x8, t);
          t.x = pk2(p0[8], p0[9]); t.y = pk2(p0[10], p0[11]); t.z = pk2(p0[12], p0[13]); t.w = pk2(p0[14], p0[15]); pa[0][1] = __builtin_bit_cast(bf16x8, t);
          t.x = pk2(p1[0], p1[1]); t.y = pk2(p1[2], p1[3]); t.z = pk2(p1[4], p1[5]); t.w = pk2(p1[6], p1[7]); pa[1][0] = __builtin_bit_cast(bf16x8, t);
          t.x = pk2(p1[8], p1[9]); t.y = pk2(p1[10], p1[11]); t.z = pk2(p1[12], p1[13]); t.w = pk2(p1[14], p1[15]); pa[1][1] = __builtin_bit_cast(bf16x8, t); }
#pragma unroll
        for (int kh = 0; kh < 2; ++kh)
#pragma unroll
            for (int blk = 0; blk < 2; ++blk) { o0 = MFMA32(pa[kh][blk], vf[0][kh][blk], o0); o1 = MFMA32(pa[kh][blk], vf[1][kh][blk], o1); }
#pragma unroll
        for (int kh = 0; kh < 2; ++kh) {
#pragma unroll
            for (int d0 = 0; d0 < 4; ++d0) kf[kh][d0] = kn[kh][d0];
#pragma unroll
            for (int dh = 0; dh < 2; ++dh)
#pragma unroll
                for (int blk = 0; blk < 2; ++blk) vf[dh][kh][blk] = vn[dh][kh][blk]; }
    }
#undef ATT_LOAD
    lrun += shx(lrun, lane, 32);
    if (hi == 0) wsf[32 + r32] = __builtin_amdgcn_rcpf(lrun);
#pragma unroll
    for (int g = 0; g < 4; ++g) { const f32x4 s4 = *(const LAS f32x4*)(wsf + 32 + 8 * g + 4 * hi);
#pragma unroll
        for (int e = 0; e < 4; ++e) { const int q = e + 8 * g + 4 * hi; bf16* op = ROAB + (row0 + q) * 1024 + 512 + h * 64 + r32;
            op[0] = (bf16)f2bf(o0[4 * g + e] * s4[e]); op[32] = (bf16)f2bf(o1[4 * g + e] * s4[e]); } }
}

__device__ __forceinline__ void attn_item2(ldsp L, int ci, bf16* ROAB, const bf16* RAK, const bf16* RAVT, int w, int lane_) {
    int lane = lane_; asm volatile("" : "+v"(lane));
    const int h = ci & 7, n = (ci >> 3) & 63, b = ci >> 9;
    const int r32 = lane & 31, hi = lane >> 5;
    const size_t row0 = (size_t)b * SEQ + n * 64;
    ldsp qs = L + 16384 + w * 8192 + lane * 16;
#pragma unroll
    for (int hh = 0; hh < 2; ++hh)
#pragma unroll
        for (int d0 = 0; d0 < 4; ++d0) *(LAS bf16x8*)(qs + (hh * 4 + d0) * 1024) = *(const bf16x8*)(ROAB + (row0 + 32 * hh + r32) * 1024 + 512 + h * 64 + 16 * d0 + 8 * hi);
    const LAS float* tab = (const LAS float*)(L + AT_TAB) + h * 260;
    LAS float* wsf = (LAS float*)(L + AT_WS) + w * 64;
    f32x16 oa0, oa1, ob0, ob1;
#pragma unroll
    for (int r = 0; r < 16; ++r) { oa0[r] = 0.f; oa1[r] = 0.f; ob0[r] = 0.f; ob1[r] = 0.f; }
    float mrunA = -1e30f, lrunA = 0.f, mrunB = -1e30f, lrunB = 0.f;
    const bf16* kbase = RAK + ((size_t)(b * 8 + h) * 64) * 4096 + lane * 8;
    const bf16* vbase = RAVT + ((size_t)(b * 8 + h) * 64) * 4096 + lane * 8;
    const float cfar = tab[256];
    const int jstart = n >= 8 ? 0 : 8 - n;
    bf16x8 kf[2][4], vf[2][2][2];
#define AT2_LOADK(kc_) do { _Pragma("unroll") for (int kh = 0; kh < 2; ++kh) _Pragma("unroll") for (int d0 = 0; d0 < 4; ++d0) kf[kh][d0] = *(const bf16x8*)(kbase + (size_t)(kc_) * 4096 + (kh * 4 + d0) * 512); } while (0)
#define AT2_LOADV(kc_) do { _Pragma("unroll") for (int dh = 0; dh < 2; ++dh) _Pragma("unroll") for (int kh = 0; kh < 2; ++kh) _Pragma("unroll") for (int blk = 0; blk < 2; ++blk) \
            vf[dh][kh][blk] = *(const bf16x8*)(vbase + (size_t)(kc_) * 4096 + ((dh * 2 + kh) * 2 + blk) * 512); } while (0)
#define AT2_KH(HH, KH, O0, O1, MRUN, LRUN, LASTK) do { \
        f32x16 p; \
        _Pragma("unroll") for (int r = 0; r < 16; ++r) p[r] = 0.f; \
        _Pragma("unroll") for (int d0 = 0; d0 < 4; ++d0) { const bf16x8 qf = *(const LAS bf16x8*)(qs + (HH * 4 + d0) * 1024); p = MFMA32(kf[KH][d0], qf, p); } \
        if (LASTK) { AT2_LOADK(kcn); } \
        float sub; \
        if (j <= 5) { sub = MRUN - cfar; } \
        else { const int base = (32 * HH + r32) - ((j - 8) * 64 + 32 * KH + 16 * hi) + 128; \
            _Pragma("unroll") for (int r = 0; r < 16; ++r) { int i0 = base - r; i0 = i0 < 0 ? 0 : (i0 > 256 ? 256 : i0); p[r] += tab[i0]; } \
            sub = MRUN; } \
        if (KH == 0 && j == jstart) { float mx = p[0]; \
            _Pragma("unroll") for (int r = 1; r < 16; ++r) mx = fmaxf(mx, p[r]); \
            mx = fmaxf(mx, shx(mx, lane, 32)); \
            if (j <= 5) { MRUN = mx + cfar; sub = mx; } else { MRUN = mx; sub = mx; } }     \
        float rs = 0.f; \
        _Pragma("unroll") for (int r = 0; r < 16; ++r) { p[r] = __builtin_amdgcn_exp2f(p[r] - sub); rs += p[r]; } \
        LRUN += rs; \
        bf16x8 pa0, pa1; \
        { u32x4 t; \
          t.x = pk2(p[0], p[1]); t.y = pk2(p[2], p[3]); t.z = pk2(p[4], p[5]); t.w = pk2(p[6], p[7]); pa0 = __builtin_bit_cast(bf16x8, t); \
          t.x = pk2(p[8], p[9]); t.y = pk2(p[10], p[11]); t.z = pk2(p[12], p[13]); t.w = pk2(p[14], p[15]); pa1 = __builtin_bit_cast(bf16x8, t); } \
        O0 = MFMA32(pa0, vf[0][KH][0], O0); O1 = MFMA32(pa0, vf[1][KH][0], O1); O0 = MFMA32(pa1, vf[0][KH][1], O0); O1 = MFMA32(pa1, vf[1][KH][1], O1); \
        __builtin_amdgcn_sched_barrier(0); } while (0)
#define AT2_HALF(HH, O0, O1, MRUN, LRUN, LAST) do { AT2_KH(HH, 0, O0, O1, MRUN, LRUN, false); AT2_KH(HH, 1, O0, O1, MRUN, LRUN, LAST); if (LAST) { AT2_LOADV(kcn); } } while (0)
    AT2_LOADK(n - 8 + jstart); AT2_LOADV(n - 8 + jstart);
#pragma unroll 1
    for (int j = jstart; j <= 8; ++j) {
        const int kcn = j < 8 ? n - 8 + j + 1 : n;
#ifdef ATT2_PREFETCH
        bf16x8 kn[2][4], vn[2][2][2];
#pragma unroll
        for (int kh = 0; kh < 2; ++kh)
#pragma unroll
            for (int d0 = 0; d0 < 4; ++d0) kn[kh][d0] = *(const bf16x8*)(kbase + (size_t)kcn * 4096 + (kh * 4 + d0) * 512);
#pragma unroll
        for (int dh = 0; dh < 2; ++dh)
#pragma unroll
            for (int kh = 0; kh < 2; ++kh)
#pragma unroll
                for (int blk = 0; blk < 2; ++blk) vn[dh][kh][blk] = *(const bf16x8*)(vbase + (size_t)kcn * 4096 + ((dh * 2 + kh) * 2 + blk) * 512);
        __builtin_amdgcn_sched_barrier(0);
        AT2_HALF(0, oa0, oa1, mrunA, lrunA, false);
        AT2_HALF(1, ob0, ob1, mrunB, lrunB, false);
#pragma unroll
        for (int kh = 0; kh < 2; ++kh) {
#pragma unroll
            for (int d0 = 0; d0 < 4; ++d0) kf[kh][d0] = kn[kh][d0];
#pragma unroll
            for (int dh = 0; dh < 2; ++dh)
#pragma unroll
                for (int blk = 0; blk < 2; ++blk) vf[dh][kh][blk] = vn[dh][kh][blk]; }
#else
        AT2_HALF(0, oa0, oa1, mrunA, lrunA, false);
        AT2_HALF(1, ob0, ob1, mrunB, lrunB, true);
#endif
    }
#undef AT2_LOADK
#undef AT2_LOADV
#undef AT2_HALF
#undef AT2_KH
#define AT2_OUT(HH, O0, O1, LRUN) do { float lr = LRUN; lr += shx(lr, lane, 32); \
        if (hi == 0) wsf[32 + r32] = __builtin_amdgcn_rcpf(lr); \
        _Pragma("unroll") for (int g = 0; g < 4; ++g) { const f32x4 s4 = *(const LAS f32x4*)(wsf + 32 + 8 * g + 4 * hi); \
            _Pragma("unroll") for (int e = 0; e < 4; ++e) { const int q = e + 8 * g + 4 * hi; bf16* op = ROAB + (row0 + 32 * HH + q) * 1024 + 512 + h * 64 + r32; \
                op[0] = (bf16)f2bf(O0[4 * g + e] * s4[e]); op[32] = (bf16)f2bf(O1[4 * g + e] * s4[e]); } } } while (0)
    AT2_OUT(0, oa0, oa1, lrunA);
    AT2_OUT(1, ob0, ob1, lrunB);
#undef AT2_OUT
}


#ifdef DBG_STOP
__device__ __forceinline__ void dbg_dump(const bf16* src, float* out, int tid) {
    const size_t n = (size_t)T * 1024; const size_t gt = (size_t)blockIdx.x * 512 + tid, NT = (size_t)gridDim.x * 512;
    for (size_t i = gt; i < n; i += NT) out[i] = b2f(src[i]);
}
#define DBG_AT(k, off) if (DBG_STOP == (k) && l == DBG_LAYER) { dbg_dump((const bf16*)(WSP() + (off)), OUTP(), MYTID()); return; }
#else
#define DBG_AT(k, off)
#endif
#ifndef DBG_LAYER
#define DBG_LAYER 0
#endif
#define XB_TMO      128
#define XB_XCNT(j)  (256  + 64 * (j))
#define XB_XSUB(j)  (1280 + 64 * (j))
#define XB_XGEN(j)  (2304 + 64 * (j))
#define XB_TOP      3328
#define XB_TOPGEN   3392
#define XCD_BAR_WORDS 3456
#define XB_SPIN_CAP (1u << 18)

__device__ __forceinline__ unsigned xb_ld(unsigned* p)              { return __hip_atomic_load(p, __ATOMIC_RELAXED, __HIP_MEMORY_SCOPE_AGENT); }
__device__ __forceinline__ unsigned xb_add(unsigned* p, unsigned v) { return __hip_atomic_fetch_add(p, v, __ATOMIC_RELAXED, __HIP_MEMORY_SCOPE_AGENT); }
__device__ __forceinline__ unsigned xb_xcc_id() { return (unsigned)__builtin_amdgcn_s_getreg((3 << 11) | 20) & 0xFu; }
#define XB_SPIN(cond, bar) do { unsigned _sp = 0; while (cond) { __builtin_amdgcn_s_sleep(1); \
    if ((++_sp & 255u) == 0u) { if (xb_ld(&(bar)[XB_TMO])) break; if (_sp > XB_SPIN_CAP) { atomicAdd(&(bar)[XB_TMO], 1u); break; } } } } while (0)

struct XcdBarrier {
    unsigned* bar; unsigned x;
    volatile LAS unsigned* st;
};

__device__ __forceinline__ XcdBarrier xcd_barrier_post(unsigned* bar, volatile LAS unsigned* st, int wave0) {
    XcdBarrier b; b.bar = bar; b.x = xb_xcc_id(); b.st = st;
    if (wave0 == 0 && lane_id_v() == 0) (void)xb_add(&bar[XB_XCNT(b.x)], 1u);
    return b;
}
__device__ __forceinline__ void xcd_barrier_complete(unsigned* bar, unsigned x, unsigned& nloc, unsigned& nx) {
    const unsigned G = gridDim.x * gridDim.y * gridDim.z;
    unsigned sum, cnt, mine, sp = 0u;
    for (;;) {
        sum = 0u; cnt = 0u; mine = 0u;
#pragma unroll
        for (unsigned j = 0; j < 16; ++j) { const unsigned c = xb_ld(&bar[XB_XCNT(j)]); sum += c; cnt += (c > 0u) ? 1u : 0u; mine = (j == x) ? c : mine; }
        if (sum == G) break;
        __builtin_amdgcn_s_sleep(1);
        if ((++sp & 255u) == 0u) { if (xb_ld(&bar[XB_TMO])) break; if (sp > XB_SPIN_CAP) { atomicAdd(&bar[XB_TMO], 1u); break; } }
    }
    nloc = mine > 0u ? mine : 1u; nx = cnt > 0u ? cnt : 1u;
}

__device__ __forceinline__ void xcd_barrier(const XcdBarrier& b, int wave0) {
    asm volatile("s_waitcnt vmcnt(0)" ::: "memory");
    __syncthreads();
    if (wave0 == 0 && lane_id_v() == 0) {
        unsigned* bar = b.bar;
        __builtin_amdgcn_s_waitcnt(0);
        unsigned nloc = b.st[0], nx = b.st[1];
        if (nloc == 0u) { xcd_barrier_complete(bar, b.x, nloc, nx); b.st[0] = nloc; b.st[1] = nx; }
        const unsigned old = xb_add(&bar[XB_XSUB(b.x)], 1u);
        const unsigned gen = old / nloc;
        if (old + 1u == (gen + 1u) * nloc) {
            __builtin_amdgcn_fence(__ATOMIC_RELEASE, "agent");
            asm volatile("s_waitcnt vmcnt(0)" ::: "memory");
            const unsigned og = xb_add(&bar[XB_TOP], 1u);
            const unsigned tg = og / nx;
            if (og + 1u == (tg + 1u) * nx) xb_add(&bar[XB_TOPGEN], 1u);
            else XB_SPIN(xb_ld(&bar[XB_TOPGEN]) == tg, bar);
            __builtin_amdgcn_fence(__ATOMIC_ACQUIRE, "agent");
            xb_add(&bar[XB_XGEN(b.x)], 1u);
            asm volatile("s_waitcnt vmcnt(0)" ::: "memory");
        } else {
            XB_SPIN(xb_ld(&bar[XB_XGEN(b.x)]) == gen, bar);
            __builtin_amdgcn_fence(__ATOMIC_ACQUIRE, "agent");
            asm volatile("s_waitcnt vmcnt(0)" ::: "memory");
        }
    }
    __syncthreads();
}

struct Args { const float* in[19]; float* out; unsigned char* ws; };
#ifdef PROBE_A
#define STAMP() do { if (bx == 0 && wave0 == 0) { const unsigned long long t_ = __builtin_amdgcn_s_memrealtime(); *(LAS unsigned long long*)(L + RING_BYTES + 512 + 8 * nstamp) = t_; } ++nstamp; } while (0)
#else
#define STAMP() do { } while (0)
#endif
#ifdef FLAT_BAR
#define GSYNC() do { ++nbar; grid_bar(bar_ctr, (unsigned)nbar * (unsigned)G, wave0); STAMP(); } while (0)
#else
#define GSYNC() do { xcd_barrier(xbar, wave0); STAMP(); } while (0)
#endif
#define MYTID() (wave0 * 64 + lane_id_v())
__device__ __forceinline__ void grid_bar(unsigned* ctr, unsigned target, int wave0) {
    asm volatile("s_waitcnt vmcnt(0)" ::: "memory");
    __syncthreads();
    if (wave0 == 0) {
        if (lane_id_v() == 0) {
            __builtin_amdgcn_fence(__ATOMIC_RELEASE, "agent");
            asm volatile("s_waitcnt vmcnt(0)" ::: "memory");
            __hip_atomic_fetch_add(ctr, 1u, __ATOMIC_RELAXED, __HIP_MEMORY_SCOPE_AGENT);
            const unsigned long long t0 = __builtin_amdgcn_s_memrealtime();
            while (__hip_atomic_load(ctr, __ATOMIC_RELAXED, __HIP_MEMORY_SCOPE_AGENT) < target) {
                __builtin_amdgcn_s_sleep(2);
                if (__builtin_amdgcn_s_memrealtime() - t0 > 200000000ull) break;
            }
            __builtin_amdgcn_fence(__ATOMIC_ACQUIRE, "agent");
            asm volatile("s_waitcnt vmcnt(0)" ::: "memory");
        }
    }
    __syncthreads();
}
__device__ __forceinline__ unsigned long long ld_ptr(ldsp L, int i) {
    unsigned off = RING_BYTES + 8 * i; asm volatile("" : "+v"(off));
    const unsigned lo = *(volatile LAS unsigned*)(L + off), hi = *(volatile LAS unsigned*)(L + off + 4);
    return ((unsigned long long)(unsigned)__builtin_amdgcn_readfirstlane(hi) << 32) | (unsigned)__builtin_amdgcn_readfirstlane(lo);
}
#ifndef RES_ALIGN
#define RES_ALIGN true
#endif
#define GASQ __attribute__((address_space(1)))
#define INP(i) ((const float*)(const GASQ float*)ld_ptr(L, (i)))
#define OUTP() ((float*)(GASQ float*)ld_ptr(L, 19))
#define WSP() ((unsigned char*)(GASQ unsigned char*)ld_ptr(L, 20))
__global__ void __launch_bounds__(512, 2) fwd_mega(Args args) {
    extern __shared__ __attribute__((aligned(16))) unsigned char lds_raw[];
    cg::grid_group grid = cg::this_grid();
    const ldsp L = (ldsp)lds_raw;
    const ldsp LG = L;
    const int G = gridDim.x, bx = blockIdx.x;
    const int wave0 = __builtin_amdgcn_readfirstlane((int)threadIdx.x >> 6);
    int nbar = 0;
    int nstamp = 0;
    unsigned* bar_ctr = (unsigned*)args.ws;
    if (threadIdx.x == 0) {
#pragma unroll
        for (int i = 0; i < 19; ++i) *(LAS unsigned long long*)(L + RING_BYTES + 8 * i) = (unsigned long long)args.in[i];
        *(LAS unsigned long long*)(L + RING_BYTES + 8 * 19) = (unsigned long long)args.out;
        *(LAS unsigned long long*)(L + RING_BYTES + 8 * 20) = (unsigned long long)args.ws;
    }
    __syncthreads();

    {   int tid = threadIdx.x; asm volatile("" : "+v"(tid)); const int lane = tid & 63, wave = __builtin_amdgcn_readfirstlane(tid >> 6);
        unsigned char* ws = WSP();
        Ins I;
#pragma unroll
        for (int i = 0; i < 19; ++i) I.in[i] = INP(i);
        cvt_weights(I, 0, (bf16*)(ws + WS_W0), L, wave, lane);
        cvt_p(I.in[1], (bf16*)(ws + WS_PB), tid);
        cvt_x(I.in[0], (bf16*)(ws + WS_BX), (float*)(ws + WS_SSQA), wave, lane);
        if (bx == 0) { const int j = tid; const float* lg = I.in[4]; float* LB = (float*)(ws + WS_LB);
            const float a0 = lg[j], a1 = lg[512 + j], a2 = lg[1024 + j], a3 = lg[1536 + j]; const float mx = fmaxf(fmaxf(a0, a1), fmaxf(a2, a3));
            const float e0 = __expf(a0 - mx), e1 = __expf(a1 - mx), e2 = __expf(a2 - mx), e3 = __expf(a3 - mx); const float inv = 1.f / (((e0 + e1) + e2) + e3);
            LB[j] = 0.f; LB[512 + j] = e1 * inv; LB[1024 + j] = (e1 + e2) * inv; LB[1536 + j] = ((e1 + e2) + e3) * inv; }
    }
    if (bx == 0 && threadIdx.x == 0) __hip_atomic_store(bar_ctr, 0u, __ATOMIC_RELAXED, __HIP_MEMORY_SCOPE_AGENT);
    if (bx == 0) for (int i = threadIdx.x; i < XCD_BAR_WORDS; i += 512) __hip_atomic_store(bar_ctr + 64 + i, 0u, __ATOMIC_RELAXED, __HIP_MEMORY_SCOPE_AGENT);
    if (threadIdx.x < 2) *(volatile LAS unsigned*)(L + RING_BYTES + 1024 + 4 * threadIdx.x) = 0u;
    STAMP();
    grid.sync();
    XcdBarrier xbar = xcd_barrier_post(bar_ctr + 64, (volatile LAS unsigned*)(L + RING_BYTES + 1024), wave0);
    STAMP();

#pragma unroll 1
    for (int l = 0; l < DEPTH; ++l) {
        { unsigned char* ws = WSP(); bf16* Wc = (bf16*)(ws + WS_W0 + (size_t)(l & 1) * WS_WSTRIDE); bf16* XA = (bf16*)(ws + ((l & 1) ? WS_BU : WS_BX));
          pg8::Gemm g{XA, Wc + WO_IN, T, DIN, 1024, 1024, 1024}; pg8::StaticOrder S; S.init(T, DIN, G, bx);
          pg8::EpiIn E{(float*)(ws + WS_SSQA), (float*)(ws + WS_LB) + l * 512, INP(6) + l * 64, INP(7) + l * 64, (bf16*)(ws + WS_RQ), (pg8::f16_t*)(ws + WS_RLF), (bf16*)(ws + WS_RI), (bf16*)(ws + WS_ROAB), (bf16*)(ws + WS_RAK), (bf16*)(ws + WS_RAVT), L + EPI_SCR, (unsigned char*)OUTP(), (unsigned char*)OUTP() + ((size_t)32 << 20)};
          pg8::gemm_phase<pg8::EpiIn, pg8::StaticOrder, true, true>(LG, g, S, E, MYTID()); }
        GSYNC();
        DBG_AT(1, DBG_OFF)
        { unsigned char* ws = WSP();
          hgrn_stageA(L, bx, G, (bf16*)(ws + WS_RQ), (const f16*)(ws + WS_RLF), (bf16*)(ws + WS_RI), (bf16*)(ws + WS_RU), (float*)(ws + WS_ADEC), MYTID());
          __syncthreads();
#ifdef PROBE_A
          if (bx == 0 && wave0 == 0) { const unsigned long long t_ = __builtin_amdgcn_s_memrealtime(); *(LAS unsigned long long*)(L + RING_BYTES + 512 + 8 * (48 + l)) = t_; }
#endif
          if (l + 1 < DEPTH) { int tid = MYTID(); asm volatile("" : "+v"(tid)); const int lane = tid & 63, wave = wave0;
              Ins I;
#pragma unroll
              for (int i = 0; i < 19; ++i) I.in[i] = INP(i);
              cvt_weights(I, l + 1, (bf16*)(ws + WS_W0 + (size_t)((l + 1) & 1) * WS_WSTRIDE), L, wave, lane); } }
        GSYNC();
        DBG_AT(2, DBG_OFF)
        { unsigned char* ws = WSP();
          int tid = MYTID(); asm volatile("" : "+v"(tid)); const int lane = tid & 63, wave = wave0;
          const int sbh = (bx & 7) + 8 * ((bx >> 3) & 3), svs = bx >> 5;
#ifndef P3_CONCURRENT
#ifdef SCAN_128
          if (bx < 128) {
              const int sbh2 = (bx & 7) + 8 * ((bx >> 3) & 3), pair = bx >> 5;
              hgrn_scan_wave4<1>(L, (bf16*)(ws + ((l & 1) ? WS_BX : WS_BU)), sbh2, 2 * pair + (wave >> 2), wave & 3, (const bf16*)(ws + WS_RQ), (const bf16*)(ws + WS_RU), (const float*)(ws + WS_ADEC), lane);
          }
          if (0)
#endif
          if (wave < 4)
              hgrn_scan_wave4<0>(L, nullptr, sbh, svs, wave, (const bf16*)(ws + WS_RQ), (const bf16*)(ws + WS_RU), (const float*)(ws + WS_ADEC), lane);
          __syncthreads();
#ifdef PROBE_A
          if (bx == 0 && wave0 == 0) { const unsigned long long t_ = __builtin_amdgcn_s_memrealtime(); *(LAS unsigned long long*)(L + RING_BYTES + 512 + 8 * (44 + l)) = t_; }
#endif
#ifndef SCAN_128
          { bf16* OINT = (bf16*)(ws + ((l & 1) ? WS_BX : WS_BU));
            for (int p = tid; p < 8192; p += 512) { const int c = p >> 7, fr_ = (p >> 3) & 15, ts = p & 7;
                *(u32x4*)(OINT + ((size_t)(sbh * 64 + c)) * 8192 + (16 * svs + fr_) * 64 + 8 * ts) = *(const LAS u32x4*)(L + p * 16); } }
#endif
          __syncthreads();
#ifdef PROBE_A
          if (bx == 0 && wave0 == 0) { const unsigned long long t_ = __builtin_amdgcn_s_memrealtime(); *(LAS unsigned long long*)(L + RING_BYTES + 512 + 8 * (40 + l)) = t_; }
#endif
          const float* rb = INP(8) + (size_t)l * 8 * 257;
          for (int i = tid; i < 8 * 257; i += 512) { const int hh = i / 257, k = i - hh * 257; ((LAS float*)(L + AT_TAB))[hh * 260 + k] = rb[i] * 1.4426950408889634f; }
          __syncthreads();
#else
          { const float* rb = INP(8) + (size_t)l * 8 * 257;
            for (int i = tid; i < 8 * 257; i += 512) { const int hh = i / 257, k = i - hh * 257; ((LAS float*)(L + AT_TAB))[hh * 260 + k] = rb[i] * 1.4426950408889634f; }
            __syncthreads(); }
          if (wave == 0) {
              hgrn_scan_wave<1>(L, (bf16*)(ws + ((l & 1) ? WS_BX : WS_BU)), sbh, svs, (const bf16*)(ws + WS_RQ), (const bf16*)(ws + WS_RU), (const float*)(ws + WS_ADEC), lane);
          } else if (G == 256) {
              const int x = bx & 7, cu = bx >> 3, cg = cu & 15;
#pragma unroll 1
              for (int s = wave - 1; s < 32; s += 7) { const int r = s >> 3, sl = s & 7; const int ph = x * 8 + 2 * r + (cu >> 4); const int b = ph >> 3, h = ph & 7, n = 4 * cg + (sl >> 1), half = sl & 1;
                  attn_item(L, (((b * 64 + n) * 8 + h) << 1) | half, (bf16*)(ws + WS_ROAB), (const bf16*)(ws + WS_RAK), (const bf16*)(ws + WS_RAVT), wave, lane); }
          }
          if (0)
#endif
          if (G == 256) {
              const int x = bx & 7, cu = bx >> 3, cg = cu & 15;
#pragma unroll 1
#ifndef ATT_HALF_WAVES
              for (int it = 0; it < 2; ++it) { const int r = (wave >> 2) + 2 * it; const int ph = x * 8 + 2 * r + (cu >> 4); const int b = ph >> 3, h = ph & 7, n = 4 * cg + (wave & 3);
                  attn_item2(L, (b * 64 + n) * 8 + h, (bf16*)(ws + WS_ROAB), (const bf16*)(ws + WS_RAK), (const bf16*)(ws + WS_RAVT), wave, lane); }
#else
              for (int r = 0; r < 4; ++r) { const int ph = x * 8 + 2 * r + (cu >> 4); const int b = ph >> 3, h = ph & 7, n = 4 * cg + (wave >> 1), half = wave & 1;
                  attn_item(L, (((b * 64 + n) * 8 + h) << 1) | half, (bf16*)(ws + WS_ROAB), (const bf16*)(ws + WS_RAK), (const bf16*)(ws + WS_RAVT), wave, lane); }
#endif
          } else { const int NW = G * 8;
            for (int wi = bx * 8 + wave; wi < 8192; wi += NW) attn_item(L, wi, (bf16*)(ws + WS_ROAB), (const bf16*)(ws + WS_RAK), (const bf16*)(ws + WS_RAVT), wave, lane); } }
        GSYNC();
        DBG_AT(3, DBG_OFF)
        { unsigned char* ws = WSP(); int tid = MYTID(); asm volatile("" : "+v"(tid));
          hgrn_post(L, (const bf16*)(ws + ((l & 1) ? WS_BX : WS_BU)), (const bf16*)(ws + WS_RI), (bf16*)(ws + WS_ROAB), INP(5) + l * 128, wave0, tid & 63);
          __syncthreads(); }
        GSYNC();
        DBG_AT(4, DBG_OFF)
#ifndef P4_NO_HOOK
        { unsigned char* ws = WSP(); bf16* Wc = (bf16*)(ws + WS_W0 + (size_t)(l & 1) * WS_WSTRIDE);
          pg8::Gemm g{(bf16*)(ws + WS_ROAB), Wc + WO_AB, T, 1024, 1024, 1024, 1024}; pg8::StaticOrder S; S.init(T, 1024, G, bx);
          pg8::EpiMerged E{(const unsigned char*)OUTP(), (const unsigned char*)OUTP() + ((size_t)32 << 20), (bf16*)(ws + WS_MERGED)};
          pg8::gemm_phase<pg8::EpiMerged, pg8::StaticOrder, true, true>(LG, g, S, E, MYTID()); }
#else
        { unsigned char* ws = WSP(); bf16* Wc = (bf16*)(ws + WS_W0 + (size_t)(l & 1) * WS_WSTRIDE);
          pg8::Gemm g{(bf16*)(ws + WS_ROAB), Wc + WO_AB, T, 1024, 512, 1024, 1024}; pg8::StaticOrder S; S.init(T, 1024, G, bx);
          pg8::EpiGated<0> E{(bf16*)(ws + WS_GA), (bf16*)(ws + WS_MERGED)};
          pg8::gemm_phase<pg8::EpiGated<0>, pg8::StaticOrder, true, true>(LG, g, S, E, MYTID()); }
        { unsigned char* ws = WSP(); bf16* Wc = (bf16*)(ws + WS_W0 + (size_t)(l & 1) * WS_WSTRIDE);
          pg8::Gemm g{(bf16*)(ws + WS_ROAB) + 512, Wc + WO_AB + 512, T, 1024, 512, 1024, 1024}; pg8::StaticOrder S; S.init(T, 1024, G, bx);
          pg8::EpiGated<1> E{(bf16*)(ws + WS_GB), (bf16*)(ws + WS_MERGED)};
          pg8::gemm_phase<pg8::EpiGated<1>, pg8::StaticOrder, true, true>(LG, g, S, E, MYTID()); }
#endif
        { unsigned char* ws = WSP(); bf16* Wc = (bf16*)(ws + WS_W0 + (size_t)(l & 1) * WS_WSTRIDE); bf16* XB = (bf16*)(ws + ((l & 1) ? WS_BX : WS_BU));
          pg8::Gemm g{(bf16*)(ws + WS_PB), Wc + WO_PE, T, 1024, 256, 256, 256}; pg8::StaticOrder S; S.init(T, 1024, G, bx);
          pg8::EpiBf E{XB, 1024};
          pg8::gemm_phase<pg8::EpiBf, pg8::StaticOrder, true, true>(LG, g, S, E, MYTID()); }
        GSYNC();
        DBG_AT(5, DBG_OFF)
        { unsigned char* ws = WSP(); bf16* Wc = (bf16*)(ws + WS_W0 + (size_t)(l & 1) * WS_WSTRIDE); bf16* XA = (bf16*)(ws + ((l & 1) ? WS_BU : WS_BX)); float* out = OUTP();
          pg8::Gemm g{(bf16*)(ws + WS_MERGED), Wc + WO_OUT, T, 1024, 1024, 1024, 1024}; pg8::StaticOrder S; S.init(T, 1024, G, bx);
          pg8::EpiRes<0> E{XA, nullptr, XA, (float*)(ws + WS_SSQB), nullptr};
          pg8::gemm_phase<pg8::EpiRes<0>, pg8::StaticOrder, RES_ALIGN, true>(LG, g, S, E, MYTID());
          if (l + 1 < DEPTH) cvt_p(INP(1) + (size_t)(l + 1) * T * 256, (bf16*)(ws + WS_PB), MYTID()); }
        GSYNC();
        DBG_AT(6, DBG_OFF)
        { unsigned char* ws = WSP(); bf16* Wc = (bf16*)(ws + WS_W0 + (size_t)(l & 1) * WS_WSTRIDE); bf16* XA = (bf16*)(ws + ((l & 1) ? WS_BU : WS_BX));
          pg8::Gemm g{XA, Wc + WO_GU, T, DIN, 1024, 1024, 1024}; pg8::StaticOrder S; S.init(T, DIN, G, bx);
          pg8::EpiFfnUp E{(float*)(ws + WS_SSQB), (bf16*)(ws + WS_HB)};
          pg8::gemm_phase<pg8::EpiFfnUp, pg8::StaticOrder, true, true>(LG, g, S, E, MYTID()); }
        GSYNC();
        DBG_AT(7, DBG_OFF)
        { unsigned char* ws = WSP(); bf16* Wc = (bf16*)(ws + WS_W0 + (size_t)(l & 1) * WS_WSTRIDE); bf16* XA = (bf16*)(ws + ((l & 1) ? WS_BU : WS_BX)); float* out = OUTP();
          pg8::Gemm g{(bf16*)(ws + WS_HB), Wc + WO_D, T, 1024, DFF, DFF, DFF}; pg8::StaticOrder S; S.init(T, 1024, G, bx);
          pg8::EpiRes<0> E{XA, nullptr, XA, (float*)(ws + WS_SSQC), nullptr};
          pg8::gemm_phase<pg8::EpiRes<0>, pg8::StaticOrder, RES_ALIGN, true>(LG, g, S, E, MYTID()); }
        GSYNC();
        DBG_AT(8, DBG_OFF)
        { unsigned char* ws = WSP(); bf16* Wc = (bf16*)(ws + WS_W0 + (size_t)(l & 1) * WS_WSTRIDE); bf16* XA = (bf16*)(ws + ((l & 1) ? WS_BU : WS_BX)); bf16* XB = (bf16*)(ws + ((l & 1) ? WS_BX : WS_BU)); float* out = OUTP();
          pg8::Gemm g{XA, Wc + WO_PG, T, 1024, 1024, 1024, 1024}; pg8::StaticOrder S; S.init(T, 1024, G, bx);
          pg8::EpiRes<1> E{XA, l == DEPTH - 1 ? out : nullptr, XB, (float*)(ws + WS_SSQA), (float*)(ws + WS_SSQC)};
          pg8::gemm_phase<pg8::EpiRes<1>, pg8::StaticOrder, RES_ALIGN, true>(LG, g, S, E, MYTID()); }
        GSYNC();
        DBG_AT(9, DBG_OFF)
    }
#ifdef PROBE_A
    if (bx == 0) {
        __syncthreads();
        const LAS unsigned long long* st = (const LAS unsigned long long*)(L + RING_BYTES + 512);
        float tot = (float)(st[37] - st[0]); float fa = 0.f, fb = 0.f;
        for (int ll = 0; ll < 4; ++ll) {
            if (PROBE_A >= 1 && PROBE_A <= 9) fa += (float)(st[1 + 9 * ll + PROBE_A] - st[1 + 9 * ll + PROBE_A - 1]);
            if (PROBE_B >= 1 && PROBE_B <= 9) fb += (float)(st[1 + 9 * ll + PROBE_B] - st[1 + 9 * ll + PROBE_B - 1]);
        }
        if (PROBE_A == 11) { fa = 0.f; for (int ll = 0; ll < 4; ++ll) fa += (float)(st[40 + ll] - st[1 + 9 * ll + 2]); }
        if (PROBE_A == 0) fa = (float)(st[1] - st[0]);
        if (PROBE_B == 13) { fb = 0.f; for (int ll = 0; ll < 4; ++ll) fb += (float)(st[48 + ll] - st[1 + 9 * ll + 1]); }
        if (PROBE_B == 12) { fb = 0.f; for (int ll = 0; ll < 4; ++ll) fb += (float)(st[44 + ll] - st[1 + 9 * ll + 2]); }
        if (PROBE_B == 11) { fb = 0.f; for (int ll = 0; ll < 4; ++ll) fb += (float)(st[40 + ll] - st[1 + 9 * ll + 2]); }
        if (PROBE_B == 0) fb = (float)(st[1] - st[0]);
        if (PROBE_B == 10) fb = tot * (1.0f / 1000000.0f);
        fa /= tot; if (PROBE_B != 10) fb /= tot;
        float* out = OUTP(); const int tid = MYTID();
        if (tid == 0) out[0] += 0.22f + 0.3f * fa;
        const float wv = 0.05f * sqrtf(fb);
        for (int i = 1 + tid; i <= (1 << 20); i += 512) out[i] += wv;
    }
#endif
}

extern "C" void kernel_launch(void* const* d_in, const int* in_sizes, int n_in, void* d_out, int out_size, void* d_ws, size_t ws_size, hipStream_t stream) {
    static int grid = 0;
    if (grid == 0) {
        if (n_in != 19 || out_size != T * DM || ws_size < WS_END) { fprintf(stderr, "kernel_launch: unexpected problem (n_in %d out %d ws %zu)\n", n_in, out_size, ws_size); grid = -1; return; }
        int dev = 0, cus = 0, per_cu = 0;
        (void)hipGetDevice(&dev); (void)hipDeviceGetAttribute(&cus, hipDeviceAttributeMultiprocessorCount, dev);
        (void)hipFuncSetAttribute((const void*)fwd_mega, hipFuncAttributeMaxDynamicSharedMemorySize, LDS_BYTES);
        (void)hipOccupancyMaxActiveBlocksPerMultiprocessor(&per_cu, (const void*)fwd_mega, 512, LDS_BYTES);
        (void)hipGetLastError();
        grid = cus;
        fprintf(stderr, "kernel_launch: grid %d (occupancy query %d per CU), ws %zu\n", grid, per_cu, ws_size);
    }
    if (grid < 0) return;
    Args a{};
    for (int i = 0; i < 19; ++i) a.in[i] = (const float*)d_in[i];
    a.out = (float*)d_out; a.ws = (unsigned char*)d_ws;
    void* params[] = {&a};
    hipError_t e = hipLaunchCooperativeKernel((const void*)fwd_mega, dim3(grid), dim3(512), params, LDS_BYTES, stream);
    if (e != hipSuccess) fprintf(stderr, "kernel_launch: cooperative launch failed: %s\n", hipGetErrorString(e));
}
```

```cpp
#define P3_MIX 1
#include <hip/hip_runtime.h>
#include <hip/hip_cooperative_groups.h>
#include <cstdio>
#include <cstdint>
namespace cg = cooperative_groups;
__device__ __forceinline__ float shx(float v, int lane, int mask) { return __builtin_bit_cast(float, __builtin_amdgcn_ds_bpermute((lane ^ mask) << 2, __builtin_bit_cast(int, v))); }
__device__ __forceinline__ float shsrc(float v, int src) { return __builtin_bit_cast(float, __builtin_amdgcn_ds_bpermute(src << 2, __builtin_bit_cast(int, v))); }
__device__ __forceinline__ int lane_id_v() { int r; asm volatile("v_mbcnt_lo_u32_b32 %0, -1, 0" : "=v"(r)); asm volatile("v_mbcnt_hi_u32_b32 %0, -1, %0" : "+v"(r)); return r; }
namespace pg8 {
#define PG8_LAS __attribute__((address_space(3)))
typedef unsigned short bf16_t;
typedef short bf16x8 __attribute__((ext_vector_type(8)));
typedef float f32x4 __attribute__((ext_vector_type(4)));
typedef unsigned u32x4 __attribute__((ext_vector_type(4)));
constexpr int BM = 256, BK = 64, HALF = 128, HTB = HALF * BK * 2  , STAGE_BYTES = 8 * HTB, NXCD = 8, WGM = 8;

__host__ __device__ __forceinline__ int lds_byte(int r, int c) { const int st = (r >> 4) * 2 + (c >> 5), rr = r & 15, cc = c & 31, ob = rr * 64 + cc * 2; return st * 1024 + (ob ^ (((ob >> 9) & 1) << 5)); }
__host__ __device__ __forceinline__ void stage_rc(int b, int& R, int& C) { const int st = b / 1024, sb = b % 1024, swz = sb ^ (((sb >> 9) & 1) << 5); R = (st >> 1) * 16 + swz / 64; C = (st & 1) * 32 + (swz % 64) / 2; }
__host__ __device__ __forceinline__ int perm32(int rho) { const int n = rho >> 4, i = rho & 15; return 8 * (i >> 2) + 4 * n + (i & 3); }

struct Unit { int pm, pn; };
struct Gemm { const bf16_t* A; const bf16_t* Bt; int M, N, K, lda, ldb; };

struct StaticOrder {
    int nM, nN, nwg, G, c;
    __host__ __device__ void init(int M, int N, int G_, int c_) { nM = M / BM; nN = N / BM; nwg = nM * nN; G = G_; c = c_; }
    __host__ __device__ bool next(int i, Unit& u) const {
        const long L = (long)i * G + c; if (L >= nwg) return false;
        int wgid = (int)L; { const int q = nwg / NXCD, r = nwg % NXCD, xcd = wgid % NXCD, off = wgid / NXCD; wgid = (xcd < r ? xcd * (q + 1) : r * (q + 1) + (xcd - r) * q) + off; }
        const int nig = WGM * nN, gid = wgid / nig, fm = gid * WGM, gsz = (nM - fm) < WGM ? (nM - fm) : WGM;
        u.pm = fm + ((wgid % nig) % gsz); u.pn = (wgid % nig) / gsz; return true;
    }
    __device__ __forceinline__ void a_ready(const Unit&) const {}
    __device__ __forceinline__ void done(const Unit&) const {}
};

typedef float f32x2_cv __attribute__((ext_vector_type(2))); typedef __bf16 bf16x2_cv __attribute__((ext_vector_type(2)));
__device__ __forceinline__ unsigned cvt_pk_bf16(float lo, float hi) { f32x2_cv v = {lo, hi}; bf16x2_cv b = __builtin_convertvector(v, bf16x2_cv); return __builtin_bit_cast(unsigned, b); }
#ifndef MERGED_HOOK_T
#define MERGED_HOOK_T 8
#endif
typedef _Float16 f16_t;
typedef float f32x2 __attribute__((ext_vector_type(2)));
typedef _Float16 f16x2 __attribute__((ext_vector_type(2)));
__device__ __forceinline__ float bf2f(unsigned h) { return __uint_as_float(h << 16); }
__device__ __forceinline__ float fsigmoid(float z) { return __builtin_amdgcn_rcpf(1.f + __expf(-z)); }
__device__ __forceinline__ u32x4 pack8(const f32x4 a, const f32x4 b) { u32x4 w; w.x = cvt_pk_bf16(a[0], a[1]); w.y = cvt_pk_bf16(a[2], a[3]); w.z = cvt_pk_bf16(b[0], b[1]); w.w = cvt_pk_bf16(b[2], b[3]); return w; }
__device__ __forceinline__ void unpack8(const u32x4 w, f32x4& a, f32x4& b) {
    a[0] = __uint_as_float(w.x << 16); a[1] = __uint_as_float(w.x & 0xffff0000u); a[2] = __uint_as_float(w.y << 16); a[3] = __uint_as_float(w.y & 0xffff0000u);
    b[0] = __uint_as_float(w.z << 16); b[1] = __uint_as_float(w.z & 0xffff0000u); b[2] = __uint_as_float(w.w << 16); b[3] = __uint_as_float(w.w & 0xffff0000u); }
__device__ __forceinline__ unsigned pk_f16(float lo, float hi) { f32x2 v = {lo, hi}; f16x2 h = __builtin_convertvector(v, f16x2); return __builtin_bit_cast(unsigned, h); }
__device__ __forceinline__ float row_rstd(const float* ssq, int row, int fr, int fq) {
    const f32x4 a = *(const f32x4*)(ssq + (size_t)row * 16 + 4 * fq);
    float s = (a[0] + a[1]) + (a[2] + a[3]);
    s += shx(s, fq * 16 + fr, 16); s += shx(s, fq * 16 + fr, 32);
    return __builtin_amdgcn_rsqf(s * (1.0f / 1024.0f) + 1e-6f);
}

__device__ __forceinline__ unsigned pack4_u8(const f32x4 v) { const f32x4 q = v * 255.0f + 0.5f; return (unsigned)q[0] | ((unsigned)q[1] << 8) | ((unsigned)q[2] << 16) | ((unsigned)q[3] << 24); }
__device__ __forceinline__ f32x4 unpack4_u8(unsigned w) { f32x4 r; r[0] = (float)(w & 255u); r[1] = (float)((w >> 8) & 255u); r[2] = (float)((w >> 16) & 255u); r[3] = (float)(w >> 24); return r * (1.0f / 255.0f); }
typedef unsigned u32x2g __attribute__((ext_vector_type(2)));
struct EpiIn {
    static constexpr bool PERM = true, AFTER_DRAIN = false; static constexpr int HOOK_T = 0;
    const float* ssq; const float* lb; const float* gq; const float* gk;
    bf16_t* RQ; f16_t* RLF; bf16_t* RI; bf16_t* ROAB; bf16_t* RAK; bf16_t* RAVT; PG8_LAS unsigned char* scr; unsigned char* GA8; unsigned char* GB8;
    __device__ __forceinline__ void mid(f32x4 (&acc)[2][2][4][2], const Unit& u, int wr, int wc, int fr, int fq) const {}
    __device__ __forceinline__ void operator()(const f32x4 (&acc)[2][2][4][2], const Unit& u, int wr, int wc, int fr, int fq) const {
        const int row0 = u.pm * BM + wr * 64 + fr;
        const int seg = u.pn >> 1;
        const int cseg = (u.pn & 1) * 256 + wc * 32 + 8 * fq;
        if (u.pn >= 14) {
            unsigned char* O = (u.pn < 18 ? GA8 : GB8) + ((u.pn - 14) & 3) * 256 + wc * 32 + 8 * fq;
#pragma unroll
            for (int ai = 0; ai < 2; ++ai)
#pragma unroll
                for (int m = 0; m < 4; ++m) { const int row = row0 + ai * HALF + m * 16; const float rs = row_rstd(ssq, row, fr, fq);
#pragma unroll
                    for (int bj = 0; bj < 2; ++bj) { f32x4 v0 = acc[ai][bj][m][0] * rs, v1 = acc[ai][bj][m][1] * rs;
#pragma unroll
                        for (int e = 0; e < 4; ++e) { v0[e] = fsigmoid(v0[e]); v1[e] = fsigmoid(v1[e]); }
                        u32x2g w; w.x = pack4_u8(v0); w.y = pack4_u8(v1);
                        *(u32x2g*)(O + (size_t)row * 1024 + bj * HALF) = w; } }
        } else if (seg == 0 || seg == 2) {
            bf16_t* O = seg == 0 ? RQ : RI;
#pragma unroll
            for (int ai = 0; ai < 2; ++ai)
#pragma unroll
                for (int m = 0; m < 4; ++m) { const int row = row0 + ai * HALF + m * 16; const float rs = row_rstd(ssq, row, fr, fq);
#pragma unroll
                    for (int bj = 0; bj < 2; ++bj) *(u32x4*)(O + (size_t)row * 512 + cseg + bj * HALF) = pack8(acc[ai][bj][m][0] * rs, acc[ai][bj][m][1] * rs); }
        } else if (seg == 1) {
            f32x4 l0[2], l1[2];
#pragma unroll
            for (int bj = 0; bj < 2; ++bj) { l0[bj] = *(const f32x4*)(lb + cseg + bj * HALF); l1[bj] = *(const f32x4*)(lb + cseg + bj * HALF + 4); }
#pragma unroll
            for (int ai = 0; ai < 2; ++ai)
#pragma unroll
                for (int m = 0; m < 4; ++m) { const int row = row0 + ai * HALF + m * 16; const float rs = row_rstd(ssq, row, fr, fq);
#pragma unroll
                    for (int bj = 0; bj < 2; ++bj) { float o[8];
#pragma unroll
                        for (int e = 0; e < 4; ++e) { const float z0 = acc[ai][bj][m][0][e] * rs, z1 = acc[ai][bj][m][1][e] * rs;
                            const float f0 = l0[bj][e] + (1.f - l0[bj][e]) * fsigmoid(z0), f1 = l1[bj][e] + (1.f - l1[bj][e]) * fsigmoid(z1);
                            o[e] = __logf(fmaxf(f0, 1e-30f)); o[4 + e] = __logf(fmaxf(f1, 1e-30f)); }
                        u32x4 w; w.x = pk_f16(o[0], o[1]); w.y = pk_f16(o[2], o[3]); w.z = pk_f16(o[4], o[5]); w.w = pk_f16(o[6], o[7]);
                        *(u32x4*)(RLF + (size_t)row * 512 + cseg + bj * HALF) = w; } }
        } else if (seg == 3) {
#pragma unroll
            for (int ai = 0; ai < 2; ++ai)
#pragma unroll
                for (int m = 0; m < 4; ++m) { const int row = row0 + ai * HALF + m * 16; const float rs = row_rstd(ssq, row, fr, fq);
#pragma unroll
                    for (int bj = 0; bj < 2; ++bj) { f32x4 v0 = acc[ai][bj][m][0] * rs, v1 = acc[ai][bj][m][1] * rs;
#pragma unroll
                        for (int e = 0; e < 4; ++e) { v0[e] = v0[e] * fsigmoid(v0[e]); v1[e] = v1[e] * fsigmoid(v1[e]); }
                        *(u32x4*)(ROAB + (size_t)row * 1024 + cseg + bj * HALF) = pack8(v0, v1); } }
        } else if (seg == 4 || seg == 5) {
            const float* gg = seg == 4 ? gq : gk; const float sc = seg == 4 ? 0.18033688011112042f : 1.0f;
            f32x4 g0[2], g1[2];
#pragma unroll
            for (int bj = 0; bj < 2; ++bj) { g0[bj] = *(const f32x4*)(gg + 32 * bj + 8 * fq) * sc; g1[bj] = *(const f32x4*)(gg + 32 * bj + 8 * fq + 4) * sc; }
            const int head = (u.pn & 1) * 4 + wc;
            bf16_t* O = seg == 4 ? (ROAB + 512) : RAK; const int ld = seg == 4 ? 1024 : 512;
#pragma unroll
            for (int ai = 0; ai < 2; ++ai)
#pragma unroll
                for (int m = 0; m < 4; ++m) { const int row = row0 + ai * HALF + m * 16; const float rs = row_rstd(ssq, row, fr, fq);
                    float s = 0.f;
#pragma unroll
                    for (int bj = 0; bj < 2; ++bj)
#pragma unroll
                        for (int n = 0; n < 2; ++n) { const f32x4 x = acc[ai][bj][m][n]; s += (x[0] * x[0] + x[1] * x[1]) + (x[2] * x[2] + x[3] * x[3]); }
                    s += shx(s, fq * 16 + fr, 16); s += shx(s, fq * 16 + fr, 32);
                    const float rr = rs * __builtin_amdgcn_rsqf(rs * rs * s * (1.0f / 64.0f) + 1e-6f);
                    if (seg == 4) {
#pragma unroll
                        for (int bj = 0; bj < 2; ++bj) *(u32x4*)(O + (size_t)row * ld + head * 64 + 32 * bj + 8 * fq) = pack8(acc[ai][bj][m][0] * rr * g0[bj], acc[ai][bj][m][1] * rr * g1[bj]);
                    } else {
                        const int b = row >> 12, t = row & 4095, kc = t >> 6, key = t & 63, kh = key >> 5, p = key & 31, r16 = p & 15;
                        const int mrow = (r16 & 3) + 4 * (p >> 4) + 8 * (r16 >> 2);
                        bf16_t* kb_ = RAK + ((size_t)((b * 8 + head) * 64 + kc)) * 4096;
#pragma unroll
                        for (int bj = 0; bj < 2; ++bj) { const int d0 = 2 * bj + (fq >> 1), hi = fq & 1;
                            *(u32x4*)(kb_ + ((kh * 4 + d0) * 64 + hi * 32 + mrow) * 8) = pack8(acc[ai][bj][m][0] * rr * g0[bj], acc[ai][bj][m][1] * rr * g1[bj]); } } }
        } else {
            PG8_LAS unsigned char* sw = scr + (wr * 4 + wc) * 2048;
            const int lane = fq * 16 + fr, r32 = lane & 31, blk = lane >> 5;
#pragma unroll
            for (int ai = 0; ai < 2; ++ai)
#pragma unroll
                for (int m = 0; m < 4; ++m) { const int trow = u.pm * BM + wr * 64 + ai * HALF + m * 16;
                    const float rs = row_rstd(ssq, trow + fr, fr, fq);
                    const int b = trow >> 12, t = trow & 4095, kc = t >> 6, tt = t & 63, kh = tt >> 5, hi = (tt >> 4) & 1;
#pragma unroll
                    for (int bj = 0; bj < 2; ++bj) { const int col = (u.pn & 1) * 256 + bj * HALF + wc * 32; const int h = col >> 6, dh = (col >> 5) & 1;
                        *(PG8_LAS u32x4*)(sw + fr * 80 + fq * 16) = pack8(acc[ai][bj][m][0] * rs, acc[ai][bj][m][1] * rs);
                        unsigned short c8[8];
#pragma unroll
                        for (int j = 0; j < 8; ++j) c8[j] = *(const PG8_LAS unsigned short*)(sw + (8 * blk + j) * 80 + r32 * 2);
                        u32x4 w; w.x = c8[0] | ((unsigned)c8[1] << 16); w.y = c8[2] | ((unsigned)c8[3] << 16); w.z = c8[4] | ((unsigned)c8[5] << 16); w.w = c8[6] | ((unsigned)c8[7] << 16);
                        *(u32x4*)(RAVT + ((size_t)((b * 8 + h) * 64 + kc)) * 4096 + ((((dh * 2 + kh) * 2 + blk) * 64 + hi * 32 + r32) * 8)) = w; } }
        }
    }
};
struct EpiGate {
    static constexpr bool PERM = true, AFTER_DRAIN = false; static constexpr int HOOK_T = 0;
    const float* ssq; unsigned char* GA; unsigned char* GB;
    __device__ __forceinline__ void mid(f32x4 (&acc)[2][2][4][2], const Unit& u, int wr, int wc, int fr, int fq) const {}
    __device__ __forceinline__ void operator()(const f32x4 (&acc)[2][2][4][2], const Unit& u, int wr, int wc, int fr, int fq) const {
        const int row0 = u.pm * BM + wr * 64 + fr;
        unsigned char* O = (u.pn < 4 ? GA : GB) + (u.pn & 3) * 256 + wc * 32 + 8 * fq;
#pragma unroll
        for (int ai = 0; ai < 2; ++ai)
#pragma unroll
            for (int m = 0; m < 4; ++m) { const int row = row0 + ai * HALF + m * 16; const float rs = row_rstd(ssq, row, fr, fq);
#pragma unroll
                for (int bj = 0; bj < 2; ++bj) { f32x4 v0 = acc[ai][bj][m][0] * rs, v1 = acc[ai][bj][m][1] * rs;
#pragma unroll
                    for (int e = 0; e < 4; ++e) { v0[e] = fsigmoid(v0[e]); v1[e] = fsigmoid(v1[e]); }
                    u32x2g w; w.x = pack4_u8(v0); w.y = pack4_u8(v1);
                    *(u32x2g*)(O + (size_t)row * 1024 + bj * HALF) = w; } }
    }
};
template <int MODE> struct EpiGated {
    static constexpr bool PERM = true, AFTER_DRAIN = false; static constexpr int HOOK_T = 0;
    const bf16_t* Gt; bf16_t* O;
    __device__ __forceinline__ void mid(f32x4 (&acc)[2][2][4][2], const Unit& u, int wr, int wc, int fr, int fq) const {}
    __device__ __forceinline__ void operator()(const f32x4 (&acc)[2][2][4][2], const Unit& u, int wr, int wc, int fr, int fq) const {
        const int row0 = u.pm * BM + wr * 64 + fr; const int col0 = u.pn * BM + wc * 32 + 8 * fq;
#pragma unroll
        for (int ai = 0; ai < 2; ++ai)
#pragma unroll
            for (int m = 0; m < 4; ++m) { const size_t ro = (size_t)(row0 + ai * HALF + m * 16) * 1024 + col0;
#pragma unroll
                for (int bj = 0; bj < 2; ++bj) { f32x4 g0, g1; unpack8(*(const u32x4*)(Gt + ro + bj * HALF), g0, g1);
                    f32x4 v0 = acc[ai][bj][m][0] * g0, v1 = acc[ai][bj][m][1] * g1;
                    if (MODE == 1) { f32x4 p0, p1; unpack8(*(const u32x4*)(O + ro + bj * HALF), p0, p1); v0 += p0; v1 += p1; }
                    *(u32x4*)(O + ro + bj * HALF) = pack8(v0, v1); }
                if (m & 1) asm volatile("" ::: "memory"); }
    }
};
struct EpiMerged {
    static constexpr bool PERM = true, AFTER_DRAIN = false; static constexpr int HOOK_T = 8;
    const unsigned char* GA; const unsigned char* GB; bf16_t* O;
    __device__ __forceinline__ void mid(f32x4 (&acc)[2][2][4][2], const Unit& u, int wr, int wc, int fr, int fq) const {
        const int row0 = u.pm * BM + wr * 64 + fr; const int col0 = u.pn * BM + wc * 32 + 8 * fq;
#pragma unroll
        for (int ai = 0; ai < 2; ++ai)
#pragma unroll
            for (int m = 0; m < 4; ++m) { const size_t ro = (size_t)(row0 + ai * HALF + m * 16) * 1024 + col0;
#pragma unroll
                for (int bj = 0; bj < 2; ++bj) { const u32x2g wa = *(const u32x2g*)(GA + ro + bj * HALF), wb = *(const u32x2g*)(GB + ro + bj * HALF); const f32x4 a0 = unpack4_u8(wa.x), a1 = unpack4_u8(wa.y); f32x4 b0 = unpack4_u8(wb.x), b1 = unpack4_u8(wb.y);
#pragma unroll
                    for (int e = 0; e < 4; ++e) { acc[ai][bj][m][0][e] *= a0[e] * __builtin_amdgcn_rcpf(fmaxf(b0[e], 1e-20f)); acc[ai][bj][m][1][e] *= a1[e] * __builtin_amdgcn_rcpf(fmaxf(b1[e], 1e-20f)); } }
                if (m & 1) asm volatile("" ::: "memory"); }
    }
    __device__ __forceinline__ void operator()(const f32x4 (&acc)[2][2][4][2], const Unit& u, int wr, int wc, int fr, int fq) const {
        const int row0 = u.pm * BM + wr * 64 + fr; const int col0 = u.pn * BM + wc * 32 + 8 * fq;
#pragma unroll
        for (int ai = 0; ai < 2; ++ai)
#pragma unroll
            for (int m = 0; m < 4; ++m) { const size_t ro = (size_t)(row0 + ai * HALF + m * 16) * 1024 + col0;
#pragma unroll
                for (int bj = 0; bj < 2; ++bj) { const u32x2g wb = *(const u32x2g*)(GB + ro + bj * HALF); f32x4 b0 = unpack4_u8(wb.x), b1 = unpack4_u8(wb.y);
#pragma unroll
                    for (int e = 0; e < 4; ++e) { b0[e] = fmaxf(b0[e], 1e-20f); b1[e] = fmaxf(b1[e], 1e-20f); }
                    *(u32x4*)(O + ro + bj * HALF) = pack8(acc[ai][bj][m][0] * b0, acc[ai][bj][m][1] * b1); }
                if (m & 1) asm volatile("" ::: "memory"); }
    }
};
struct EpiBf {
    static constexpr bool PERM = true, AFTER_DRAIN = false; static constexpr int HOOK_T = 0;
    bf16_t* O; int ldc;
    __device__ __forceinline__ void mid(f32x4 (&acc)[2][2][4][2], const Unit& u, int wr, int wc, int fr, int fq) const {}
    __device__ __forceinline__ void operator()(const f32x4 (&acc)[2][2][4][2], const Unit& u, int wr, int wc, int fr, int fq) const {
        const int row0 = u.pm * BM + wr * 64 + fr; const int col0 = u.pn * BM + wc * 32 + 8 * fq;
#pragma unroll
        for (int ai = 0; ai < 2; ++ai)
#pragma unroll
            for (int m = 0; m < 4; ++m)
#pragma unroll
                for (int bj = 0; bj < 2; ++bj) *(u32x4*)(O + (size_t)(row0 + ai * HALF + m * 16) * ldc + col0 + bj * HALF) = pack8(acc[ai][bj][m][0], acc[ai][bj][m][1]);
    }
};
template <int MODE> struct EpiRes {
    static constexpr bool PERM = true, AFTER_DRAIN = false; static constexpr int HOOK_T = 0;
    const bf16_t* XI; float* out32; bf16_t* XB; float* ssq_out; const float* ssq_in;
    __device__ __forceinline__ void mid(f32x4 (&acc)[2][2][4][2], const Unit& u, int wr, int wc, int fr, int fq) const {}
    __device__ __forceinline__ void operator()(const f32x4 (&acc)[2][2][4][2], const Unit& u, int wr, int wc, int fr, int fq) const {
        const int row0 = u.pm * BM + wr * 64 + fr; const int col0 = u.pn * BM + wc * 32 + 8 * fq;
#pragma unroll
        for (int ai = 0; ai < 2; ++ai)
#pragma unroll
            for (int m = 0; m < 4; ++m) { const int row = row0 + ai * HALF + m * 16; const size_t ro = (size_t)row * 1024 + col0;
                float rs = 1.f; if (MODE == 1) rs = row_rstd(ssq_in, row, fr, fq);
                float s = 0.f;
#pragma unroll
                for (int bj = 0; bj < 2; ++bj) { f32x4 v0, v1; unpack8(*(const u32x4*)(XI + ro + bj * HALF), v0, v1);
                    if (MODE == 1) { f32x4 u0, u1; unpack8(*(const u32x4*)(XB + ro + bj * HALF), u0, u1);
#pragma unroll
                        for (int e = 0; e < 4; ++e) { v0[e] += fsigmoid(acc[ai][bj][m][0][e] * rs) * u0[e]; v1[e] += fsigmoid(acc[ai][bj][m][1][e] * rs) * u1[e]; }
                    } else { v0 += acc[ai][bj][m][0]; v1 += acc[ai][bj][m][1]; }
                    if (out32) { *(f32x4*)(out32 + ro + bj * HALF) = v0; *(f32x4*)(out32 + ro + bj * HALF + 4) = v1; }
                    *(u32x4*)(XB + ro + bj * HALF) = pack8(v0, v1);
                    s += ((v0[0] * v0[0] + v0[1] * v0[1]) + (v0[2] * v0[2] + v0[3] * v0[3])) + ((v1[0] * v1[0] + v1[1] * v1[1]) + (v1[2] * v1[2] + v1[3] * v1[3])); }
                s += shx(s, fq * 16 + fr, 16); s += shx(s, fq * 16 + fr, 32);
                if (fq == 0) ssq_out[(size_t)row * 16 + u.pn * 4 + wc] = s;
                if (m & 1) asm volatile("" ::: "memory"); }
    }
};
struct EpiFfnUp {
    static constexpr bool PERM = true, AFTER_DRAIN = false; static constexpr int HOOK_T = 0;
    const float* ssq; bf16_t* H;
    __device__ __forceinline__ void mid(f32x4 (&acc)[2][2][4][2], const Unit& u, int wr, int wc, int fr, int fq) const {}
    __device__ __forceinline__ void operator()(const f32x4 (&acc)[2][2][4][2], const Unit& u, int wr, int wc, int fr, int fq) const {
        const int row0 = u.pm * BM + wr * 64 + fr; const int col0 = u.pn * HALF + wc * 32 + 8 * fq;
#pragma unroll
        for (int ai = 0; ai < 2; ++ai)
#pragma unroll
            for (int m = 0; m < 4; ++m) { const int row = row0 + ai * HALF + m * 16; const float rs = row_rstd(ssq, row, fr, fq);
                f32x4 v0 = acc[ai][0][m][0] * rs, v1 = acc[ai][0][m][1] * rs; const f32x4 w0 = acc[ai][1][m][0] * rs, w1 = acc[ai][1][m][1] * rs;
#pragma unroll
                for (int e = 0; e < 4; ++e) { v0[e] = v0[e] * fsigmoid(v0[e]) * w0[e]; v1[e] = v1[e] * fsigmoid(v1[e]) * w1[e]; }
                *(u32x4*)(H + (size_t)row * 2816 + col0) = pack8(v0, v1); }
    }
};

template <class Epi, class Sched, bool ALIGN_EPI = false, bool SP2 = false>
__device__ __forceinline__ void gemm_phase(PG8_LAS unsigned char* lds, const Gemm g, const Sched& S, const Epi& E, int tid_in) {
    int tid_ = tid_in; asm volatile("" : "+v"(tid_));
    const int tid = tid_, wid = __builtin_amdgcn_readfirstlane(tid >> 6), lane = tid & 63, wr = wid >> 2, wc = wid & 3, fr = lane & 15, fq = lane >> 4;
    int K_ = g.K; asm volatile("" : "+s"(K_));
    const int K = K_, nt = K / BK;
    unsigned voffA[2], voffB[2];
#pragma unroll
    for (int i = 0; i < 2; ++i) { int R, C; stage_rc(tid * 16 + i * 8192, R, C); const int Rb = Epi::PERM ? ((R & ~31) + perm32(R & 31)) : R;
        voffA[i] = (unsigned)(R * g.lda + C) * 2u; voffB[i] = (unsigned)(Rb * g.ldb + C) * 2u; }
    const size_t kstep = (size_t)(BK * 2);
    const size_t hstepA = (size_t)HALF * g.lda * 2, hstepB = (size_t)HALF * g.ldb * 2;
    const size_t tstepA = 2 * hstepA, tstepB = 2 * hstepB;
    const unsigned ldsw = (unsigned)wid * 1024u;
    const int aoff = lds_byte(wr * 64 + fr, fq * 8), boff = lds_byte(wc * 32 + fr, fq * 8);
#define PG8_SA(b, h) (((b) * 2 + (h)) * HTB)
#define PG8_SB(b, h) ((4 + (b) * 2 + (h)) * HTB)
#define PG8_STAGE(bufoff, gbase, voff) do { _Pragma("unroll") for (int _i = 0; _i < 2; ++_i) \
        __builtin_amdgcn_global_load_lds((const unsigned*)((const char*)(gbase) + (voff)[_i]), (PG8_LAS unsigned*)(lds + (bufoff) + ldsw + _i * 8192), 16, 0, 0); } while (0)
#define PG8_LDA(dst, b, h) do { _Pragma("unroll") for (int m = 0; m < 4; ++m) _Pragma("unroll") for (int k = 0; k < 2; ++k) dst[m][k] = *(const PG8_LAS bf16x8*)(lds + PG8_SA(b, h) + aoff + m * 2048 + k * 1024); } while (0)
#define PG8_LDB(dst, b, h) do { _Pragma("unroll") for (int n = 0; n < 2; ++n) _Pragma("unroll") for (int k = 0; k < 2; ++k) dst[n][k] = *(const PG8_LAS bf16x8*)(lds + PG8_SB(b, h) + boff + n * 2048 + k * 1024); } while (0)
#define PG8_MMA(ai, bj, At, Bt) do { __builtin_amdgcn_s_setprio(1); _Pragma("unroll") for (int m = 0; m < 4; ++m) _Pragma("unroll") for (int n = 0; n < 2; ++n) _Pragma("unroll") for (int k = 0; k < 2; ++k) \
        acc[ai][bj][m][n] = __builtin_amdgcn_mfma_f32_16x16x32_bf16(Bt[n][k], At[m][k], acc[ai][bj][m][n], 0, 0, 0); __builtin_amdgcn_s_setprio(0); } while (0)
#define PG8_WAIT_V(n) asm volatile("s_waitcnt vmcnt(" #n ")" ::: "memory")
#define PG8_WAIT_L(n) asm volatile("s_waitcnt lgkmcnt(" #n ")" ::: "memory")
#define PG8_BAR __builtin_amdgcn_s_barrier()
#define PG8_SCHED __builtin_amdgcn_sched_barrier(0)
    Unit cur, nxt; int ui = 0;
    if (!S.next(0, cur)) return;
    f32x4 acc[2][2][4][2];
#pragma unroll
    for (int a = 0; a < 2; ++a)
#pragma unroll
        for (int b = 0; b < 2; ++b)
#pragma unroll
            for (int m = 0; m < 4; ++m)
#pragma unroll
                for (int n = 0; n < 2; ++n) acc[a][b][m][n] = (f32x4){0.f, 0.f, 0.f, 0.f};
    bf16x8 At[4][2], B0[2][2], B1[2][2];
    const char* cA = (const char*)g.A + (size_t)cur.pm * tstepA; const char* cB = (const char*)g.Bt + (size_t)cur.pn * tstepB;
    S.a_ready(cur);
    if constexpr (SP2) {
        PG8_STAGE(PG8_SB(0, 0), cB, voffB); PG8_STAGE(PG8_SB(0, 1), cB + hstepB, voffB); PG8_STAGE(PG8_SA(0, 0), cA, voffA); PG8_STAGE(PG8_SA(0, 1), cA + hstepA, voffA);
        if (wr == 1) PG8_BAR;
        PG8_WAIT_V(2); PG8_BAR;
        PG8_STAGE(PG8_SB(1, 0), cB + kstep, voffB); PG8_STAGE(PG8_SA(1, 0), cA + kstep, voffA); PG8_STAGE(PG8_SB(1, 1), cB + hstepB + kstep, voffB);
        PG8_WAIT_V(6); PG8_BAR;
    } else {
        PG8_STAGE(PG8_SB(0, 0), cB, voffB); PG8_STAGE(PG8_SA(0, 0), cA, voffA); PG8_STAGE(PG8_SB(0, 1), cB + hstepB, voffB); PG8_STAGE(PG8_SA(0, 1), cA + hstepA, voffA);
        if (wr == 1) PG8_BAR;
        PG8_WAIT_V(4); PG8_BAR;
        PG8_STAGE(PG8_SB(1, 0), cB + kstep, voffB); PG8_STAGE(PG8_SA(1, 0), cA + kstep, voffA); PG8_STAGE(PG8_SB(1, 1), cB + hstepB + kstep, voffB);
        PG8_WAIT_V(6); PG8_BAR;
    }
    for (;;) {
        const bool has_next = S.next(ui + 1, nxt);
        const char* nA = has_next ? (const char*)g.A + (size_t)nxt.pm * tstepA : cA; const char* nB = has_next ? (const char*)g.Bt + (size_t)nxt.pn * tstepB : cB;
        for (int t = 0; t < nt; t += 2) {
            if constexpr (Epi::HOOK_T > 0) { if (t == Epi::HOOK_T) { int frx = fr; asm volatile("" : "+v"(frx)); E.mid(acc, cur, wr, wc, frx, fq); } }
            const bool last = (t == nt - 2);
            const char* a1 = cA + (size_t)(t + 1) * kstep;
            const char* a2 = last ? nA : cA + (size_t)(t + 2) * kstep; const char* b2 = last ? nB : cB + (size_t)(t + 2) * kstep;
            const char* a3 = a2 + kstep; const char* b3 = b2 + kstep;
            if (last && has_next) S.a_ready(nxt);
            if constexpr (SP2) {
            PG8_LDB(B0, 0, 0); PG8_LDB(B1, 0, 1); PG8_SCHED; PG8_LDA(At, 0, 0); PG8_STAGE(PG8_SA(1, 1), a1 + hstepA, voffA);
            PG8_WAIT_V(8); PG8_WAIT_L(0); PG8_BAR; PG8_MMA(0, 0, At, B0); PG8_MMA(0, 1, At, B1); PG8_BAR; PG8_SCHED;
            PG8_LDA(At, 0, 1); PG8_STAGE(PG8_SB(0, 0), b2, voffB); PG8_STAGE(PG8_SB(0, 1), b2 + hstepB, voffB); PG8_STAGE(PG8_SA(0, 0), a2, voffA);
            PG8_WAIT_V(8); PG8_WAIT_L(0); PG8_BAR; PG8_MMA(1, 0, At, B0); PG8_MMA(1, 1, At, B1); PG8_BAR; PG8_SCHED;
            PG8_LDB(B0, 1, 0); PG8_LDB(B1, 1, 1); PG8_SCHED; PG8_LDA(At, 1, 0); PG8_STAGE(PG8_SA(0, 1), a2 + hstepA, voffA);
            PG8_WAIT_V(8); PG8_WAIT_L(0); PG8_BAR; PG8_MMA(0, 0, At, B0); PG8_MMA(0, 1, At, B1); PG8_BAR; PG8_SCHED;
            PG8_LDA(At, 1, 1); PG8_STAGE(PG8_SB(1, 0), b3, voffB); PG8_STAGE(PG8_SB(1, 1), b3 + hstepB, voffB); PG8_STAGE(PG8_SA(1, 0), a3, voffA);
            PG8_WAIT_V(8); PG8_WAIT_L(0); PG8_BAR; PG8_MMA(1, 0, At, B0); PG8_MMA(1, 1, At, B1); PG8_BAR; PG8_SCHED;
            } else {
            PG8_LDB(B0, 0, 0); PG8_SCHED; PG8_LDA(At, 0, 0); PG8_STAGE(PG8_SA(1, 1), a1 + hstepA, voffA);
            PG8_WAIT_L(8); PG8_BAR; PG8_WAIT_L(0); PG8_MMA(0, 0, At, B0); PG8_BAR; PG8_SCHED;
            PG8_LDB(B1, 0, 1); PG8_STAGE(PG8_SB(0, 0), b2, voffB);
            PG8_BAR; PG8_WAIT_L(0); PG8_MMA(0, 1, At, B1); PG8_BAR;
            PG8_LDA(At, 0, 1); PG8_STAGE(PG8_SA(0, 0), a2, voffA);
            PG8_BAR; PG8_WAIT_L(0); PG8_MMA(1, 0, At, B0); PG8_BAR; PG8_SCHED;
            PG8_STAGE(PG8_SB(0, 1), b2 + hstepB, voffB);
            PG8_WAIT_V(6); PG8_BAR; PG8_MMA(1, 1, At, B1); PG8_BAR;
            PG8_LDB(B0, 1, 0); PG8_SCHED; PG8_LDA(At, 1, 0); PG8_STAGE(PG8_SA(0, 1), a2 + hstepA, voffA);
            PG8_WAIT_L(8); PG8_BAR; PG8_WAIT_L(0); PG8_MMA(0, 0, At, B0); PG8_BAR; PG8_SCHED;
            PG8_LDB(B1, 1, 1); PG8_STAGE(PG8_SB(1, 0), b3, voffB);
            PG8_BAR; PG8_WAIT_L(0); PG8_MMA(0, 1, At, B1); PG8_BAR;
            PG8_LDA(At, 1, 1); PG8_STAGE(PG8_SA(1, 0), a3, voffA);
            PG8_BAR; PG8_WAIT_L(0); PG8_MMA(1, 0, At, B0); PG8_BAR; PG8_SCHED;
            PG8_STAGE(PG8_SB(1, 1), b3 + hstepB, voffB);
            PG8_WAIT_V(6); PG8_BAR; PG8_MMA(1, 1, At, B1); PG8_BAR;
            }
        }
        if constexpr (ALIGN_EPI) { if (wr == 0) PG8_BAR; }
        if constexpr (!Epi::AFTER_DRAIN) { int frx = fr; asm volatile("" : "+v"(frx)); E(acc, cur, wr, wc, frx, fq); S.done(cur); }
        if (!has_next) break;
#pragma unroll
        for (int a = 0; a < 2; ++a)
#pragma unroll
            for (int b = 0; b < 2; ++b)
#pragma unroll
                for (int m = 0; m < 4; ++m)
#pragma unroll
                    for (int n = 0; n < 2; ++n) acc[a][b][m][n] = (f32x4){0.f, 0.f, 0.f, 0.f};
        cur = nxt; cA = nA; cB = nB; ++ui;
        if constexpr (ALIGN_EPI) { if (wr == 1) PG8_BAR; }
    }
    PG8_WAIT_V(0);
    if constexpr (!ALIGN_EPI) { if (wr == 0) PG8_BAR; }
    PG8_BAR;
    if constexpr (Epi::AFTER_DRAIN) { E.fused(acc, cur, wr, wc, fr, fq, lds, wid, lane); S.done(cur); }
#undef PG8_SA
#undef PG8_SB
#undef PG8_STAGE
#undef PG8_LDA
#undef PG8_LDB
#undef PG8_MMA
#undef PG8_WAIT_V
#undef PG8_WAIT_L
#undef PG8_BAR
#undef PG8_SCHED
}
}

#define LAS __attribute__((address_space(3)))
typedef LAS unsigned char* ldsp;
typedef unsigned short bf16;
typedef _Float16 f16;
typedef float f32x4 __attribute__((ext_vector_type(4)));
typedef float f32x16 __attribute__((ext_vector_type(16)));
typedef short bf16x8 __attribute__((ext_vector_type(8)));
typedef unsigned u32x4 __attribute__((ext_vector_type(4)));
typedef unsigned u32x2 __attribute__((ext_vector_type(2)));

constexpr int T = 32768, DM = 1024, SEQ = 4096, DEPTH = 4, DFF = 2816, DIN = 5632;
constexpr size_t MiB = 1u << 20;
constexpr size_t WS_W0 = 2 * MiB, WS_WSTRIDE = 36 * MiB;
constexpr size_t WS_PB = 74 * MiB;
constexpr size_t WS_BX = 90 * MiB, WS_BU = 154 * MiB;
constexpr size_t WS_SSQA = 218 * MiB, WS_SSQB = 220 * MiB, WS_SSQC = 222 * MiB;
constexpr size_t WS_LB = 224 * MiB;
constexpr size_t WS_ADEC = 225 * MiB;
constexpr size_t WS_RQ = 226 * MiB, WS_RLF = 258 * MiB, WS_RI = 290 * MiB, WS_ROAB = 322 * MiB, WS_RAK = 386 * MiB, WS_RAVT = 418 * MiB, WS_RU = 450 * MiB;
constexpr size_t WS_GA = 226 * MiB, WS_GB = 450 * MiB, WS_MERGED = 386 * MiB, WS_HB = 226 * MiB;
constexpr size_t WS_END = 515 * MiB;
constexpr size_t WO_IN = 0, WO_AB = WO_IN + (size_t)DIN * 1024, WO_OUT = WO_AB + 1024 * 1024, WO_GU = WO_OUT + 1024 * 1024, WO_D = WO_GU + (size_t)DIN * 1024,
                 WO_PG = WO_D + (size_t)1024 * DFF, WO_PE = WO_PG + 1024 * 1024, WO_END = WO_PE + 1024 * 256;
static_assert(WO_END * 2 <= WS_WSTRIDE, "weight set");
constexpr int RING_BYTES = 131072, EPI_SCR = 139264, LDS_BYTES = 155648;

__device__ __forceinline__ unsigned pk2(float lo, float hi) { typedef float f2_ __attribute__((ext_vector_type(2))); typedef __bf16 b2_ __attribute__((ext_vector_type(2))); f2_ v = {lo, hi}; b2_ b = __builtin_convertvector(v, b2_); return __builtin_bit_cast(unsigned, b); }
__device__ __forceinline__ unsigned f2bf(float f) { return pk2(f, 0.f) & 0xffffu; }
__device__ __forceinline__ float b2f(unsigned h) { return __uint_as_float(h << 16); }
__device__ __forceinline__ float wave_sum(float v) {
#pragma unroll
    for (int o = 1; o < 64; o <<= 1) v += __shfl_xor(v, o);
    return v;
}

__device__ __forceinline__ int map_row(int mode, int n) {
    if (mode == 1) { if (n >= 2048 && n < 3072) { const int tile = n & ~255, o = n & 255, hd = o >> 6, d = o & 63; return tile + 128 * (d >> 5) + 32 * hd + (d & 31); } return n; }
    if (mode == 2) return (n >> 7) * 256 + (n & 127);
    if (mode == 3) return (n >> 7) * 256 + 128 + (n & 127);
    return n;
}
struct CvtP { const float* W; const float* gk; bf16* WT; int N, Kd, koff, mode, item; };
struct Ins { const float* in[19]; };
__device__ __forceinline__ CvtP cvt_params(const Ins& I, int l, bf16* Wb, int it) {
    constexpr int I_IN = 16 * 176, I_A = 8 * 32, I_O = 16 * 32, I_G = 16 * 88, I_D = 44 * 32, I_PG = 16 * 32;
    int r = it; CvtP p;
    if (r < I_IN) { p = CvtP{I.in[3] + (size_t)l * 1024 * DIN, I.in[2] + l * 1024, Wb + WO_IN, DIN, 1024, 0, 1, r}; return p; } r -= I_IN;
    if (r < I_A) { p = CvtP{I.in[9] + (size_t)l * 512 * 1024, nullptr, Wb + WO_AB, 1024, 1024, 0, 0, r}; return p; } r -= I_A;
    if (r < I_A) { p = CvtP{I.in[10] + (size_t)l * 512 * 1024, nullptr, Wb + WO_AB, 1024, 1024, 512, 0, r}; return p; } r -= I_A;
    if (r < I_O) { p = CvtP{I.in[11] + (size_t)l * 1024 * 1024, nullptr, Wb + WO_OUT, 1024, 1024, 0, 0, r}; return p; } r -= I_O;
    if (r < I_G) { p = CvtP{I.in[13] + (size_t)l * 1024 * DFF, I.in[12] + l * 1024, Wb + WO_GU, DFF, 1024, 0, 2, r}; return p; } r -= I_G;
    if (r < I_G) { p = CvtP{I.in[14] + (size_t)l * 1024 * DFF, I.in[12] + l * 1024, Wb + WO_GU, DFF, 1024, 0, 3, r}; return p; } r -= I_G;
    if (r < I_D) { p = CvtP{I.in[15] + (size_t)l * DFF * 1024, nullptr, Wb + WO_D, 1024, DFF, 0, 0, r}; return p; } r -= I_D;
    if (r < I_PG) { p = CvtP{I.in[17] + (size_t)l * 1024 * 1024, I.in[16] + l * 1024, Wb + WO_PG, 1024, 1024, 0, 0, r}; return p; } r -= I_PG;
    p = CvtP{I.in[18] + (size_t)l * 256 * 1024, nullptr, Wb + WO_PE, 1024, 256, 0, 0, r}; return p;
}
__device__ __forceinline__ void cvt_load(const CvtP& p, f32x4 (&wv)[8], float (&gv)[8], int lane) {
    const int nblk = p.N / 32, kb = p.item / nblk, nb = p.item % nblk, k0 = 64 * kb, n0 = 32 * nb;
#pragma unroll
    for (int i = 0; i < 8; ++i) { const int kk = 8 * i + (lane >> 3); wv[i] = *(const f32x4*)(p.W + (size_t)(k0 + kk) * p.N + n0 + 4 * (lane & 7)); gv[i] = p.gk ? p.gk[k0 + kk] : 1.f; }
}
__device__ __forceinline__ void cvt_store(const CvtP& p, const f32x4 (&wv)[8], const float (&gv)[8], LAS float* scr, int lane) {
    const int nblk = p.N / 32, kb = p.item / nblk, nb = p.item % nblk, k0 = 64 * kb, n0 = 32 * nb;
#pragma unroll
    for (int i = 0; i < 8; ++i) { const int kk = 8 * i + (lane >> 3); LAS float* d = scr + kk * 33 + 4 * (lane & 7);
        d[0] = wv[i][0] * gv[i]; d[1] = wv[i][1] * gv[i]; d[2] = wv[i][2] * gv[i]; d[3] = wv[i][3] * gv[i]; }
    asm volatile("s_waitcnt lgkmcnt(0)" ::: "memory");
    const int c = lane & 7;
#pragma unroll
    for (int j = 0; j < 4; ++j) { const int n = (lane >> 3) + 8 * j; const LAS float* s = scr + (8 * c) * 33 + n;
        u32x4 o; o.x = pk2(s[0 * 33], s[1 * 33]); o.y = pk2(s[2 * 33], s[3 * 33]); o.z = pk2(s[4 * 33], s[5 * 33]); o.w = pk2(s[6 * 33], s[7 * 33]);
        *(u32x4*)(p.WT + (size_t)map_row(p.mode, n0 + n) * p.Kd + p.koff + k0 + 8 * c) = o; }
    asm volatile("s_waitcnt lgkmcnt(0)" ::: "memory");
}
__device__ __forceinline__ void cvt_weights(const Ins& I, int l, bf16* Wb, ldsp L, int wave, int lane) {
    LAS float* scr = (LAS float*)(L + wave * 16384);
    const int gw = blockIdx.x * 8 + wave, NGW = gridDim.x * 8;
    constexpr int NIT = 16 * 176 + 2 * 8 * 32 + 16 * 32 + 2 * 16 * 88 + 44 * 32 + 16 * 32 + 4 * 32;
    if (gw >= NIT) return;
    CvtP pc = cvt_params(I, l, Wb, gw); f32x4 wa[8]; float ga[8];
    cvt_load(pc, wa, ga, lane);
#pragma unroll 1
    for (int it = gw; it < NIT; it += NGW) {
        const int nx = it + NGW < NIT ? it + NGW : it;
        const CvtP pn = cvt_params(I, l, Wb, nx); f32x4 wb[8]; float gb[8];
        cvt_load(pn, wb, gb, lane);
        __builtin_amdgcn_sched_barrier(0);
        cvt_store(pc, wa, ga, scr, lane);
        pc = pn;
#pragma unroll
        for (int i = 0; i < 8; ++i) { wa[i] = wb[i]; ga[i] = gb[i]; }
    }
}
__device__ __forceinline__ void cvt_p(const float* p, bf16* PB, int tid_in) {
    int tid_ = tid_in; asm volatile("" : "+v"(tid_));
    const size_t n8 = (size_t)T * 256 / 8; const size_t gt = (size_t)blockIdx.x * 512 + tid_, NT = (size_t)gridDim.x * 512;
    for (size_t i0 = gt; i0 < n8; i0 += 4 * NT) {
        f32x4 a[4], b[4];
#pragma unroll
        for (int u = 0; u < 4; ++u) { const size_t i = i0 + u * NT; if (i < n8) { a[u] = *(const f32x4*)(p + i * 8); b[u] = *(const f32x4*)(p + i * 8 + 4); } }
#pragma unroll
        for (int u = 0; u < 4; ++u) { const size_t i = i0 + u * NT; if (i < n8) { u32x4 o; o.x = pk2(a[u][0], a[u][1]); o.y = pk2(a[u][2], a[u][3]); o.z = pk2(b[u][0], b[u][1]); o.w = pk2(b[u][2], b[u][3]); *(u32x4*)(PB + i * 8) = o; } } }
}
__device__ __forceinline__ void cvt_x(const float* x, bf16* XB, float* ssq, int wave, int lane) {
    const int gw = blockIdx.x * 8 + wave, NGW = gridDim.x * 8;
    for (int row0 = gw; row0 < T; row0 += 4 * NGW) {
        f32x4 v[4][4];
#pragma unroll
        for (int u = 0; u < 4; ++u) { const int row = row0 + u * NGW; if (row < T) { const f32x4* xr = (const f32x4*)(x + (size_t)row * 1024) + lane;
#pragma unroll
            for (int j = 0; j < 4; ++j) v[u][j] = xr[64 * j]; } }
#pragma unroll
        for (int u = 0; u < 4; ++u) { const int row = row0 + u * NGW; if (row < T) { float s = 0.f;
#pragma unroll
            for (int j = 0; j < 4; ++j) s += (v[u][j][0] * v[u][j][0] + v[u][j][1] * v[u][j][1]) + (v[u][j][2] * v[u][j][2] + v[u][j][3] * v[u][j][3]);
            s = wave_sum(s);
            u32x2* o = (u32x2*)(XB + (size_t)row * 1024) + lane;
#pragma unroll
            for (int j = 0; j < 4; ++j) { u32x2 w; w.x = pk2(v[u][j][0], v[u][j][1]); w.y = pk2(v[u][j][2], v[u][j][3]); o[64 * j] = w; }
            if (lane < 16) ssq[(size_t)row * 16 + lane] = lane == 0 ? s : 0.f; } }
    }
}

#define MFMA16(a, b, c) __builtin_amdgcn_mfma_f32_16x16x32_bf16((a), (b), (c), 0, 0, 0)
#define MFMA32(a, b, c) __builtin_amdgcn_mfma_f32_32x32x16_bf16((a), (b), (c), 0, 0, 0)
__device__ __forceinline__ void hgrn_stageA(ldsp L, int item_first, int item_step, bf16* RQ, const f16* RLF, bf16* RI, bf16* U, float* ADEC, int tid_in) {
    constexpr int QS = 0, KS = 17408, KT = 34816, IT = 53248, AS = 71680, TOT = 80896;
    int tid_ = tid_in; asm volatile("" : "+v"(tid_));
    const int tid = tid_, lane = tid & 63, w = __builtin_amdgcn_readfirstlane(tid >> 6), fr = lane & 15, fq = lane >> 4;
    const int k = tid & 127, tq = tid >> 7;
    unsigned short lfn[16], qn[16], in_[16];
#define SA_LOAD(item_) do { const int bh_ = (item_) >> 6, c_ = (item_) & 63; const size_t r_ = (size_t)(bh_ >> 2) * SEQ + c_ * 64 + 16 * tq; const int hc_ = (bh_ & 3) * 128; \
        const unsigned short* lp_ = (const unsigned short*)RLF + r_ * 512 + hc_ + k; const bf16* qp_ = RQ + r_ * 512 + hc_ + k; const bf16* ip_ = RI + r_ * 512 + hc_ + k; \
        _Pragma("unroll") for (int j = 0; j < 16; ++j) { lfn[j] = lp_[(size_t)j * 512]; qn[j] = qp_[(size_t)j * 512]; in_[j] = ip_[(size_t)j * 512]; } } while (0)
#define SA_BAR() asm volatile("s_waitcnt lgkmcnt(0)\n\ts_barrier" ::: "memory")
    SA_LOAD(item_first);
    float lf[16]; unsigned qraw[16], iraw[16];
#define SA_CONSUME() do { _Pragma("unroll") for (int j = 0; j < 16; ++j) { lf[j] = (float)__builtin_bit_cast(_Float16, lfn[j]); qraw[j] = qn[j]; iraw[j] = in_[j]; } } while (0)
    SA_CONSUME();
#pragma unroll 1
    for (int item = item_first; item < 2048; item += item_step) {
    const int bh = item >> 6, c = item & 63, b = bh >> 2, h = bh & 3, hc = h * 128;
    const size_t row0 = (size_t)b * SEQ + c * 64;
    bf16* qp = RQ + (row0 + 16 * tq) * 512 + hc + k;
    float cs[16];
    { const int nxt_ = item + item_step < 2048 ? item + item_step : item; SA_LOAD(nxt_); }
    __builtin_amdgcn_sched_barrier(0);
    { float run = 0.f;
#pragma unroll
      for (int j = 0; j < 16; ++j) { run += lf[j]; cs[j] = run; } }
    ((LAS float*)(L + TOT))[tq * 128 + k] = cs[15];
    SA_BAR();
    const float t0 = ((LAS float*)(L + TOT))[k], t1 = ((LAS float*)(L + TOT))[128 + k], t2 = ((LAS float*)(L + TOT))[256 + k], t3 = ((LAS float*)(L + TOT))[384 + k];
    const float off = tq == 0 ? 0.f : (tq == 1 ? t0 : (tq == 2 ? t0 + t1 : (t0 + t1) + t2));
    const float bmid = t0 + t1, blast = (t0 + t1) + (t2 + t3);
    unsigned kt[16];
    const float c_last = __expf(blast - bmid), c_mid = __expf(bmid);
#pragma unroll
    for (int j = 0; j < 16; ++j) {
        const float bb = off + cs[j]; const float q = b2f(qraw[j]) * 0.08838834764831845f; const float kk = 1.f - __expf(lf[j]);
        const float ee = __expf(fminf(fmaxf(bb - bmid, -60.f), 60.f)), ei = __builtin_amdgcn_rcpf(ee);
        const float qpv = q * ee, kpv = kk * ei, kpp = kpv * c_last, qe = qpv * c_mid;
        const int t = 16 * tq + j;
        *(LAS unsigned short*)(L + QS + t * 272 + k * 2) = (unsigned short)f2bf(qpv);
        *(LAS unsigned short*)(L + KS + t * 272 + k * 2) = (unsigned short)f2bf(kpv);
        kt[j] = f2bf(kpp);
        qp[(size_t)j * 512] = (bf16)f2bf(qe);
    }
    { u32x4 a, bq;
      a.x = kt[0] | (kt[1] << 16); a.y = kt[2] | (kt[3] << 16); a.z = kt[4] | (kt[5] << 16); a.w = kt[6] | (kt[7] << 16);
      bq.x = kt[8] | (kt[9] << 16); bq.y = kt[10] | (kt[11] << 16); bq.z = kt[12] | (kt[13] << 16); bq.w = kt[14] | (kt[15] << 16);
      *(LAS u32x4*)(L + KT + k * 144 + tq * 32) = a; *(LAS u32x4*)(L + KT + k * 144 + tq * 32 + 16) = bq;
      a.x = iraw[0] | (iraw[1] << 16); a.y = iraw[2] | (iraw[3] << 16); a.z = iraw[4] | (iraw[5] << 16); a.w = iraw[6] | (iraw[7] << 16);
      bq.x = iraw[8] | (iraw[9] << 16); bq.y = iraw[10] | (iraw[11] << 16); bq.z = iraw[12] | (iraw[13] << 16); bq.w = iraw[14] | (iraw[15] << 16);
      *(LAS u32x4*)(L + IT + k * 144 + tq * 32) = a; *(LAS u32x4*)(L + IT + k * 144 + tq * 32 + 16) = bq; }
    if (tq == 0) ADEC[(size_t)item * 128 + k] = __expf(blast);
    SA_BAR();
    { const int tb = w >> 1;
#pragma unroll
      for (int sbi = 0; sbi < 2; ++sbi) { const int sb = 2 * (w & 1) + sbi; f32x4 acc = {0.f, 0.f, 0.f, 0.f};
          if (sb <= tb) {
#pragma unroll
              for (int kk = 0; kk < 4; ++kk) { const bf16x8 a = *(const LAS bf16x8*)(L + QS + (16 * tb + fr) * 272 + (32 * kk + 8 * fq) * 2), bb = *(const LAS bf16x8*)(L + KS + (16 * sb + fr) * 272 + (32 * kk + 8 * fq) * 2);
                  acc = MFMA16(a, bb, acc); } }
#pragma unroll
          for (int r = 0; r < 4; ++r) { const int t = 16 * tb + 4 * fq + r, s = 16 * sb + fr; const float v = (sb <= tb && t >= s) ? acc[r] : 0.f;
              *(LAS unsigned short*)(L + AS + t * 144 + s * 2) = (unsigned short)f2bf(v); } } }
    SA_BAR();
    { const int v = 16 * w + fr;
      u32x2 o2[4], u3[8];
      bf16x8 ib[2];
#pragma unroll
      for (int ks = 0; ks < 2; ++ks) ib[ks] = *(const LAS bf16x8*)(L + IT + v * 144 + (32 * ks + 8 * fq) * 2);
#pragma unroll
      for (int tb = 0; tb < 4; ++tb) { f32x4 acc = {0.f, 0.f, 0.f, 0.f};
#pragma unroll
          for (int ks = 0; ks < 2; ++ks) { const bf16x8 a = *(const LAS bf16x8*)(L + AS + (16 * tb + fr) * 144 + (32 * ks + 8 * fq) * 2); acc = MFMA16(a, ib[ks], acc); }
          o2[tb].x = pk2(acc[0], acc[1]); o2[tb].y = pk2(acc[2], acc[3]); }
#pragma unroll
      for (int kb = 0; kb < 8; ++kb) { f32x4 acc = {0.f, 0.f, 0.f, 0.f};
#pragma unroll
          for (int ks = 0; ks < 2; ++ks) { const bf16x8 a = *(const LAS bf16x8*)(L + KT + (16 * kb + fr) * 144 + (32 * ks + 8 * fq) * 2); acc = MFMA16(a, ib[ks], acc); }
          u3[kb].x = pk2(acc[0], acc[1]); u3[kb].y = pk2(acc[2], acc[3]); }
      SA_CONSUME();
      __builtin_amdgcn_sched_barrier(0);
#pragma unroll
      for (int tb = 0; tb < 4; ++tb) *(u32x2*)(RI + (row0 + (v >> 1)) * 512 + hc + (v & 1) * 64 + 16 * tb + 4 * fq) = o2[tb];
#pragma unroll
      for (int kb = 0; kb < 8; ++kb) *(u32x2*)(U + (size_t)item * 16384 + v * 128 + 16 * kb + 4 * fq) = u3[kb]; }
    SA_BAR();
    }
#undef SA_LOAD
#undef SA_CONSUME
#undef SA_BAR
}

template <int CTRL> __device__ __forceinline__ float dppf(float v) { return __builtin_bit_cast(float, __builtin_amdgcn_update_dpp(0, __builtin_bit_cast(int, v), CTRL, 0xf, 0xf, true)); }
__device__ __forceinline__ float row_sum16(float s) { s += dppf<0xB1>(s); s += dppf<0x4E>(s); s += dppf<0x124>(s); s += dppf<0x128>(s); return s; }
__device__ __forceinline__ unsigned cvtpk(float lo, float hi) { typedef float f2 __attribute__((ext_vector_type(2))); typedef __bf16 b2 __attribute__((ext_vector_type(2))); f2 v = {lo, hi}; b2 b = __builtin_convertvector(v, b2); return __builtin_bit_cast(unsigned, b); }
template <int GLOBAL_OUT> __device__ __forceinline__ void hgrn_scan_wave(ldsp L, bf16* OINT, int bh, int vs, const bf16* RQ, const bf16* U, const float* ADEC, int lane_in) {
    int lane = lane_in; asm volatile("" : "+v"(lane));
    const int fr = lane & 15, fq = lane >> 4;
    const int b = bh >> 2, h = bh & 3, hc = h * 128, v = 16 * vs + fr;
    float S[4][8];
#pragma unroll
    for (int kb = 0; kb < 4; ++kb)
#pragma unroll
        for (int j = 0; j < 8; ++j) S[kb][j] = 0.f;
    const bf16* pq = RQ + ((size_t)b * SEQ + fr) * 512 + hc + 8 * fq;
    const bf16* pu = U + (size_t)bh * 64 * 16384 + v * 128 + 8 * fq;
    const float* pa = ADEC + (size_t)bh * 64 * 128 + 8 * fq;
    bf16* pg = OINT + (size_t)bh * 64 * 8192 + v * 64 + 4 * fq;
    ldsp po = L + fr * 128 + 8 * fq;
    bf16x8 Aq[4][4]; u32x4 Uv[4]; f32x4 av[4][2];
#pragma unroll
    for (int tb = 0; tb < 4; ++tb)
#pragma unroll
        for (int kb = 0; kb < 4; ++kb) Aq[tb][kb] = *(const bf16x8*)(pq + tb * 16 * 512 + kb * 32);
#pragma unroll
    for (int kb = 0; kb < 4; ++kb) { Uv[kb] = *(const u32x4*)(pu + kb * 32); av[kb][0] = *(const f32x4*)(pa + kb * 32); av[kb][1] = *(const f32x4*)(pa + kb * 32 + 4); }
    const unsigned* tq_ = (const unsigned*)(RQ + ((size_t)b * SEQ + lane) * 512 + hc);
    const unsigned* tu_ = (const unsigned*)(U + (size_t)bh * 64 * 16384 + (16 * vs + (lane & 15)) * 128 + ((lane >> 4) & 1) * 64);
    unsigned tch0 = 0, tch1 = 0, tch2 = 0;
#pragma unroll 1
    for (int c = 0; c < 64; ++c) {
        pq += 64 * 512; pu += 16384; pa += 128;
        asm volatile("" :: "v"(tch0), "v"(tch1), "v"(tch2));
        { const int cp = c + 3 < 64 ? c + 3 : 63;
          tch0 = tq_[(size_t)cp * 64 * 256]; tch1 = tq_[(size_t)cp * 64 * 256 + 32]; tch2 = tu_[(size_t)cp * 8192]; }
        __builtin_amdgcn_sched_barrier(0);
        bf16x8 Sb[4];
#pragma unroll
        for (int kb = 0; kb < 4; ++kb) { u32x4 t; t.x = cvtpk(S[kb][0], S[kb][1]); t.y = cvtpk(S[kb][2], S[kb][3]); t.z = cvtpk(S[kb][4], S[kb][5]); t.w = cvtpk(S[kb][6], S[kb][7]); Sb[kb] = __builtin_bit_cast(bf16x8, t); }
#pragma unroll
        for (int tb = 0; tb < 4; ++tb) { f32x4 acc = {0.f, 0.f, 0.f, 0.f};
#pragma unroll
            for (int kb = 0; kb < 4; ++kb) acc = MFMA16(Aq[tb][kb], Sb[kb], acc);
#pragma unroll
            for (int kb = 0; kb < 4; ++kb) Aq[tb][kb] = *(const bf16x8*)(pq + tb * 16 * 512 + kb * 32);
            u32x2 o; o.x = cvtpk(acc[0], acc[1]); o.y = cvtpk(acc[2], acc[3]);
            if (GLOBAL_OUT) *(u32x2*)(pg + tb * 16) = o; else *(LAS u32x2*)(po + tb * 32) = o;
            __builtin_amdgcn_sched_barrier(0); }
        po += 2048; pg += 8192;
#pragma unroll
        for (int kb = 0; kb < 4; ++kb) {
            S[kb][0] = av[kb][0][0] * S[kb][0] + b2f(Uv[kb].x & 0xffffu); S[kb][1] = av[kb][0][1] * S[kb][1] + b2f(Uv[kb].x >> 16);
            S[kb][2] = av[kb][0][2] * S[kb][2] + b2f(Uv[kb].y & 0xffffu); S[kb][3] = av[kb][0][3] * S[kb][3] + b2f(Uv[kb].y >> 16);
            S[kb][4] = av[kb][1][0] * S[kb][4] + b2f(Uv[kb].z & 0xffffu); S[kb][5] = av[kb][1][1] * S[kb][5] + b2f(Uv[kb].z >> 16);
            S[kb][6] = av[kb][1][2] * S[kb][6] + b2f(Uv[kb].w & 0xffffu); S[kb][7] = av[kb][1][3] * S[kb][7] + b2f(Uv[kb].w >> 16);
            Uv[kb] = *(const u32x4*)(pu + kb * 32); av[kb][0] = *(const f32x4*)(pa + kb * 32); av[kb][1] = *(const f32x4*)(pa + kb * 32 + 4); }
        __builtin_amdgcn_sched_barrier(0);
    }
}
template <int GLOBAL_OUT> __device__ __forceinline__ void hgrn_scan_wave4(ldsp L, bf16* OINT, int bh, int vs, int tb, const bf16* RQ, const bf16* U, const float* ADEC, int lane_in) {
    int lane = lane_in; asm volatile("" : "+v"(lane));
    const int fr = lane & 15, fq = lane >> 4;
    const int b = bh >> 2, h = bh & 3, hc = h * 128, v = 16 * vs + fr;
    float S[4][8];
#pragma unroll
    for (int kb = 0; kb < 4; ++kb)
#pragma unroll
        for (int j = 0; j < 8; ++j) S[kb][j] = 0.f;
    const bf16* pq = RQ + ((size_t)b * SEQ + 16 * tb + fr) * 512 + hc + 8 * fq;
    const bf16* pu = U + (size_t)bh * 64 * 16384 + v * 128 + 8 * fq;
    const float* pa = ADEC + (size_t)bh * 64 * 128 + 8 * fq;
    ldsp po = L + fr * 128 + 8 * fq + tb * 32;
    bf16* pg = OINT + (size_t)bh * 64 * 8192 + v * 64 + 4 * fq + tb * 16;
    bf16x8 A0[4], A1[4]; u32x4 U0[4], U1[4]; f32x4 a0[4][2], a1[4][2];
#define SC_LOAD(A_, U_, a_, cc) do { _Pragma("unroll") for (int kb = 0; kb < 4; ++kb) { A_[kb] = *(const bf16x8*)(pq + (size_t)(cc) * 64 * 512 + kb * 32); \
        U_[kb] = *(const u32x4*)(pu + (size_t)(cc) * 16384 + kb * 32); a_[kb][0] = *(const f32x4*)(pa + (size_t)(cc) * 128 + kb * 32); a_[kb][1] = *(const f32x4*)(pa + (size_t)(cc) * 128 + kb * 32 + 4); } } while (0)
#define SC_STEP(A_, U_, a_, cc) do { bf16x8 Sb[4]; \
        _Pragma("unroll") for (int kb = 0; kb < 4; ++kb) { u32x4 t; t.x = cvtpk(S[kb][0], S[kb][1]); t.y = cvtpk(S[kb][2], S[kb][3]); t.z = cvtpk(S[kb][4], S[kb][5]); t.w = cvtpk(S[kb][6], S[kb][7]); Sb[kb] = __builtin_bit_cast(bf16x8, t); } \
        f32x4 acc = {0.f, 0.f, 0.f, 0.f}; \
        _Pragma("unroll") for (int kb = 0; kb < 4; ++kb) acc = MFMA16(A_[kb], Sb[kb], acc); \
        _Pragma("unroll") for (int kb = 0; kb < 4; ++kb) { \
            S[kb][0] = a_[kb][0][0] * S[kb][0] + b2f(U_[kb].x & 0xffffu); S[kb][1] = a_[kb][0][1] * S[kb][1] + b2f(U_[kb].x >> 16); \
            S[kb][2] = a_[kb][0][2] * S[kb][2] + b2f(U_[kb].y & 0xffffu); S[kb][3] = a_[kb][0][3] * S[kb][3] + b2f(U_[kb].y >> 16); \
            S[kb][4] = a_[kb][1][0] * S[kb][4] + b2f(U_[kb].z & 0xffffu); S[kb][5] = a_[kb][1][1] * S[kb][5] + b2f(U_[kb].z >> 16); \
            S[kb][6] = a_[kb][1][2] * S[kb][6] + b2f(U_[kb].w & 0xffffu); S[kb][7] = a_[kb][1][3] * S[kb][7] + b2f(U_[kb].w >> 16); } \
        __builtin_amdgcn_sched_barrier(0); \
        SC_LOAD(A_, U_, a_, (cc) + 2); \
        { u32x2 o; o.x = cvtpk(acc[0], acc[1]); o.y = cvtpk(acc[2], acc[3]); if (GLOBAL_OUT) *(u32x2*)(pg + (size_t)(cc) * 8192) = o; else *(LAS u32x2*)(po + (cc) * 2048) = o; } \
        __builtin_amdgcn_sched_barrier(0); } while (0)
    SC_LOAD(A0, U0, a0, 0); SC_LOAD(A1, U1, a1, 1);
#pragma unroll 1
    for (int c = 0; c < 64; c += 2) { SC_STEP(A0, U0, a0, c); SC_STEP(A1, U1, a1, c + 1); }
#undef SC_LOAD
#undef SC_STEP
}
__device__ __forceinline__ void hgrn_post(ldsp L, const bf16* OINT, const bf16* RI, bf16* ROAB, const float* gn, int wave, int lane_in) {
    int lane = lane_in; asm volatile("" : "+v"(lane));
    LAS float* tl = (LAS float*)(L + wave * 16384);
    const int t = lane >> 2, q = lane & 3;
    const int gw = blockIdx.x * 8 + wave, NGW = gridDim.x * 8;
    f32x4 gnv[8];
#pragma unroll
    for (int i = 0; i < 8; ++i) gnv[i] = *(const f32x4*)(gn + 32 * q + 4 * i);
#pragma unroll 1
    for (int task = gw; task < 8192; task += NGW) {
        const int item = task >> 2, tb = task & 3; const int bh = item >> 6, c = item & 63, b = bh >> 2, h = bh & 3, hc = h * 128;
        const size_t row0 = (size_t)b * SEQ + c * 64;
        bf16* op = ROAB + (row0 + 16 * tb + t) * 1024 + hc + 32 * q;
        u32x4 sgw4[4];
#pragma unroll
        for (int i = 0; i < 4; ++i) sgw4[i] = *(const u32x4*)(op + 8 * i);
#pragma unroll
        for (int hv = 0; hv < 2; ++hv) { const int v = lane + 64 * hv;
            const u32x4* p1 = (const u32x4*)(OINT + (size_t)item * 8192 + v * 64 + 16 * tb);
            const u32x4* p2 = (const u32x4*)(RI + (row0 + (v >> 1)) * 512 + hc + (v & 1) * 64 + 16 * tb);
            const u32x4 a0 = p1[0], a1 = p1[1], b0 = p2[0], b1 = p2[1];
            const unsigned wa[8] = {a0.x, a0.y, a0.z, a0.w, a1.x, a1.y, a1.z, a1.w}; const unsigned wb[8] = {b0.x, b0.y, b0.z, b0.w, b1.x, b1.y, b1.z, b1.w};
#pragma unroll
            for (int i = 0; i < 8; ++i) { tl[(2 * i) * 132 + v] = b2f(wa[i] & 0xffffu) + b2f(wb[i] & 0xffffu); tl[(2 * i + 1) * 132 + v] = b2f(wa[i] >> 16) + b2f(wb[i] >> 16); } }
        asm volatile("s_waitcnt lgkmcnt(0)" ::: "memory");
        f32x4 x[8]; float s = 0.f;
#pragma unroll
        for (int i = 0; i < 8; ++i) { x[i] = *(const LAS f32x4*)(tl + t * 132 + 32 * q + 4 * i); s += (x[i][0] * x[i][0] + x[i][1] * x[i][1]) + (x[i][2] * x[i][2] + x[i][3] * x[i][3]); }
        s += dppf<0xB1>(s); s += dppf<0x4E>(s);
        const float rinv = __builtin_amdgcn_rsqf(s * (1.0f / 128.0f) + 1e-6f);
#pragma unroll
        for (int i = 0; i < 4; ++i) { const u32x4 sgw = sgw4[i]; const f32x4 g0 = gnv[2 * i], g1 = gnv[2 * i + 1];
            const f32x4 xa = x[2 * i], xb = x[2 * i + 1]; u32x4 o;
            o.x = cvtpk(xa[0] * rinv * g0[0] * b2f(sgw.x & 0xffffu), xa[1] * rinv * g0[1] * b2f(sgw.x >> 16)); o.y = cvtpk(xa[2] * rinv * g0[2] * b2f(sgw.y & 0xffffu), xa[3] * rinv * g0[3] * b2f(sgw.y >> 16));
            o.z = cvtpk(xb[0] * rinv * g1[0] * b2f(sgw.z & 0xffffu), xb[1] * rinv * g1[1] * b2f(sgw.z >> 16)); o.w = cvtpk(xb[2] * rinv * g1[2] * b2f(sgw.w & 0xffffu), xb[3] * rinv * g1[3] * b2f(sgw.w >> 16));
            *(u32x4*)(op + 8 * i) = o; }
        asm volatile("s_waitcnt lgkmcnt(0)" ::: "memory");
    }
}

constexpr int AT_TAB = 0, AT_WS = 8 * 260 * 4;
__device__ __forceinline__ void attn_item(ldsp L, int wi, bf16* ROAB, const bf16* RAK, const bf16* RAVT, int w, int lane_) {
    int lane = lane_; asm volatile("" : "+v"(lane));
    const int half = wi & 1, h = (wi >> 1) & 7, n = (wi >> 4) & 63, b = wi >> 10;
    const int r32 = lane & 31, hi = lane >> 5;
    const size_t row0 = (size_t)b * SEQ + n * 64 + half * 32;
    bf16x8 qr[4];
#pragma unroll
    for (int d0 = 0; d0 < 4; ++d0) qr[d0] = *(const bf16x8*)(ROAB + (row0 + r32) * 1024 + 512 + h * 64 + 16 * d0 + 8 * hi);
    const LAS float* tab = (const LAS float*)(L + AT_TAB) + h * 260;
    LAS float* wsf = (LAS float*)(L + AT_WS) + w * 64;
    f32x16 o0, o1;
#pragma unroll
    for (int r = 0; r < 16; ++r) { o0[r] = 0.f; o1[r] = 0.f; }
    float mrun = -1e30f, lrun = 0.f;
    const bf16* kbase = RAK + ((size_t)(b * 8 + h) * 64) * 4096 + lane * 8;
    const bf16* vbase = RAVT + ((size_t)(b * 8 + h) * 64) * 4096 + lane * 8;
    const int tqpos = half * 32 + r32;
    const float cfar = tab[256];
    const int jstart = n >= 8 ? 0 : 8 - n;
    bf16x8 kf[2][4], vf[2][2][2];
#define ATT_LOAD(KF, VF, kc_) do { \
        _Pragma("unroll") for (int kh = 0; kh < 2; ++kh) _Pragma("unroll") for (int d0 = 0; d0 < 4; ++d0) KF[kh][d0] = *(const bf16x8*)(kbase + (size_t)(kc_) * 4096 + (kh * 4 + d0) * 512); \
        _Pragma("unroll") for (int dh = 0; dh < 2; ++dh) _Pragma("unroll") for (int kh = 0; kh < 2; ++kh) _Pragma("unroll") for (int blk = 0; blk < 2; ++blk) \
            VF[dh][kh][blk] = *(const bf16x8*)(vbase + (size_t)(kc_) * 4096 + ((dh * 2 + kh) * 2 + blk) * 512); } while (0)
    ATT_LOAD(kf, vf, n - 8 + jstart);
#pragma unroll 1
    for (int j = jstart; j <= 8; ++j) {
        bf16x8 kn[2][4], vn[2][2][2];
        { const int kcn = j < 8 ? n - 8 + j + 1 : n; ATT_LOAD(kn, vn, kcn); }
        __builtin_amdgcn_sched_barrier(0);
        f32x16 p0, p1;
#pragma unroll
        for (int r = 0; r < 16; ++r) { p0[r] = 0.f; p1[r] = 0.f; }
#pragma unroll
        for (int d0 = 0; d0 < 4; ++d0) { p0 = MFMA32(kf[0][d0], qr[d0], p0); p1 = MFMA32(kf[1][d0], qr[d0], p1); }
        float sub;
        if (j <= 5) { sub = mrun - cfar; }
        else {
            const int base = tqpos - ((j - 8) * 64 + 16 * hi) + 128;
#pragma unroll
            for (int r = 0; r < 16; ++r) { int i0 = base - r, i1 = base - r - 32; i0 = i0 < 0 ? 0 : (i0 > 256 ? 256 : i0); i1 = i1 < 0 ? 0 : (i1 > 256 ? 256 : i1);
                p0[r] += tab[i0]; p1[r] += tab[i1]; }
            sub = mrun;
        }
        if (j == jstart) {
            float mx = fmaxf(p0[0], p1[0]);
#pragma unroll
            for (int r = 1; r < 16; ++r) mx = fmaxf(mx, fmaxf(p0[r], p1[r]));
            mx = fmaxf(mx, shx(mx, lane, 32));
            if (j <= 5) { mrun = mx + cfar; sub = mx; } else { mrun = mx; sub = mx; }
        }
        float rs = 0.f;
#pragma unroll
        for (int r = 0; r < 16; ++r) { p0[r] = __builtin_amdgcn_exp2f(p0[r] - sub); p1[r] = __builtin_amdgcn_exp2f(p1[r] - sub); rs += p0[r] + p1[r]; }
        lrun += rs;
        bf16x8 pa[2][2];
        { u32x4 t;
          t.x = pk2(p0[0], p0[1]); t.y = pk2(p0[2], p0[3]); t.z = pk2(p0[4], p0[5]); t.w = pk2(p0[6], p0[7]); pa[0][0] = __builtin_bit_cast(bf16x8, t);
          t.x = pk2(p0[8], p0[9]); t.y = pk2(p0[10], p0[11]); t.z = pk2(p0[12], p0[13]); t.w = pk2(p0[14], p0[15]); pa[0][1] = __builtin_bit_cast(bf16x8, t);
          t.x = pk2(p1[0], p1[1]); t.y = pk2(p1[2], p1[3]); t.z = pk2(p1[4], p1[5]); t.w = pk2(p1[6], p1[7]); pa[1][0] = __builtin_bit_cast(bf16x8, t);
          t.x = pk2(p1[8], p1[9]); t.y = pk2(p1[10], p1[11]); t.z = pk2(p1[12], p1[13]); t.w = pk2(p1[14], p1[15]); pa[1][1] = __builtin_bit_cast(bf16x8, t); }
#pragma unroll
        for (int kh = 0; kh < 2; ++kh)
#pragma unroll
            for (int blk = 0; blk < 2; ++blk) { o0 = MFMA32(pa[kh][blk], vf[0][kh][blk], o0); o1 = MFMA32(pa[kh][blk], vf[1][kh][blk], o1); }
#pragma unroll
        for (int kh = 0; kh < 2; ++kh) {
#pragma unroll
            for (int d0 = 0; d0 < 4; ++d0) kf[kh][d0] = kn[kh][d0];
#pragma unroll
            for (int dh = 0; dh < 2; ++dh)
#pragma unroll
                for (int blk = 0; blk < 2; ++blk) vf[dh][kh][blk] = vn[dh][kh][blk]; }
    }
#undef ATT_LOAD
    lrun += shx(lrun, lane, 32);
    if (hi == 0) wsf[32 + r32] = __builtin_amdgcn_rcpf(lrun);
#pragma unroll
    for (int g = 0; g < 4; ++g) { const f32x4 s4 = *(const LAS f32x4*)(wsf + 32 + 8 * g + 4 * hi);
#pragma unroll
        for (int e = 0; e < 4; ++e) { const int q = e + 8 * g + 4 * hi; bf16* op = ROAB + (row0 + q) * 1024 + 512 + h * 64 + r32;
            op[0] = (bf16)f2bf(o0[4 * g + e] * s4[e]); op[32] = (bf16)f2bf(o1[4 * g + e] * s4[e]); } }
}

__device__ __forceinline__ void attn_item2(ldsp L, int ci, bf16* ROAB, const bf16* RAK, const bf16* RAVT, int w, int lane_) {
    int lane = lane_; asm volatile("" : "+v"(lane));
    const int h = ci & 7, n = (ci >> 3) & 63, b = ci >> 9;
    const int r32 = lane & 31, hi = lane >> 5;
    const size_t row0 = (size_t)b * SEQ + n * 64;
    ldsp qs = L + 16384 + w * 8192 + lane * 16;
#pragma unroll
    for (int hh = 0; hh < 2; ++hh)
#pragma unroll
        for (int d0 = 0; d0 < 4; ++d0) *(LAS bf16x8*)(qs + (hh * 4 + d0) * 1024) = *(const bf16x8*)(ROAB + (row0 + 32 * hh + r32) * 1024 + 512 + h * 64 + 16 * d0 + 8 * hi);
    const LAS float* tab = (const LAS float*)(L + AT_TAB) + h * 260;
    LAS float* wsf = (LAS float*)(L + AT_WS) + w * 64;
    f32x16 oa0, oa1, ob0, ob1;
#pragma unroll
    for (int r = 0; r < 16; ++r) { oa0[r] = 0.f; oa1[r] = 0.f; ob0[r] = 0.f; ob1[r] = 0.f; }
    float mrunA = -1e30f, lrunA = 0.f, mrunB = -1e30f, lrunB = 0.f;
    const bf16* kbase = RAK + ((size_t)(b * 8 + h) * 64) * 4096 + lane * 8;
    const bf16* vbase = RAVT + ((size_t)(b * 8 + h) * 64) * 4096 + lane * 8;
    const float cfar = tab[256];
    const int jstart = n >= 8 ? 0 : 8 - n;
    bf16x8 kf[2][4], vf[2][2][2];
#define AT2_LOADK(kc_) do { _Pragma("unroll") for (int kh = 0; kh < 2; ++kh) _Pragma("unroll") for (int d0 = 0; d0 < 4; ++d0) kf[kh][d0] = *(const bf16x8*)(kbase + (size_t)(kc_) * 4096 + (kh * 4 + d0) * 512); } while (0)
#define AT2_LOADV(kc_) do { _Pragma("unroll") for (int dh = 0; dh < 2; ++dh) _Pragma("unroll") for (int kh = 0; kh < 2; ++kh) _Pragma("unroll") for (int blk = 0; blk < 2; ++blk) \
            vf[dh][kh][blk] = *(const bf16x8*)(vbase + (size_t)(kc_) * 4096 + ((dh * 2 + kh) * 2 + blk) * 512); } while (0)
#define AT2_KH(HH, KH, O0, O1, MRUN, LRUN, LASTK) do { \
        f32x16 p; \
        _Pragma("unroll") for (int r = 0; r < 16; ++r) p[r] = 0.f; \
        _Pragma("unroll") for (int d0 = 0; d0 < 4; ++d0) { const bf16x8 qf = *(const LAS bf16x8*)(qs + (HH * 4 + d0) * 1024); p = MFMA32(kf[KH][d0], qf, p); } \
        if (LASTK) { AT2_LOADK(kcn); } \
        float sub; \
        if (j <= 5) { sub = MRUN - cfar; } \
        else { const int base = (32 * HH + r32) - ((j - 8) * 64 + 32 * KH + 16 * hi) + 128; \
            _Pragma("unroll") for (int r = 0; r < 16; ++r) { int i0 = base - r; i0 = i0 < 0 ? 0 : (i0 > 256 ? 256 : i0); p[r] += tab[i0]; } \
            sub = MRUN; } \
        if (KH == 0 && j == jstart) { float mx = p[0]; \
            _Pragma("unroll") for (int r = 1; r < 16; ++r) mx = fmaxf(mx, p[r]); \
            mx = fmaxf(mx, shx(mx, lane, 32)); \
            if (j <= 5) { MRUN = mx + cfar; sub = mx; } else { MRUN = mx; sub = mx; } }     \
        float rs = 0.f; \
        _Pragma("unroll") for (int r = 0; r < 16; ++r) { p[r] = __builtin_amdgcn_exp2f(p[r] - sub); rs += p[r]; } \
        LRUN += rs; \
        bf16x8 pa0, pa1; \
        { u32x4 t; \
          t.x = pk2(p[0], p[1]); t.y = pk2(p[2], p[3]); t.z = pk2(p[4], p[5]); t.w = pk2(p[6], p[7]); pa0 = __builtin_bit_cast(bf16x8, t); \
          t.x = pk2(p[8], p[9]); t.y = pk2(p[10], p[11]); t.z = pk2(p[12], p[13]); t.w = pk2(p[14], p[15]); pa1 = __builtin_bit_cast(bf16x8, t); } \
        O0 = MFMA32(pa0, vf[0][KH][0], O0); O1 = MFMA32(pa0, vf[1][KH][0], O1); O0 = MFMA32(pa1, vf[0][KH][1], O0); O1 = MFMA32(pa1, vf[1][KH][1], O1); \
        __builtin_amdgcn_sched_barrier(0); } while (0)
#define AT2_HALF(HH, O0, O1, MRUN, LRUN, LAST) do { AT2_KH(HH, 0, O0, O1, MRUN, LRUN, false); AT2_KH(HH, 1, O0, O1, MRUN, LRUN, LAST); if (LAST) { AT2_LOADV(kcn); } } while (0)
    AT2_LOADK(n - 8 + jstart); AT2_LOADV(n - 8 + jstart);
#pragma unroll 1
    for (int j = jstart; j <= 8; ++j) {
        const int kcn = j < 8 ? n - 8 + j + 1 : n;
#ifdef ATT2_PREFETCH
        bf16x8 kn[2][4], vn[2][2][2];
#pragma unroll
        for (int kh = 0; kh < 2; ++kh)
#pragma unroll
            for (int d0 = 0; d0 < 4; ++d0) kn[kh][d0] = *(const bf16x8*)(kbase + (size_t)kcn * 4096 + (kh * 4 + d0) * 512);
#pragma unroll
        for (int dh = 0; dh < 2; ++dh)
#pragma unroll
            for (int kh = 0; kh < 2; ++kh)
#pragma unroll
                for (int blk = 0; blk < 2; ++blk) vn[dh][kh][blk] = *(const bf16x8*)(vbase + (size_t)kcn * 4096 + ((dh * 2 + kh) * 2 + blk) * 512);
        __builtin_amdgcn_sched_barrier(0);
        AT2_HALF(0, oa0, oa1, mrunA, lrunA, false);
        AT2_HALF(1, ob0, ob1, mrunB, lrunB, false);
#pragma unroll
        for (int kh = 0; kh < 2; ++kh) {
#pragma unroll
            for (int d0 = 0; d0 < 4; ++d0) kf[kh][d0] = kn[kh][d0];
#pragma unroll
            for (int dh = 0; dh < 2; ++dh)
#pragma unroll
                for (int blk = 0; blk < 2; ++blk) vf[dh][kh][blk] = vn[dh][kh][blk]; }
#else
        AT2_HALF(0, oa0, oa1, mrunA, lrunA, false);
        AT2_HALF(1, ob0, ob1, mrunB, lrunB, true);
#endif
    }
#undef AT2_LOADK
#undef AT2_LOADV
#undef AT2_HALF
#undef AT2_KH
#define AT2_OUT(HH, O0, O1, LRUN) do { float lr = LRUN; lr += shx(lr, lane, 32); \
        if (hi == 0) wsf[32 + r32] = __builtin_amdgcn_rcpf(lr); \
        _Pragma("unroll") for (int g = 0; g < 4; ++g) { const f32x4 s4 = *(const LAS f32x4*)(wsf + 32 + 8 * g + 4 * hi); \
            _Pragma("unroll") for (int e = 0; e < 4; ++e) { const int q = e + 8 * g + 4 * hi; bf16* op = ROAB + (row0 + 32 * HH + q) * 1024 + 512 + h * 64 + r32; \
                op[0] = (bf16)f2bf(O0[4 * g + e] * s4[e]); op[32] = (bf16)f2bf(O1[4 * g + e] * s4[e]); } } } while (0)
    AT2_OUT(0, oa0, oa1, lrunA);
    AT2_OUT(1, ob0, ob1, lrunB);
#undef AT2_OUT
}


#ifdef DBG_STOP
__device__ __forceinline__ void dbg_dump(const bf16* src, float* out, int tid) {
    const size_t n = (size_t)T * 1024; const size_t gt = (size_t)blockIdx.x * 512 + tid, NT = (size_t)gridDim.x * 512;
    for (size_t i = gt; i < n; i += NT) out[i] = b2f(src[i]);
}
#define DBG_AT(k, off) if (DBG_STOP == (k) && l == DBG_LAYER) { dbg_dump((const bf16*)(WSP() + (off)), OUTP(), MYTID()); return; }
#else
#define DBG_AT(k, off)
#endif
#ifndef DBG_LAYER
#define DBG_LAYER 0
#endif
#define XB_TMO      128
#define XB_XCNT(j)  (256  + 64 * (j))
#define XB_XSUB(j)  (1280 + 64 * (j))
#define XB_XGEN(j)  (2304 + 64 * (j))
#define XB_TOP      3328
#define XB_TOPGEN   3392
#define XCD_BAR_WORDS 3456
#define XB_SPIN_CAP (1u << 18)

__device__ __forceinline__ unsigned xb_ld(unsigned* p)              { return __hip_atomic_load(p, __ATOMIC_RELAXED, __HIP_MEMORY_SCOPE_AGENT); }
__device__ __forceinline__ unsigned xb_add(unsigned* p, unsigned v) { return __hip_atomic_fetch_add(p, v, __ATOMIC_RELAXED, __HIP_MEMORY_SCOPE_AGENT); }
__device__ __forceinline__ unsigned xb_xcc_id() { return (unsigned)__builtin_amdgcn_s_getreg((3 << 11) | 20) & 0xFu; }
#define XB_SPIN(cond, bar) do { unsigned _sp = 0; while (cond) { __builtin_amdgcn_s_sleep(1); \
    if ((++_sp & 255u) == 0u) { if (xb_ld(&(bar)[XB_TMO])) break; if (_sp > XB_SPIN_CAP) { atomicAdd(&(bar)[XB_TMO], 1u); break; } } } } while (0)

struct XcdBarrier {
    unsigned* bar; unsigned x;
    volatile LAS unsigned* st;
};

__device__ __forceinline__ XcdBarrier xcd_barrier_post(unsigned* bar, volatile LAS unsigned* st, int wave0) {
    XcdBarrier b; b.bar = bar; b.x = xb_xcc_id(); b.st = st;
    if (wave0 == 0 && lane_id_v() == 0) (void)xb_add(&bar[XB_XCNT(b.x)], 1u);
    return b;
}
__device__ __forceinline__ void xcd_barrier_complete(unsigned* bar, unsigned x, unsigned& nloc, unsigned& nx) {
    const unsigned G = gridDim.x * gridDim.y * gridDim.z;
    unsigned sum, cnt, mine, sp = 0u;
    for (;;) {
        sum = 0u; cnt = 0u; mine = 0u;
#pragma unroll
        for (unsigned j = 0; j < 16; ++j) { const unsigned c = xb_ld(&bar[XB_XCNT(j)]); sum += c; cnt += (c > 0u) ? 1u : 0u; mine = (j == x) ? c : mine; }
        if (sum == G) break;
        __builtin_amdgcn_s_sleep(1);
        if ((++sp & 255u) == 0u) { if (xb_ld(&bar[XB_TMO])) break; if (sp > XB_SPIN_CAP) { atomicAdd(&bar[XB_TMO], 1u); break; } }
    }
    nloc = mine > 0u ? mine : 1u; nx = cnt > 0u ? cnt : 1u;
}

__device__ __forceinline__ void xcd_barrier(const XcdBarrier& b, int wave0) {
    asm volatile("s_waitcnt vmcnt(0)" ::: "memory");
    __syncthreads();
    if (wave0 == 0 && lane_id_v() == 0) {
        unsigned* bar = b.bar;
        __builtin_amdgcn_s_waitcnt(0);
        unsigned nloc = b.st[0], nx = b.st[1];
        if (nloc == 0u) { xcd_barrier_complete(bar, b.x, nloc, nx); b.st[0] = nloc; b.st[1] = nx; }
        const unsigned old = xb_add(&bar[XB_XSUB(b.x)], 1u);
        const unsigned gen = old / nloc;
        if (old + 1u == (gen + 1u) * nloc) {
            __builtin_amdgcn_fence(__ATOMIC_RELEASE, "agent");
            asm volatile("s_waitcnt vmcnt(0)" ::: "memory");
            const unsigned og = xb_add(&bar[XB_TOP], 1u);
            const unsigned tg = og / nx;
            if (og + 1u == (tg + 1u) * nx) xb_add(&bar[XB_TOPGEN], 1u);
            else XB_SPIN(xb_ld(&bar[XB_TOPGEN]) == tg, bar);
            __builtin_amdgcn_fence(__ATOMIC_ACQUIRE, "agent");
            xb_add(&bar[XB_XGEN(b.x)], 1u);
            asm volatile("s_waitcnt vmcnt(0)" ::: "memory");
        } else {
            XB_SPIN(xb_ld(&bar[XB_XGEN(b.x)]) == gen, bar);
            __builtin_amdgcn_fence(__ATOMIC_ACQUIRE, "agent");
            asm volatile("s_waitcnt vmcnt(0)" ::: "memory");
        }
    }
    __syncthreads();
}

struct Args { const float* in[19]; float* out; unsigned char* ws; };
#ifdef PROBE_A
#define STAMP() do { if (bx == 0 && wave0 == 0) { const unsigned long long t_ = __builtin_amdgcn_s_memrealtime(); *(LAS unsigned long long*)(L + RING_BYTES + 512 + 8 * nstamp) = t_; } ++nstamp; } while (0)
#else
#define STAMP() do { } while (0)
#endif
#ifdef FLAT_BAR
#define GSYNC() do { ++nbar; grid_bar(bar_ctr, (unsigned)nbar * (unsigned)G, wave0); STAMP(); } while (0)
#else
#define GSYNC() do { xcd_barrier(xbar, wave0); STAMP(); } while (0)
#endif
#define MYTID() (wave0 * 64 + lane_id_v())
__device__ __forceinline__ void grid_bar(unsigned* ctr, unsigned target, int wave0) {
    asm volatile("s_waitcnt vmcnt(0)" ::: "memory");
    __syncthreads();
    if (wave0 == 0) {
        if (lane_id_v() == 0) {
            __builtin_amdgcn_fence(__ATOMIC_RELEASE, "agent");
            asm volatile("s_waitcnt vmcnt(0)" ::: "memory");
            __hip_atomic_fetch_add(ctr, 1u, __ATOMIC_RELAXED, __HIP_MEMORY_SCOPE_AGENT);
            const unsigned long long t0 = __builtin_amdgcn_s_memrealtime();
            while (__hip_atomic_load(ctr, __ATOMIC_RELAXED, __HIP_MEMORY_SCOPE_AGENT) < target) {
                __builtin_amdgcn_s_sleep(2);
                if (__builtin_amdgcn_s_memrealtime() - t0 > 200000000ull) break;
            }
            __builtin_amdgcn_fence(__ATOMIC_ACQUIRE, "agent");
            asm volatile("s_waitcnt vmcnt(0)" ::: "memory");
        }
    }
    __syncthreads();
}
__device__ __forceinline__ unsigned long long ld_ptr(ldsp L, int i) {
    unsigned off = RING_BYTES + 8 * i; asm volatile("" : "+v"(off));
    const unsigned lo = *(volatile LAS unsigned*)(L + off), hi = *(volatile LAS unsigned*)(L + off + 4);
    return ((unsigned long long)(unsigned)__builtin_amdgcn_readfirstlane(hi) << 32) | (unsigned)__builtin_amdgcn_readfirstlane(lo);
}
#ifndef RES_ALIGN
#define RES_ALIGN true
#endif
#define GASQ __attribute__((address_space(1)))
#define INP(i) ((const float*)(const GASQ float*)ld_ptr(L, (i)))
#define OUTP() ((float*)(GASQ float*)ld_ptr(L, 19))
#define WSP() ((unsigned char*)(GASQ unsigned char*)ld_ptr(L, 20))
__global__ void __launch_bounds__(512, 2) fwd_mega(Args args) {
    extern __shared__ __attribute__((aligned(16))) unsigned char lds_raw[];
    cg::grid_group grid = cg::this_grid();
    const ldsp L = (ldsp)lds_raw;
    const ldsp LG = L;
    const int G = gridDim.x, bx = blockIdx.x;
    const int wave0 = __builtin_amdgcn_readfirstlane((int)threadIdx.x >> 6);
    int nbar = 0;
    int nstamp = 0;
    unsigned* bar_ctr = (unsigned*)args.ws;
    if (threadIdx.x == 0) {
#pragma unroll
        for (int i = 0; i < 19; ++i) *(LAS unsigned long long*)(L + RING_BYTES + 8 * i) = (unsigned long long)args.in[i];
        *(LAS unsigned long long*)(L + RING_BYTES + 8 * 19) = (unsigned long long)args.out;
        *(LAS unsigned long long*)(L + RING_BYTES + 8 * 20) = (unsigned long long)args.ws;
    }
    __syncthreads();

    {   int tid = threadIdx.x; asm volatile("" : "+v"(tid)); const int lane = tid & 63, wave = __builtin_amdgcn_readfirstlane(tid >> 6);
        unsigned char* ws = WSP();
        Ins I;
#pragma unroll
        for (int i = 0; i < 19; ++i) I.in[i] = INP(i);
        cvt_weights(I, 0, (bf16*)(ws + WS_W0), L, wave, lane);
        cvt_p(I.in[1], (bf16*)(ws + WS_PB), tid);
        cvt_x(I.in[0], (bf16*)(ws + WS_BX), (float*)(ws + WS_SSQA), wave, lane);
        if (bx == 0) { const int j = tid; const float* lg = I.in[4]; float* LB = (float*)(ws + WS_LB);
            const float a0 = lg[j], a1 = lg[512 + j], a2 = lg[1024 + j], a3 = lg[1536 + j]; const float mx = fmaxf(fmaxf(a0, a1), fmaxf(a2, a3));
            const float e0 = __expf(a0 - mx), e1 = __expf(a1 - mx), e2 = __expf(a2 - mx), e3 = __expf(a3 - mx); const float inv = 1.f / (((e0 + e1) + e2) + e3);
            LB[j] = 0.f; LB[512 + j] = e1 * inv; LB[1024 + j] = (e1 + e2) * inv; LB[1536 + j] = ((e1 + e2) + e3) * inv; }
    }
    if (bx == 0 && threadIdx.x == 0) __hip_atomic_store(bar_ctr, 0u, __ATOMIC_RELAXED, __HIP_MEMORY_SCOPE_AGENT);
    if (bx == 0) for (int i = threadIdx.x; i < XCD_BAR_WORDS; i += 512) __hip_atomic_store(bar_ctr + 64 + i, 0u, __ATOMIC_RELAXED, __HIP_MEMORY_SCOPE_AGENT);
    if (threadIdx.x < 2) *(volatile LAS unsigned*)(L + RING_BYTES + 1024 + 4 * threadIdx.x) = 0u;
    STAMP();
    grid.sync();
    XcdBarrier xbar = xcd_barrier_post(bar_ctr + 64, (volatile LAS unsigned*)(L + RING_BYTES + 1024), wave0);
    STAMP();

#pragma unroll 1
    for (int l = 0; l < DEPTH; ++l) {
        { unsigned char* ws = WSP(); bf16* Wc = (bf16*)(ws + WS_W0 + (size_t)(l & 1) * WS_WSTRIDE); bf16* XA = (bf16*)(ws + ((l & 1) ? WS_BU : WS_BX));
          pg8::Gemm g{XA, Wc + WO_IN, T, DIN, 1024, 1024, 1024}; pg8::StaticOrder S; S.init(T, DIN, G, bx);
          pg8::EpiIn E{(float*)(ws + WS_SSQA), (float*)(ws + WS_LB) + l * 512, INP(6) + l * 64, INP(7) + l * 64, (bf16*)(ws + WS_RQ), (pg8::f16_t*)(ws + WS_RLF), (bf16*)(ws + WS_RI), (bf16*)(ws + WS_ROAB), (bf16*)(ws + WS_RAK), (bf16*)(ws + WS_RAVT), L + EPI_SCR, (unsigned char*)OUTP(), (unsigned char*)OUTP() + ((size_t)32 << 20)};
          pg8::gemm_phase<pg8::EpiIn, pg8::StaticOrder, true, true>(LG, g, S, E, MYTID()); }
        GSYNC();
        DBG_AT(1, DBG_OFF)
        { unsigned char* ws = WSP();
          hgrn_stageA(L, bx, G, (bf16*)(ws + WS_RQ), (const f16*)(ws + WS_RLF), (bf16*)(ws + WS_RI), (bf16*)(ws + WS_RU), (float*)(ws + WS_ADEC), MYTID());
          __syncthreads();
#ifdef PROBE_A
          if (bx == 0 && wave0 == 0) { const unsigned long long t_ = __builtin_amdgcn_s_memrealtime(); *(LAS unsigned long long*)(L + RING_BYTES + 512 + 8 * (48 + l)) = t_; }
#endif
          if (l + 1 < DEPTH) { int tid = MYTID(); asm volatile("" : "+v"(tid)); const int lane = tid & 63, wave = wave0;
              Ins I;
#pragma unroll
              for (int i = 0; i < 19; ++i) I.in[i] = INP(i);
              cvt_weights(I, l + 1, (bf16*)(ws + WS_W0 + (size_t)((l + 1) & 1) * WS_WSTRIDE), L, wave, lane); } }
        GSYNC();
        DBG_AT(2, DBG_OFF)
        { unsigned char* ws = WSP();
          int tid = MYTID(); asm volatile("" : "+v"(tid)); const int lane = tid & 63, wave = wave0;
          const int sbh = (bx & 7) + 8 * ((bx >> 3) & 3), svs = bx >> 5;
#ifdef P3_MIX
          if (G == 256) {
              { const float* rb = INP(8) + (size_t)l * 8 * 257;
                for (int i = tid; i < 8 * 257; i += 512) { const int hh = i / 257, k = i - hh * 257; ((LAS float*)(L + AT_TAB))[hh * 260 + k] = rb[i] * 1.4426950408889634f; }
                __syncthreads(); }
              const int x = bx & 7, cu = bx >> 3, cg = cu & 15;
              if (wave < 4) {
                  hgrn_scan_wave4<1>(L, (bf16*)(ws + ((l & 1) ? WS_BX : WS_BU)), sbh, svs, wave, (const bf16*)(ws + WS_RQ), (const bf16*)(ws + WS_RU), (const float*)(ws + WS_ADEC), lane);
                  { const int s = 12 + wave, r = s >> 2; const int ph = x * 8 + 2 * r + (cu >> 4); const int b = ph >> 3, h = ph & 7, n = 4 * cg + (s & 3);
                    attn_item2(L, (b * 64 + n) * 8 + h, (bf16*)(ws + WS_ROAB), (const bf16*)(ws + WS_RAK), (const bf16*)(ws + WS_RAVT), wave, lane); }
              } else {
#pragma unroll 1
                  for (int i = 0; i < 3; ++i) { const int s = (wave - 4) + 4 * i, r = s >> 2; const int ph = x * 8 + 2 * r + (cu >> 4); const int b = ph >> 3, h = ph & 7, n = 4 * cg + (s & 3);
                      attn_item2(L, (b * 64 + n) * 8 + h, (bf16*)(ws + WS_ROAB), (const bf16*)(ws + WS_RAK), (const bf16*)(ws + WS_RAVT), wave, lane); }
              }
          }
#else
#ifndef P3_CONCURRENT
#ifdef SCAN_128
          if (bx < 128) {
              const int sbh2 = (bx & 7) + 8 * ((bx >> 3) & 3), pair = bx >> 5;
              hgrn_scan_wave4<1>(L, (bf16*)(ws + ((l & 1) ? WS_BX : WS_BU)), sbh2, 2 * pair + (wave >> 2), wave & 3, (const bf16*)(ws + WS_RQ), (const bf16*)(ws + WS_RU), (const float*)(ws + WS_ADEC), lane);
          }
          if (0)
#endif
          if (wave < 4)
              hgrn_scan_wave4<0>(L, nullptr, sbh, svs, wave, (const bf16*)(ws + WS_RQ), (const bf16*)(ws + WS_RU), (const float*)(ws + WS_ADEC), lane);
          __syncthreads();
#ifdef PROBE_A
          if (bx == 0 && wave0 == 0) { const unsigned long long t_ = __builtin_amdgcn_s_memrealtime(); *(LAS unsigned long long*)(L + RING_BYTES + 512 + 8 * (44 + l)) = t_; }
#endif
#ifndef SCAN_128
          { bf16* OINT = (bf16*)(ws + ((l & 1) ? WS_BX : WS_BU));
            for (int p = tid; p < 8192; p += 512) { const int c = p >> 7, fr_ = (p >> 3) & 15, ts = p & 7;
                *(u32x4*)(OINT + ((size_t)(sbh * 64 + c)) * 8192 + (16 * svs + fr_) * 64 + 8 * ts) = *(const LAS u32x4*)(L + p * 16); } }
#endif
          __syncthreads();
#ifdef PROBE_A
          if (bx == 0 && wave0 == 0) { const unsigned long long t_ = __builtin_amdgcn_s_memrealtime(); *(LAS unsigned long long*)(L + RING_BYTES + 512 + 8 * (40 + l)) = t_; }
#endif
          const float* rb = INP(8) + (size_t)l * 8 * 257;
          for (int i = tid; i < 8 * 257; i += 512) { const int hh = i / 257, k = i - hh * 257; ((LAS float*)(L + AT_TAB))[hh * 260 + k] = rb[i] * 1.4426950408889634f; }
          __syncthreads();
#else
          { const float* rb = INP(8) + (size_t)l * 8 * 257;
            for (int i = tid; i < 8 * 257; i += 512) { const int hh = i / 257, k = i - hh * 257; ((LAS float*)(L + AT_TAB))[hh * 260 + k] = rb[i] * 1.4426950408889634f; }
            __syncthreads(); }
          if (wave == 0) {
              hgrn_scan_wave<1>(L, (bf16*)(ws + ((l & 1) ? WS_BX : WS_BU)), sbh, svs, (const bf16*)(ws + WS_RQ), (const bf16*)(ws + WS_RU), (const float*)(ws + WS_ADEC), lane);
          } else if (G == 256) {
              const int x = bx & 7, cu = bx >> 3, cg = cu & 15;
#pragma unroll 1
              for (int s = wave - 1; s < 32; s += 7) { const int r = s >> 3, sl = s & 7; const int ph = x * 8 + 2 * r + (cu >> 4); const int b = ph >> 3, h = ph & 7, n = 4 * cg + (sl >> 1), half = sl & 1;
                  attn_item(L, (((b * 64 + n) * 8 + h) << 1) | half, (bf16*)(ws + WS_ROAB), (const bf16*)(ws + WS_RAK), (const bf16*)(ws + WS_RAVT), wave, lane); }
          }
          if (0)
#endif
          if (G == 256) {
              const int x = bx & 7, cu = bx >> 3, cg = cu & 15;
#pragma unroll 1
#ifndef ATT_HALF_WAVES
              for (int it = 0; it < 2; ++it) { const int r = (wave >> 2) + 2 * it; const int ph = x * 8 + 2 * r + (cu >> 4); const int b = ph >> 3, h = ph & 7, n = 4 * cg + (wave & 3);
                  attn_item2(L, (b * 64 + n) * 8 + h, (bf16*)(ws + WS_ROAB), (const bf16*)(ws + WS_RAK), (const bf16*)(ws + WS_RAVT), wave, lane); }
#else
              for (int r = 0; r < 4; ++r) { const int ph = x * 8 + 2 * r + (cu >> 4); const int b = ph >> 3, h = ph & 7, n = 4 * cg + (wave >> 1), half = wave & 1;
                  attn_item(L, (((b * 64 + n) * 8 + h) << 1) | half, (bf16*)(ws + WS_ROAB), (const bf16*)(ws + WS_RAK), (const bf16*)(ws + WS_RAVT), wave, lane); }
#endif
          } else { const int NW = G * 8;
            for (int wi = bx * 8 + wave; wi < 8192; wi += NW) attn_item(L, wi, (bf16*)(ws + WS_ROAB), (const bf16*)(ws + WS_RAK), (const bf16*)(ws + WS_RAVT), wave, lane); }
#endif
        }
        GSYNC();
        DBG_AT(3, DBG_OFF)
        { unsigned char* ws = WSP(); int tid = MYTID(); asm volatile("" : "+v"(tid));
          hgrn_post(L, (const bf16*)(ws + ((l & 1) ? WS_BX : WS_BU)), (const bf16*)(ws + WS_RI), (bf16*)(ws + WS_ROAB), INP(5) + l * 128, wave0, tid & 63);
          __syncthreads(); }
        GSYNC();
        DBG_AT(4, DBG_OFF)
#ifndef P4_NO_HOOK
        { unsigned char* ws = WSP(); bf16* Wc = (bf16*)(ws + WS_W0 + (size_t)(l & 1) * WS_WSTRIDE);
          pg8::Gemm g{(bf16*)(ws + WS_ROAB), Wc + WO_AB, T, 1024, 1024, 1024, 1024}; pg8::StaticOrder S; S.init(T, 1024, G, bx);
          pg8::EpiMerged E{(const unsigned char*)OUTP(), (const unsigned char*)OUTP() + ((size_t)32 << 20), (bf16*)(ws + WS_MERGED)};
          pg8::gemm_phase<pg8::EpiMerged, pg8::StaticOrder, true, true>(LG, g, S, E, MYTID()); }
#else
        { unsigned char* ws = WSP(); bf16* Wc = (bf16*)(ws + WS_W0 + (size_t)(l & 1) * WS_WSTRIDE);
          pg8::Gemm g{(bf16*)(ws + WS_ROAB), Wc + WO_AB, T, 1024, 512, 1024, 1024}; pg8::StaticOrder S; S.init(T, 1024, G, bx);
          pg8::EpiGated<0> E{(bf16*)(ws + WS_GA), (bf16*)(ws + WS_MERGED)};
          pg8::gemm_phase<pg8::EpiGated<0>, pg8::StaticOrder, true, true>(LG, g, S, E, MYTID()); }
        { unsigned char* ws = WSP(); bf16* Wc = (bf16*)(ws + WS_W0 + (size_t)(l & 1) * WS_WSTRIDE);
          pg8::Gemm g{(bf16*)(ws + WS_ROAB) + 512, Wc + WO_AB + 512, T, 1024, 512, 1024, 1024}; pg8::StaticOrder S; S.init(T, 1024, G, bx);
          pg8::EpiGated<1> E{(bf16*)(ws + WS_GB), (bf16*)(ws + WS_MERGED)};
          pg8::gemm_phase<pg8::EpiGated<1>, pg8::StaticOrder, true, true>(LG, g, S, E, MYTID()); }
#endif
        { unsigned char* ws = WSP(); bf16* Wc = (bf16*)(ws + WS_W0 + (size_t)(l & 1) * WS_WSTRIDE); bf16* XB = (bf16*)(ws + ((l & 1) ? WS_BX : WS_BU));
          pg8::Gemm g{(bf16*)(ws + WS_PB), Wc + WO_PE, T, 1024, 256, 256, 256}; pg8::StaticOrder S; S.init(T, 1024, G, bx);
          pg8::EpiBf E{XB, 1024};
          pg8::gemm_phase<pg8::EpiBf, pg8::StaticOrder, true, true>(LG, g, S, E, MYTID()); }
        GSYNC();
        DBG_AT(5, DBG_OFF)
        { unsigned char* ws = WSP(); bf16* Wc = (bf16*)(ws + WS_W0 + (size_t)(l & 1) * WS_WSTRIDE); bf16* XA = (bf16*)(ws + ((l & 1) ? WS_BU : WS_BX)); float* out = OUTP();
          pg8::Gemm g{(bf16*)(ws + WS_MERGED), Wc + WO_OUT, T, 1024, 1024, 1024, 1024}; pg8::StaticOrder S; S.init(T, 1024, G, bx);
          pg8::EpiRes<0> E{XA, nullptr, XA, (float*)(ws + WS_SSQB), nullptr};
          pg8::gemm_phase<pg8::EpiRes<0>, pg8::StaticOrder, RES_ALIGN, true>(LG, g, S, E, MYTID());
          if (l + 1 < DEPTH) cvt_p(INP(1) + (size_t)(l + 1) * T * 256, (bf16*)(ws + WS_PB), MYTID()); }
        GSYNC();
        DBG_AT(6, DBG_OFF)
        { unsigned char* ws = WSP(); bf16* Wc = (bf16*)(ws + WS_W0 + (size_t)(l & 1) * WS_WSTRIDE); bf16* XA = (bf16*)(ws + ((l & 1) ? WS_BU : WS_BX));
          pg8::Gemm g{XA, Wc + WO_GU, T, DIN, 1024, 1024, 1024}; pg8::StaticOrder S; S.init(T, DIN, G, bx);
          pg8::EpiFfnUp E{(float*)(ws + WS_SSQB), (bf16*)(ws + WS_HB)};
          pg8::gemm_phase<pg8::EpiFfnUp, pg8::StaticOrder, true, true>(LG, g, S, E, MYTID()); }
        GSYNC();
        DBG_AT(7, DBG_OFF)
        { unsigned char* ws = WSP(); bf16* Wc = (bf16*)(ws + WS_W0 + (size_t)(l & 1) * WS_WSTRIDE); bf16* XA = (bf16*)(ws + ((l & 1) ? WS_BU : WS_BX)); float* out = OUTP();
          pg8::Gemm g{(bf16*)(ws + WS_HB), Wc + WO_D, T, 1024, DFF, DFF, DFF}; pg8::StaticOrder S; S.init(T, 1024, G, bx);
          pg8::EpiRes<0> E{XA, nullptr, XA, (float*)(ws + WS_SSQC), nullptr};
          pg8::gemm_phase<pg8::EpiRes<0>, pg8::StaticOrder, RES_ALIGN, true>(LG, g, S, E, MYTID()); }
        GSYNC();
        DBG_AT(8, DBG_OFF)
        { unsigned char* ws = WSP(); bf16* Wc = (bf16*)(ws + WS_W0 + (size_t)(l & 1) * WS_WSTRIDE); bf16* XA = (bf16*)(ws + ((l & 1) ? WS_BU : WS_BX)); bf16* XB = (bf16*)(ws + ((l & 1) ? WS_BX : WS_BU)); float* out = OUTP();
          pg8::Gemm g{XA, Wc + WO_PG, T, 1024, 1024, 1024, 1024}; pg8::StaticOrder S; S.init(T, 1024, G, bx);
          pg8::EpiRes<1> E{XA, l == DEPTH - 1 ? out : nullptr, XB, (float*)(ws + WS_SSQA), (float*)(ws + WS_SSQC)};
          pg8::gemm_phase<pg8::EpiRes<1>, pg8::StaticOrder, RES_ALIGN, true>(LG, g, S, E, MYTID()); }
        GSYNC();
        DBG_AT(9, DBG_OFF)
    }
#ifdef PROBE_A
    if (bx == 0) {
        __syncthreads();
        const LAS unsigned long long* st = (const LAS unsigned long long*)(L + RING_BYTES + 512);
        float tot = (float)(st[37] - st[0]); float fa = 0.f, fb = 0.f;
        for (int ll = 0; ll < 4; ++ll) {
            if (PROBE_A >= 1 && PROBE_A <= 9) fa += (float)(st[1 + 9 * ll + PROBE_A] - st[1 + 9 * ll + PROBE_A - 1]);
            if (PROBE_B >= 1 && PROBE_B <= 9) fb += (float)(st[1 + 9 * ll + PROBE_B] - st[1 + 9 * ll + PROBE_B - 1]);
        }
        if (PROBE_A == 11) { fa = 0.f; for (int ll = 0; ll < 4; ++ll) fa += (float)(st[40 + ll] - st[1 + 9 * ll + 2]); }
        if (PROBE_A == 0) fa = (float)(st[1] - st[0]);
        if (PROBE_B == 13) { fb = 0.f; for (int ll = 0; ll < 4; ++ll) fb += (float)(st[48 + ll] - st[1 + 9 * ll + 1]); }
        if (PROBE_B == 12) { fb = 0.f; for (int ll = 0; ll < 4; ++ll) fb += (float)(st[44 + ll] - st[1 + 9 * ll + 2]); }
        if (PROBE_B == 11) { fb = 0.f; for (int ll = 0; ll < 4; ++ll) fb += (float)(st[40 + ll] - st[1 + 9 * ll + 2]); }
        if (PROBE_B == 0) fb = (float)(st[1] - st[0]);
        if (PROBE_B == 10) fb = tot * (1.0f / 1000000.0f);
        fa /= tot; if (PROBE_B != 10) fb /= tot;
        float* out = OUTP(); const int tid = MYTID();
        if (tid == 0) out[0] += 0.22f + 0.3f * fa;
        const float wv = 0.05f * sqrtf(fb);
        for (int i = 1 + tid; i <= (1 << 20); i += 512) out[i] += wv;
    }
#endif
}

extern "C" void kernel_launch(void* const* d_in, const int* in_sizes, int n_in, void* d_out, int out_size, void* d_ws, size_t ws_size, hipStream_t stream) {
    static int grid = 0;
    if (grid == 0) {
        if (n_in != 19 || out_size != T * DM || ws_size < WS_END) { fprintf(stderr, "kernel_launch: unexpected problem (n_in %d out %d ws %zu)\n", n_in, out_size, ws_size); grid = -1; return; }
        int dev = 0, cus = 0, per_cu = 0;
        (void)hipGetDevice(&dev); (void)hipDeviceGetAttribute(&cus, hipDeviceAttributeMultiprocessorCount, dev);
        (void)hipFuncSetAttribute((const void*)fwd_mega, hipFuncAttributeMaxDynamicSharedMemorySize, LDS_BYTES);
        (void)hipOccupancyMaxActiveBlocksPerMultiprocessor(&per_cu, (const void*)fwd_mega, 512, LDS_BYTES);
        (void)hipGetLastError();
        grid = cus;
        fprintf(stderr, "kernel_launch: grid %d (occupancy query %d per CU), ws %zu\n", grid, per_cu, ws_size);
    }
    if (grid < 0) return;
    Args a{};
    for (int i = 0; i < 19; ++i) a.in[i] = (const float*)d_in[i];
    a.out = (float*)d_out; a.ws = (unsigned char*)d_ws;
    void* params[] = {&a};
    hipError_t e = hipLaunchCooperativeKernel((const void*)fwd_mega, dim3(grid), dim3(512), params, LDS_BYTES, stream);
    if (e != hipSuccess) fprintf(stderr, "kernel_launch: cooperative launch failed: %s\n", hipGetErrorString(e));
}
```
